# Optimizing an MI355X kernel written in HIP

```python
import jax, jax.numpy as jnp
from jax import lax
import numpy as np

D_MODEL = 1024
BATCH = 4
SEQ = 4096
DEPTH = 1

D_MIX = D_MODEL
D_LRU = D_MIX // 2
D_SGU = D_MIX - D_LRU
LRU_HEADS = 8
LRU_HEAD_DIM = D_LRU // LRU_HEADS
CONV_WIDTH = 4
LRU_C = 8.0
SGU_HEADS = 8
SGU_HEAD_DIM = D_SGU // SGU_HEADS
CHUNK = 128
N_EXPERTS = 32
TOP_K = 4
D_EXPERT = D_MODEL
SWIGLU_ALPHA = 1.702
SWIGLU_LIMIT = 7.0
EXPERT_BLOCK = 128
EPS = 1e-6

kernel_name = 'hymba_style_rglru_sgu_moe_adaln_layer'


def rmsnorm(x, g):
    xf = x.astype(jnp.float32)
    y = xf * lax.rsqrt(jnp.mean(xf * xf, axis=-1, keepdims=True) + EPS)
    return (y * g.astype(jnp.float32)).astype(x.dtype)


def layernorm(x, g, b):
    xf = x.astype(jnp.float32)
    mu = jnp.mean(xf, axis=-1, keepdims=True)
    var = jnp.mean(jnp.square(xf - mu), axis=-1, keepdims=True)
    y = (xf - mu) * lax.rsqrt(var + EPS)
    return (y * g.astype(jnp.float32) + b.astype(jnp.float32)).astype(x.dtype)


def rg_lru_group(xa, ya, conv_w, conv_b, wr, br, wi, bi, lam):
    bsz, s, ch = xa.shape
    xc = lax.conv_general_dilated(
        xa, conv_w[:, None, :].astype(xa.dtype), window_strides=(1,),
        padding=[(CONV_WIDTH - 1, 0)], dimension_numbers=('NWC', 'WIO', 'NWC'),
        feature_group_count=ch) + conv_b.astype(xa.dtype)
    xh = xc.reshape(bsz, s, LRU_HEADS, LRU_HEAD_DIM)
    rec = jnp.einsum('bshi,hio->bsho', xh, wr.astype(xa.dtype)).reshape(bsz, s, ch)
    inp = jnp.einsum('bshi,hio->bsho', xh, wi.astype(xa.dtype)).reshape(bsz, s, ch)
    r_gate = jax.nn.sigmoid(rec.astype(jnp.float32) + br.astype(jnp.float32))
    i_gate = jax.nn.sigmoid(inp.astype(jnp.float32) + bi.astype(jnp.float32))
    log_a = -LRU_C * r_gate * jax.nn.softplus(-lam.astype(jnp.float32))
    a = jnp.exp(log_a)
    mult = jnp.sqrt(-jnp.expm1(2.0 * log_a))
    bterm = mult * i_gate * xc.astype(jnp.float32)

    def combine(left, right):
        a1, b1 = left
        a2, b2 = right
        return a1 * a2, a2 * b1 + b2

    _, h = lax.associative_scan(combine, (a, bterm), axis=1)
    return (h * ya.astype(jnp.float32)).astype(xa.dtype)


def sgu_group(u, v, ln_g, ln_b, w_s, b_s):
    bsz, s, ch = v.shape
    v = layernorm(v, ln_g, ln_b)
    vh = v.reshape(bsz, s // CHUNK, CHUNK, SGU_HEADS, SGU_HEAD_DIM)
    causal = jnp.tril(jnp.ones((CHUNK, CHUNK), dtype=bool))
    wm = jnp.where(causal[None], w_s, 0.0).astype(v.dtype)
    mixed = jnp.einsum('hts,bnshe->bnthe', wm, vh) + b_s.T.astype(v.dtype)[None, None, :, :, None]
    return u * mixed.reshape(bsz, s, ch)


def moe(h, router_w, router_b, w_gu, b_gu, w_down, b_down):
    bsz, s, d = h.shape
    n_tok = bsz * s
    hf = h.reshape(n_tok, d)
    logits = (hf @ router_w).astype(jnp.float32) + router_b.astype(jnp.float32)
    top_logit, top_e = lax.top_k(logits, TOP_K)
    gates = jax.nn.softmax(top_logit, axis=-1)
    n_assign = n_tok * TOP_K
    flat_e = top_e.reshape(n_assign).astype(jnp.int32)
    order = jnp.argsort(flat_e)
    sorted_e = flat_e[order]
    sorted_tok = (order // TOP_K).astype(jnp.int32)
    sorted_gate = gates.reshape(n_assign)[order]
    counts = jnp.bincount(flat_e, length=N_EXPERTS).astype(jnp.int32)
    padded = (counts + EXPERT_BLOCK - 1) // EXPERT_BLOCK * EXPERT_BLOCK
    pad_end = jnp.cumsum(padded)
    pad_start = pad_end - padded
    grp_start = jnp.cumsum(counts) - counts
    dest = pad_start[sorted_e] + jnp.arange(n_assign, dtype=jnp.int32) - grp_start[sorted_e]
    n_rows = n_assign + N_EXPERTS * EXPERT_BLOCK
    n_blocks = n_rows // EXPERT_BLOCK
    row_tok = jnp.full((n_rows,), n_tok, jnp.int32).at[dest].set(sorted_tok)
    row_gate = jnp.zeros((n_rows,), jnp.float32).at[dest].set(sorted_gate)
    block_start = jnp.arange(n_blocks, dtype=jnp.int32) * EXPERT_BLOCK
    block_e = jnp.minimum(jnp.searchsorted(pad_end, block_start, side='right'), N_EXPERTS - 1)
    hf_pad = jnp.concatenate([hf, jnp.zeros((1, d), hf.dtype)], axis=0)
    xs = hf_pad[row_tok].reshape(n_blocks, EXPERT_BLOCK, d)

    def expert_block(args):
        xb, e = args
        gu = xb @ w_gu[e] + b_gu[e]
        g, lin = jnp.split(gu, 2, axis=-1)
        g = jnp.minimum(g, SWIGLU_LIMIT)
        lin = jnp.clip(lin, -SWIGLU_LIMIT, SWIGLU_LIMIT)
        act = g * jax.nn.sigmoid(SWIGLU_ALPHA * g) * (lin + 1.0)
        return act @ w_down[e] + b_down[e]

    ys = lax.map(expert_block, (xs, block_e)).reshape(n_rows, d)
    ys = ys.astype(jnp.float32) * row_gate[:, None]
    out = jnp.zeros((n_tok + 1, d), jnp.float32).at[row_tok].add(ys)[:n_tok]
    return out.reshape(bsz, s, d).astype(h.dtype)


def setup_inputs(seed: int = 0) -> dict:
    key = jax.random.key(seed)
    ks = jax.random.split(key, 32)
    f32 = jnp.float32
    L = DEPTH

    def nrm(k, shape, scale):
        return jax.random.normal(k, shape, f32) * scale

    def gain(k, shape):
        return 1.0 + 0.1 * jax.random.normal(k, shape, f32)

    a0 = jax.random.uniform(ks[12], (L, D_LRU), f32, 0.9, 0.999)
    a_base = a0 ** (1.0 / LRU_C)
    lru_lambda = jnp.log(a_base) - jnp.log1p(-a_base)
    return {
        'x': nrm(ks[0], (BATCH, SEQ, D_MODEL), 1.0),
        'c': nrm(ks[1], (BATCH, D_MODEL), 1.0),
        'ada_w': nrm(ks[2], (L, D_MODEL, 6 * D_MODEL), 0.5 * D_MODEL ** -0.5),
        'ada_b': nrm(ks[3], (L, 6 * D_MODEL), 0.02),
        'norm1_g': gain(ks[4], (L, D_MODEL)),
        'w_in': nrm(ks[5], (L, D_MODEL, 2 * D_MIX), D_MODEL ** -0.5),
        'conv_w': nrm(ks[6], (L, CONV_WIDTH, D_LRU), CONV_WIDTH ** -0.5),
        'conv_b': nrm(ks[7], (L, D_LRU), 0.02),
        'lru_wr': nrm(ks[8], (L, LRU_HEADS, LRU_HEAD_DIM, LRU_HEAD_DIM), LRU_HEAD_DIM ** -0.5),
        'lru_br': nrm(ks[9], (L, D_LRU), 0.1),
        'lru_wi': nrm(ks[10], (L, LRU_HEADS, LRU_HEAD_DIM, LRU_HEAD_DIM), LRU_HEAD_DIM ** -0.5),
        'lru_bi': nrm(ks[11], (L, D_LRU), 0.1),
        'lru_lambda': lru_lambda,
        'sgu_ln_g': gain(ks[13], (L, D_SGU)),
        'sgu_ln_b': nrm(ks[14], (L, D_SGU), 0.02),
        'sgu_w': nrm(ks[15], (L, SGU_HEADS, CHUNK, CHUNK), 0.5 * CHUNK ** -0.5),
        'sgu_b': 1.0 + nrm(ks[16], (L, SGU_HEADS, CHUNK), 0.1),
        'gnorm_lru_g': gain(ks[17], (L, D_LRU)),
        'gnorm_sgu_g': gain(ks[18], (L, D_SGU)),
        'w_out': nrm(ks[19], (L, D_MIX, D_MODEL), D_MIX ** -0.5),
        'norm2_g': gain(ks[20], (L, D_MODEL)),
        'router_w': nrm(ks[21], (L, D_MODEL, N_EXPERTS), D_MODEL ** -0.5),
        'router_b': nrm(ks[22], (L, N_EXPERTS), 0.01),
        'exp_w_gu': nrm(ks[23], (L, N_EXPERTS, D_MODEL, 2 * D_EXPERT), D_MODEL ** -0.5),
        'exp_b_gu': nrm(ks[24], (L, N_EXPERTS, 2 * D_EXPERT), 0.02),
        'exp_w_down': nrm(ks[25], (L, N_EXPERTS, D_EXPERT, D_MODEL), D_EXPERT ** -0.5),
        'exp_b_down': nrm(ks[26], (L, N_EXPERTS, D_MODEL), 0.02),
        'final_g': gain(ks[27], (D_MODEL,)),
    }


def reference(x, c, ada_w, ada_b, norm1_g, w_in, conv_w, conv_b, lru_wr, lru_br, lru_wi, lru_bi,
              lru_lambda, sgu_ln_g, sgu_ln_b, sgu_w, sgu_b, gnorm_lru_g, gnorm_sgu_g, w_out,
              norm2_g, router_w, router_b, exp_w_gu, exp_b_gu, exp_w_down, exp_b_down, final_g):
    c_act = jax.nn.silu(c)
    h = x
    for l in range(DEPTH):
        mod = c_act @ ada_w[l] + ada_b[l]
        sh1, sc1, g1, sh2, sc2, g2 = jnp.split(mod[:, None, :], 6, axis=-1)
        z = rmsnorm(h, norm1_g[l]) * (1.0 + sc1) + sh1
        proj = z @ w_in[l]
        xa, ya, u, v = jnp.split(proj, [D_LRU, 2 * D_LRU, 2 * D_LRU + D_SGU], axis=-1)
        o_lru = rg_lru_group(xa, jax.nn.gelu(ya), conv_w[l], conv_b[l], lru_wr[l], lru_br[l],
                             lru_wi[l], lru_bi[l], lru_lambda[l])
        o_sgu = sgu_group(jax.nn.gelu(u), jax.nn.gelu(v), sgu_ln_g[l], sgu_ln_b[l], sgu_w[l], sgu_b[l])
        heads = jnp.concatenate([rmsnorm(o_lru, gnorm_lru_g[l]), rmsnorm(o_sgu, gnorm_sgu_g[l])], axis=-1)
        h = h + g1 * (heads @ w_out[l])
        z2 = rmsnorm(h, norm2_g[l]) * (1.0 + sc2) + sh2
        h = h + g2 * moe(z2, router_w[l], router_b[l], exp_w_gu[l], exp_b_gu[l], exp_w_down[l], exp_b_down[l])
    return rmsnorm(h, final_g)
```

```cpp
#include <hip/hip_runtime.h>
#include <cstdio>
#include <cstdint>

typedef unsigned short bf16;
constexpr int D = 1024, BATCH = 4, SEQ = 4096, NTOK = BATCH * SEQ, NPROJ = 2048, DL = 512, NH = 8, HD = 64, CHUNK = 128, NE = 32, TOPK = 4;
constexpr int NASSIGN = NTOK * TOPK;
constexpr float EPS = 1e-6f;

__device__ __forceinline__ unsigned f2bf(float f) { unsigned u = __builtin_bit_cast(unsigned, f); return (u + 0x7fffu + ((u >> 16) & 1u)) >> 16; }
__device__ __forceinline__ float bf2f(bf16 h) { return __builtin_bit_cast(float, (unsigned)h << 16); }
__device__ __forceinline__ float gelu_tanh(float x) { const float u = 1.5957691216057308f * (x + 0.044715f * x * x * x); return x / (1.f + __expf(-u)); }
__device__ __forceinline__ float sigmoidf_(float x) { return 1.f / (1.f + __expf(-x)); }

constexpr size_t MiB = 1u << 20;
constexpr size_t WS_CTL = 0;
constexpr size_t CTL_ZERO_BYTES = 20480;
constexpr size_t WS_MODP = 1 * MiB;
constexpr size_t WS_MOD = 3 * MiB;
constexpr size_t WS_AGG = 4 * MiB;
constexpr size_t WS_CNT = 5 * MiB;
constexpr size_t WS_TOPE = 6 * MiB;
constexpr size_t WS_GATE = 7 * MiB;
constexpr size_t WS_RANK = 8 * MiB;
constexpr size_t WS_POS = 9 * MiB;
constexpr size_t WS_GSORT = 10 * MiB;
constexpr size_t WS_TOKL = 11 * MiB;
constexpr size_t WS_STATS = 12 * MiB;
constexpr size_t WS_WRT = 13 * MiB;
constexpr size_t WS_WM = 14 * MiB;
constexpr size_t WS_Z = 16 * MiB;
constexpr size_t WS_HEADS = 48 * MiB;
constexpr size_t WS_PROJ = 80 * MiB;
constexpr size_t WS_ACT = 144 * MiB;
constexpr size_t WS_Y = 280 * MiB;
constexpr size_t WS_WINT = 416 * MiB;
constexpr size_t WS_WOUTT = 420 * MiB;
constexpr size_t WS_WGUT = 424 * MiB;
constexpr size_t WS_WDNT = 552 * MiB;
constexpr size_t WS_TOKE = 616 * MiB;
constexpr size_t WS_GATEE = 620 * MiB;
constexpr size_t WS_O32 = 752 * MiB;
constexpr size_t WS_XB = 784 * MiB;
constexpr size_t WS_END = 816 * MiB;
constexpr int CW_CNT = 0, CW_CUR = 64, CW_EBASE = 128;
constexpr int CW_BAR = 1024;

namespace pg8 {
#define PG8_LAS __attribute__((address_space(3)))
typedef unsigned short bf16_t;
typedef short bf16x8 __attribute__((ext_vector_type(8)));
typedef float f32x4 __attribute__((ext_vector_type(4)));
typedef unsigned u32x4 __attribute__((ext_vector_type(4)));
constexpr int BM = 256, BK = 64, HALF = 128, HTB = HALF * BK * 2, STAGE_BYTES = 8 * HTB, NXCD = 8, WGM = 8;
constexpr int ELIST = 16384;

__host__ __device__ __forceinline__ int lds_byte(int r, int c) { const int st = (r >> 4) * 2 + (c >> 5), rr = r & 15, cc = c & 31, ob = rr * 64 + cc * 2; return st * 1024 + (ob ^ (((ob >> 9) & 1) << 5)); }
__host__ __device__ __forceinline__ void stage_rc(int b, int& R, int& C) { const int st = b / 1024, sb = b % 1024, swz = sb ^ (((sb >> 9) & 1) << 5); R = (st >> 1) * 16 + swz / 64; C = (st & 1) * 32 + (swz % 64) / 2; }
__host__ __device__ __forceinline__ int perm32(int rho) { const int n = rho >> 4, i = rho & 15; return 8 * (i >> 2) + 4 * n + (i & 3); }

struct Unit { const char* A; const char* B; int row0, col0, nr, e, lrow0; };

struct DenseOrder {
    const char* A; const char* B; int nM, nN, nwg, G, c, pitch;
    __device__ __forceinline__ void init(const void* A_, const void* B_, int M, int N, int pitch_, int G_, int c_) { A = (const char*)A_; B = (const char*)B_; nM = M / BM; nN = N / BM; nwg = nM * nN; G = G_; c = c_; pitch = pitch_; }
    __device__ __forceinline__ bool next(int i, Unit& u) const {
        const long L = (long)i * G + c; if (L >= nwg) return false;
        int wgid = (int)L; { const int q = nwg / NXCD, r = nwg % NXCD, xcd = wgid % NXCD, off = wgid / NXCD; wgid = (xcd < r ? xcd * (q + 1) : r * (q + 1) + (xcd - r) * q) + off; }
        const int nig = WGM * nN, gid = wgid / nig, fm = gid * WGM, gsz = (nM - fm) < WGM ? (nM - fm) : WGM;
        const int pm = fm + ((wgid % nig) % gsz), pn = (wgid % nig) / gsz;
        u.A = A + (size_t)pm * BM * pitch; u.B = B + (size_t)pn * BM * pitch; u.row0 = pm * BM; u.col0 = pn * BM; u.nr = BM; u.e = 0; u.lrow0 = 0; return true;
    }
};
struct MoeOrder {
    const char* A; const char* B; const PG8_LAS int* tpre; const PG8_LAS int* ebase; int NPN, nU, G, c, pitch, N;
    __device__ __forceinline__ void init(const void* A_, const void* B_, const PG8_LAS int* tpre_, const PG8_LAS int* ebase_, int N_, int pitch_, int G_, int c_) {
        A = (const char*)A_; B = (const char*)B_; tpre = tpre_; ebase = ebase_; N = N_; NPN = N_ / BM; pitch = pitch_; G = G_; c = c_; nU = __builtin_amdgcn_readfirstlane(tpre_[32]) * NPN; }
    __device__ __forceinline__ bool next(int i, Unit& u) const {
        const long L = (long)i * G + c; if (L >= nU) return false;
        int wgid = (int)L; { const int q = nU / NXCD, r = nU % NXCD, xcd = wgid % NXCD, off = wgid / NXCD; wgid = (xcd < r ? xcd * (q + 1) : r * (q + 1) + (xcd - r) * q) + off; }
        const int ln = threadIdx.x & 31; const unsigned long long bal = __ballot(tpre[ln + 1] * NPN <= wgid);
        int e = __builtin_popcount((unsigned)bal); e = e > 31 ? 31 : e;
        const int tp0 = __builtin_amdgcn_readfirstlane(tpre[e]), tp1 = __builtin_amdgcn_readfirstlane(tpre[e + 1]);
        const int q2 = wgid - tp0 * NPN, nt = tp1 - tp0, pn = q2 / nt, mt = q2 - pn * nt;
        const int eb = __builtin_amdgcn_readfirstlane(ebase[e]), cnt = __builtin_amdgcn_readfirstlane(ebase[e + 1]) - eb;
        u.row0 = eb + BM * mt; u.nr = min(BM, cnt - BM * mt); u.col0 = pn * BM; u.e = e; u.lrow0 = e * ELIST + BM * mt;
        u.A = A + (size_t)u.row0 * pitch; u.B = B + ((size_t)e * N + (size_t)pn * BM) * pitch; return true;
    }
};

__device__ __forceinline__ unsigned cvt_pk_bf16(float lo, float hi) { unsigned r; asm volatile("v_cvt_pk_bf16_f32 %0, %1, %2" : "=v"(r) : "v"(lo), "v"(hi)); return r; }
__device__ __forceinline__ float gelu_fast(float x) { const float u = x * (1.5957691216f + 0.0713548163f * x * x); return x * __builtin_amdgcn_rcpf(1.f + __builtin_amdgcn_exp2f(-1.4426950409f * u)); }
__device__ __forceinline__ f32x4 gelu4(const f32x4 x) {
    const f32x4 t = x * (x * x * (-0.0713548163f * 1.4426950409f) + (-1.5957691216f * 1.4426950409f)); f32x4 d;
#pragma unroll
    for (int q = 0; q < 4; ++q) d[q] = __builtin_amdgcn_rcpf(1.f + __builtin_amdgcn_exp2f(t[q]));
    return x * d;
}
__device__ __forceinline__ float sigm_fast(float x) { return __builtin_amdgcn_rcpf(1.f + __builtin_amdgcn_exp2f(-1.4426950409f * x)); }

struct EpiInProj {
    static constexpr bool PERM = true; bf16_t* O;
    __device__ __forceinline__ void prefetch(const Unit&, int, int) const {}
    __device__ __forceinline__ void operator()(const f32x4 (&acc)[2][2][4][2], const Unit& u, int wr, int wc, int fr, int fq) const {
        const int row0 = u.row0 + wr * 64 + fr, col0 = u.col0 + wc * 32 + 8 * fq; const bool act = u.col0 >= 512;
#pragma unroll
        for (int ai = 0; ai < 2; ++ai)
#pragma unroll
            for (int m = 0; m < 4; ++m) { bf16_t* rowp = O + (size_t)(row0 + ai * HALF + m * 16) * NPROJ + col0;
#pragma unroll
                for (int bj = 0; bj < 2; ++bj) { f32x4 v0 = acc[ai][bj][m][0], v1 = acc[ai][bj][m][1];
                    if (act) { v0 = gelu4(v0); v1 = gelu4(v1); }
                    u32x4 w; w.x = cvt_pk_bf16(v0[0], v0[1]); w.y = cvt_pk_bf16(v0[2], v0[3]); w.z = cvt_pk_bf16(v1[0], v1[1]); w.w = cvt_pk_bf16(v1[2], v1[3]);
                    *(u32x4*)(rowp + bj * HALF) = w; } }
    }
};
struct EpiOutProj {
    static constexpr bool PERM = true; const float* mod; const bf16_t* XB; bf16_t* O;
    __device__ __forceinline__ void prefetch(const Unit&, int, int) const {}
    __device__ __forceinline__ void operator()(const f32x4 (&acc)[2][2][4][2], const Unit& u, int wr, int wc, int fr, int fq) const {
        const int row0 = u.row0 + wr * 64 + fr, col0 = u.col0 + wc * 32 + 8 * fq; const int b = u.row0 / SEQ;
        f32x4 g[2][2];
#pragma unroll
        for (int bj = 0; bj < 2; ++bj)
#pragma unroll
            for (int n = 0; n < 2; ++n) g[bj][n] = *(const f32x4*)(mod + b * 6144 + 2048 + col0 + bj * HALF + 4 * n);
#pragma unroll
        for (int ai = 0; ai < 2; ++ai) {
            u32x4 xr[4][2];
#pragma unroll
            for (int m = 0; m < 4; ++m)
#pragma unroll
                for (int bj = 0; bj < 2; ++bj) xr[m][bj] = __builtin_nontemporal_load((const u32x4*)(XB + (size_t)(row0 + ai * HALF + m * 16) * D + col0 + bj * HALF));
#pragma unroll
            for (int m = 0; m < 4; ++m) { bf16_t* rowp = O + (size_t)(row0 + ai * HALF + m * 16) * D + col0;
#pragma unroll
                for (int bj = 0; bj < 2; ++bj) { const u32x4 xw = xr[m][bj]; f32x4 v0 = acc[ai][bj][m][0] * g[bj][0], v1 = acc[ai][bj][m][1] * g[bj][1];
                    v0[0] += __builtin_bit_cast(float, xw.x << 16); v0[1] += __builtin_bit_cast(float, xw.x & 0xffff0000u); v0[2] += __builtin_bit_cast(float, xw.y << 16); v0[3] += __builtin_bit_cast(float, xw.y & 0xffff0000u);
                    v1[0] += __builtin_bit_cast(float, xw.z << 16); v1[1] += __builtin_bit_cast(float, xw.z & 0xffff0000u); v1[2] += __builtin_bit_cast(float, xw.w << 16); v1[3] += __builtin_bit_cast(float, xw.w & 0xffff0000u);
                    u32x4 w; w.x = cvt_pk_bf16(v0[0], v0[1]); w.y = cvt_pk_bf16(v0[2], v0[3]); w.z = cvt_pk_bf16(v1[0], v1[1]); w.w = cvt_pk_bf16(v1[2], v1[3]);
                    *(u32x4*)(rowp + bj * HALF) = w; } }
            asm volatile("" ::: "memory"); }
    }
};
__device__ __forceinline__ unsigned pk4_fp8(float a, float b, float c, float d) { int w = 0; w = __builtin_amdgcn_cvt_pk_fp8_f32(a, b, w, false); w = __builtin_amdgcn_cvt_pk_fp8_f32(c, d, w, true); return (unsigned)w; }
constexpr float W8_SCALE = 64.f, A8_SCALE = 4.f;
typedef unsigned u32x2 __attribute__((ext_vector_type(2)));
__device__ __forceinline__ u32x4 pair16(const u32x2 wA, const u32x2 wB, const bool) {
    const auto r0 = __builtin_amdgcn_permlane16_swap(wA.x, wB.x, false, false), r1 = __builtin_amdgcn_permlane16_swap(wA.y, wB.y, false, false);
    return (u32x4){(unsigned)r0[0], (unsigned)r1[0], (unsigned)r0[1], (unsigned)r1[1]};
}
struct EpiSwiglu {
    static constexpr bool PERM = true; const float* bgu; unsigned char* ACT; PG8_LAS unsigned char* epl;
    __device__ __forceinline__ void prefetch(const Unit& u, int wid, int lane) const {
        if (wid == 0) { const float* src = bgu + u.e * 2048 + (lane >= 32 ? 1024 : 0) + (u.col0 >> 1) + 4 * (lane & 31);
            __builtin_amdgcn_global_load_lds((const unsigned*)src, (PG8_LAS unsigned*)epl, 16, 0, 0); }
    }
    __device__ __forceinline__ void operator()(const f32x4 (&acc)[2][2][4][2], const Unit& u, int wr, int wc, int fr, int fq) const {
        asm volatile("" : "+v"(fr), "+v"(fq));
        const int jl = wc * 32 + 8 * fq, j0 = (u.col0 >> 1) + jl; const bool odd = (fq & 1) != 0;
        f32x4 bg[2], bl[2];
#pragma unroll
        for (int n = 0; n < 2; ++n) { bg[n] = *(const PG8_LAS f32x4*)(epl + (jl + 4 * n) * 4); bl[n] = *(const PG8_LAS f32x4*)(epl + 512 + (jl + 4 * n) * 4); }
#pragma unroll
        for (int ai = 0; ai < 2; ++ai)
#pragma unroll
            for (int mp = 0; mp < 2; ++mp) { u32x2 w2[2];
#pragma unroll
                for (int h = 0; h < 2; ++h) { const int m = 2 * mp + h; f32x4 o[2];
#pragma unroll
                    for (int n = 0; n < 2; ++n) { const f32x4 g = __builtin_elementwise_min(acc[ai][0][m][n] * (1.f / W8_SCALE) + bg[n], (f32x4){7.f, 7.f, 7.f, 7.f});
                        const f32x4 l = __builtin_elementwise_min(__builtin_elementwise_max(acc[ai][1][m][n] * (1.f / W8_SCALE) + bl[n], (f32x4){-7.f, -7.f, -7.f, -7.f}), (f32x4){7.f, 7.f, 7.f, 7.f});
                        const f32x4 ex = g * (-1.702f * 1.4426950409f); f32x4 den;
#pragma unroll
                        for (int q = 0; q < 4; ++q) den[q] = __builtin_amdgcn_rcpf(1.f + __builtin_amdgcn_exp2f(ex[q]));
                        o[n] = (g * A8_SCALE) * den * (l + 1.f); }
                    w2[h].x = pk4_fp8(o[0][0], o[0][1], o[0][2], o[0][3]); w2[h].y = pk4_fp8(o[1][0], o[1][1], o[1][2], o[1][3]); }
                const u32x4 o16 = pair16(w2[0], w2[1], odd);
                const int r = ai * HALF + wr * 64 + (2 * mp + (odd ? 1 : 0)) * 16 + fr;
                if (r < u.nr) *(u32x4*)(ACT + (size_t)(u.row0 + r) * D + j0 - (odd ? 8 : 0)) = o16; }
    }
};
constexpr float Y8_SCALE = 8.f;
struct EpiDown {
    static constexpr bool PERM = true; const float* bd; const float* gs; unsigned char* Y; PG8_LAS unsigned char* epl;
    __device__ __forceinline__ void prefetch(const Unit& u, int wid, int lane) const {
        if (wid == 0) __builtin_amdgcn_global_load_lds((const unsigned*)(bd + u.e * D + u.col0 + 4 * lane), (PG8_LAS unsigned*)epl, 16, 0, 0);
        if (wid == 1) __builtin_amdgcn_global_load_lds((const unsigned*)(gs + u.lrow0 + 4 * lane), (PG8_LAS unsigned*)(epl + 1024), 16, 0, 0);
    }
    __device__ __forceinline__ void operator()(const f32x4 (&acc)[2][2][4][2], const Unit& u, int wr, int wc, int fr, int fq) const {
        asm volatile("" : "+v"(fr), "+v"(fq));
        const int cl = wc * 32 + 8 * fq, col0 = u.col0 + cl; const bool odd = (fq & 1) != 0;
        f32x4 bv[2][2];
#pragma unroll
        for (int bj = 0; bj < 2; ++bj)
#pragma unroll
            for (int n = 0; n < 2; ++n) bv[bj][n] = *(const PG8_LAS f32x4*)(epl + (cl + bj * HALF + 4 * n) * 4);
#pragma unroll
        for (int ai = 0; ai < 2; ++ai)
#pragma unroll
            for (int mp = 0; mp < 2; ++mp) { const int rb = ai * HALF + wr * 64 + 2 * mp * 16 + fr;
                const float gA = *(const PG8_LAS float*)(epl + 1024 + rb * 4) * Y8_SCALE, gB = *(const PG8_LAS float*)(epl + 1024 + (rb + 16) * 4) * Y8_SCALE;
                const int r = rb + (odd ? 16 : 0); unsigned char* rowp = Y + (size_t)(u.row0 + r) * D + col0 - (odd ? 8 : 0);
#pragma unroll
                for (int bj = 0; bj < 2; ++bj) { u32x2 w2[2];
#pragma unroll
                    for (int h = 0; h < 2; ++h) { const int m = 2 * mp + h; const float gt = h ? gB : gA;
                        const f32x4 v0 = (acc[ai][bj][m][0] * (1.f / (W8_SCALE * A8_SCALE)) + bv[bj][0]) * gt, v1 = (acc[ai][bj][m][1] * (1.f / (W8_SCALE * A8_SCALE)) + bv[bj][1]) * gt;
                        w2[h].x = pk4_fp8(v0[0], v0[1], v0[2], v0[3]); w2[h].y = pk4_fp8(v1[0], v1[1], v1[2], v1[3]); }
                    const u32x4 o16 = pair16(w2[0], w2[1], odd);
                    if (r < u.nr) *(u32x4*)(rowp + bj * HALF) = o16; } }
    }
};

typedef int v4i_t __attribute__((ext_vector_type(4)));
typedef int v8i_t __attribute__((ext_vector_type(8)));
struct GatherA { const char* base; const int* tokl; PG8_LAS unsigned* rt; };
template <class Epi, class Sched, bool ALIGN_EPI, bool FP8 = false, bool GATHER = false>
__device__ __forceinline__ void gemm_phase(PG8_LAS unsigned char* lds, const int pitch, const Sched& S, const Epi& E, const GatherA ga = GatherA{nullptr, nullptr, nullptr}) {
    const int tid = threadIdx.x, wid = __builtin_amdgcn_readfirstlane(tid >> 6), lane = tid & 63, wr = wid >> 2, wc = wid & 3, fr = lane & 15, fq = lane >> 4;
    const int nt = pitch / (BK * 2);
    unsigned voffA[2], voffB[2];
#pragma unroll
    for (int i = 0; i < 2; ++i) { int R, C; stage_rc(tid * 16 + i * 8192, R, C); const int Rb = Epi::PERM ? ((R & ~31) + perm32(R & 31)) : R;
        voffA[i] = GATHER ? (unsigned)(R * 65536 + C * 2) : (unsigned)(R * pitch + C * 2); voffB[i] = (unsigned)(Rb * pitch + C * 2); }
    const size_t kstep = (size_t)(BK * 2);
    const size_t hstep = (size_t)HALF * pitch;
    const unsigned ldsw = (unsigned)wid * 1024u;
    const int aoff = lds_byte(wr * 64 + fr, fq * 8), boff = lds_byte(wc * 32 + fr, fq * 8);
#define PG8_SA(b, h) (((b) * 2 + (h)) * HTB)
#define PG8_SB(b, h) ((4 + (b) * 2 + (h)) * HTB)
#define PG8_STAGE(bufoff, gbase, voff) do { _Pragma("unroll") for (int _i = 0; _i < 2; ++_i) \
        __builtin_amdgcn_global_load_lds((const unsigned*)((const char*)(gbase) + (voff)[_i]), (PG8_LAS unsigned*)(lds + (bufoff) + ldsw + _i * 8192), 16, 0, 0); } while (0)
#define PG8_STAGE_A(bufoff, gbase, par, half, kt) do { if constexpr (GATHER) { _Pragma("unroll") for (int _i = 0; _i < 2; ++_i) { const unsigned _tk = min(ga.rt[(par) * 256 + (half) * 128 + (voffA[_i] >> 16)], (unsigned)(NTOK - 1)); \
            __builtin_amdgcn_global_load_lds((const unsigned*)(ga.base + (size_t)_tk * pitch + (voffA[_i] & 0xffffu) + (kt) * (BK * 2)), (PG8_LAS unsigned*)(lds + (bufoff) + ldsw + _i * 8192), 16, 0, 0); } } \
        else PG8_STAGE(bufoff, gbase, voffA); } while (0)
#define PG8_GA_LOAD(par, row0_) do { if constexpr (GATHER) { if (wid == 2) __builtin_amdgcn_global_load_lds((const unsigned*)(ga.tokl + (row0_) + 4 * lane), (PG8_LAS unsigned*)(ga.rt + (par) * 256), 16, 0, 0); } } while (0)
#define PG8_CAT8(x0, x1) __builtin_shufflevector(x0, x1, 0, 1, 2, 3, 4, 5, 6, 7)
#define PG8_LDA(dst, b, h) do { if constexpr (FP8) { _Pragma("unroll") for (int m = 0; m < 4; ++m) { const v4i_t x0 = *(const PG8_LAS v4i_t*)(lds + PG8_SA(b, h) + aoff + m * 2048), x1 = *(const PG8_LAS v4i_t*)(lds + PG8_SA(b, h) + aoff + m * 2048 + 1024); dst##8[m] = PG8_CAT8(x0, x1); } } \
    else { _Pragma("unroll") for (int m = 0; m < 4; ++m) _Pragma("unroll") for (int k = 0; k < 2; ++k) dst[m][k] = *(const PG8_LAS bf16x8*)(lds + PG8_SA(b, h) + aoff + m * 2048 + k * 1024); } } while (0)
#define PG8_LDB(dst, b, h) do { if constexpr (FP8) { _Pragma("unroll") for (int n = 0; n < 2; ++n) { const v4i_t x0 = *(const PG8_LAS v4i_t*)(lds + PG8_SB(b, h) + boff + n * 2048), x1 = *(const PG8_LAS v4i_t*)(lds + PG8_SB(b, h) + boff + n * 2048 + 1024); dst##8[n] = PG8_CAT8(x0, x1); } } \
    else { _Pragma("unroll") for (int n = 0; n < 2; ++n) _Pragma("unroll") for (int k = 0; k < 2; ++k) dst[n][k] = *(const PG8_LAS bf16x8*)(lds + PG8_SB(b, h) + boff + n * 2048 + k * 1024); } } while (0)
#define PG8_MMA(ai, bj, At, Bt) do { __builtin_amdgcn_s_setprio(1); _Pragma("unroll") for (int m = 0; m < 4; ++m) _Pragma("unroll") for (int n = 0; n < 2; ++n) { \
        if constexpr (FP8) { asm volatile("v_mfma_f32_16x16x128_f8f6f4 %0, %1, %2, %0" : "+v"(acc[ai][bj][m][n]) : "v"(Bt##8[n]), "v"(At##8[m])); } \
        else { _Pragma("unroll") for (int k = 0; k < 2; ++k) acc[ai][bj][m][n] = __builtin_amdgcn_mfma_f32_16x16x32_bf16(Bt[n][k], At[m][k], acc[ai][bj][m][n], 0, 0, 0); } } \
        __builtin_amdgcn_s_setprio(0); } while (0)
#define PG8_WAIT_V(n) asm volatile("s_waitcnt vmcnt(" #n ")" ::: "memory")
#define PG8_WAIT_L(n) asm volatile("s_waitcnt lgkmcnt(" #n ")" ::: "memory")
#define PG8_BAR __builtin_amdgcn_s_barrier()
#define PG8_SCHED __builtin_amdgcn_sched_barrier(0)
    Unit cur, nxt; int ui = 0;
    if (!S.next(0, cur)) return;
    f32x4 acc[2][2][4][2];
#pragma unroll
    for (int a = 0; a < 2; ++a)
#pragma unroll
        for (int b = 0; b < 2; ++b)
#pragma unroll
            for (int m = 0; m < 4; ++m)
#pragma unroll
                for (int n = 0; n < 2; ++n) acc[a][b][m][n] = (f32x4){0.f, 0.f, 0.f, 0.f};
    bf16x8 At[4][2], B0[2][2], B1[2][2]; v8i_t At8[4], B08[2], B18[2];
    const char* cA = cur.A; const char* cB = cur.B;
    if constexpr (GATHER) { PG8_GA_LOAD(0, cur.lrow0); PG8_WAIT_V(0); PG8_BAR; }
    PG8_STAGE(PG8_SB(0, 0), cB, voffB); PG8_STAGE(PG8_SB(0, 1), cB + hstep, voffB); PG8_STAGE_A(PG8_SA(0, 0), cA, 0, 0, 0); PG8_STAGE_A(PG8_SA(0, 1), cA + hstep, 0, 1, 0);
    if (wr == 1) PG8_BAR;
    PG8_WAIT_V(2); PG8_BAR;
    PG8_STAGE(PG8_SB(1, 0), cB + kstep, voffB); PG8_STAGE_A(PG8_SA(1, 0), cA + kstep, 0, 0, 1); PG8_STAGE(PG8_SB(1, 1), cB + hstep + kstep, voffB);
    PG8_WAIT_V(6); PG8_BAR;
    for (;;) {
        bool has_next = false; const char* nA = cA; const char* nB = cB;
        for (int t = 0; t < nt; t += 2) {
            const bool last = (t == nt - 2);
            if (t == 2) {
                has_next = S.next(ui + 1, nxt); nA = has_next ? nxt.A : cA; nB = has_next ? nxt.B : cB;
                if (GATHER && has_next) { PG8_GA_LOAD((ui & 1) ^ 1, nxt.lrow0); PG8_SCHED; } }
            const char* a1 = cA + (size_t)(t + 1) * kstep;
            const char* a2 = last ? nA : cA + (size_t)(t + 2) * kstep; const char* b2 = last ? nB : cB + (size_t)(t + 2) * kstep;
            const char* a3 = a2 + kstep; const char* b3 = b2 + kstep;
            const int pc = ui & 1, p2 = (last && has_next) ? (pc ^ 1) : pc, k2 = last ? 0 : t + 2;
            if (last) { E.prefetch(cur, wid, lane); PG8_SCHED; }
            PG8_LDB(B0, 0, 0); PG8_LDB(B1, 0, 1); PG8_SCHED; PG8_LDA(At, 0, 0); PG8_STAGE_A(PG8_SA(1, 1), a1 + hstep, pc, 1, t + 1);
            PG8_WAIT_V(8); PG8_WAIT_L(0); PG8_BAR; PG8_MMA(0, 0, At, B0); PG8_MMA(0, 1, At, B1); PG8_BAR; PG8_SCHED;
            PG8_LDA(At, 0, 1); PG8_STAGE(PG8_SB(0, 0), b2, voffB); PG8_STAGE(PG8_SB(0, 1), b2 + hstep, voffB); PG8_STAGE_A(PG8_SA(0, 0), a2, p2, 0, k2);
            PG8_WAIT_V(8); PG8_WAIT_L(0); PG8_BAR; PG8_MMA(1, 0, At, B0); PG8_MMA(1, 1, At, B1); PG8_BAR; PG8_SCHED;
            PG8_LDB(B0, 1, 0); PG8_LDB(B1, 1, 1); PG8_SCHED; PG8_LDA(At, 1, 0); PG8_STAGE_A(PG8_SA(0, 1), a2 + hstep, p2, 1, k2);
            PG8_WAIT_V(8); PG8_WAIT_L(0); PG8_BAR; PG8_MMA(0, 0, At, B0); PG8_MMA(0, 1, At, B1); PG8_BAR; PG8_SCHED;
            PG8_LDA(At, 1, 1); PG8_STAGE(PG8_SB(1, 0), b3, voffB); PG8_STAGE(PG8_SB(1, 1), b3 + hstep, voffB); PG8_STAGE_A(PG8_SA(1, 0), a3, p2, 0, k2 + 1);
            PG8_WAIT_V(8); PG8_WAIT_L(0); PG8_BAR; PG8_MMA(1, 0, At, B0); PG8_MMA(1, 1, At, B1); PG8_BAR; PG8_SCHED;
        }
        if constexpr (ALIGN_EPI) { if (wr == 0) PG8_BAR; }
        if constexpr (FP8) asm volatile("s_nop 15\n\ts_nop 15" ::: "memory");
        E(acc, cur, wr, wc, fr, fq);
        if (!has_next) break;
#pragma unroll
        for (int a = 0; a < 2; ++a)
#pragma unroll
            for (int b = 0; b < 2; ++b)
#pragma unroll
                for (int m = 0; m < 4; ++m)
#pragma unroll
                    for (int n = 0; n < 2; ++n) acc[a][b][m][n] = (f32x4){0.f, 0.f, 0.f, 0.f};
        cur = nxt; cA = nA; cB = nB; ++ui;
        if constexpr (ALIGN_EPI) { if (wr == 1) PG8_BAR; }
    }
    PG8_WAIT_V(0);
    if constexpr (!ALIGN_EPI) { if (wr == 0) PG8_BAR; }
    PG8_BAR;
#undef PG8_SA
#undef PG8_SB
#undef PG8_STAGE
#undef PG8_STAGE_A
#undef PG8_GA_LOAD
#undef PG8_LDA
#undef PG8_LDB
#undef PG8_MMA
#undef PG8_CAT8
#undef PG8_WAIT_V
#undef PG8_WAIT_L
#undef PG8_BAR
#undef PG8_SCHED
}
}

constexpr int RING_OFF = 0, RING_BYTES = 131072;
constexpr int MISC_OFF = 143360, TBL_OFF = MISC_OFF + 256, EPI_OFF = MISC_OFF + 1024;
constexpr int _unused_tbl = 0;
constexpr int RT_OFF = 146432;
constexpr int LDS_BYTES = 151552;
constexpr int NWAVES = 8;

#define GAS __attribute__((address_space(1)))
#define LAS __attribute__((address_space(3)))
typedef unsigned v4u __attribute__((ext_vector_type(4)));
typedef unsigned v2u __attribute__((ext_vector_type(2)));
typedef float f32x4 __attribute__((ext_vector_type(4)));
typedef short bf16x8 __attribute__((ext_vector_type(8)));
typedef short bf16x4 __attribute__((ext_vector_type(4)));
typedef GAS unsigned gu32;
#define RLX_AGENT __ATOMIC_RELAXED, __HIP_MEMORY_SCOPE_AGENT
#define LDS_WAIT() asm volatile("s_waitcnt lgkmcnt(0)" ::: "memory")
#define VM_WAIT() asm volatile("s_waitcnt vmcnt(0)" ::: "memory")
__device__ __forceinline__ unsigned pk2(float lo, float hi) { unsigned r; asm("v_cvt_pk_bf16_f32 %0, %1, %2" : "=v"(r) : "v"(lo), "v"(hi)); return r; }
__device__ __forceinline__ bf16 f2bf1(float x) { return (bf16)(pk2(x, x) & 0xffffu); }
__device__ __forceinline__ float bflo(unsigned w) { return __builtin_bit_cast(float, w << 16); }
__device__ __forceinline__ float bfhi(unsigned w) { return __builtin_bit_cast(float, w & 0xffff0000u); }

#define XB_TMO      128
#define XB_XCNT(j)  (256  + 64 * (j))
#define XB_XSUB(j)  (1280 + 64 * (j))
#define XB_XGEN(j)  (2304 + 64 * (j))
#define XB_TOP      3328
#define XB_TOPGEN   3392
#define XCD_BAR_WORDS 3456
#define XB_SPIN_CAP (1u << 18)
__device__ __forceinline__ unsigned xb_ld(unsigned* p)              { return __hip_atomic_load(p, __ATOMIC_RELAXED, __HIP_MEMORY_SCOPE_AGENT); }
__device__ __forceinline__ unsigned xb_add(unsigned* p, unsigned v) { return __hip_atomic_fetch_add(p, v, __ATOMIC_RELAXED, __HIP_MEMORY_SCOPE_AGENT); }
__device__ __forceinline__ unsigned xb_xcc_id() { return (unsigned)__builtin_amdgcn_s_getreg((3 << 11) | 20) & 0xFu; }
#define XB_SPIN(cond, bar) do { unsigned _sp = 0; while (cond) { __builtin_amdgcn_s_sleep(1); \
    if ((++_sp & 255u) == 0u) { if (xb_ld(&(bar)[XB_TMO])) break; if (_sp > XB_SPIN_CAP) { atomicAdd(&(bar)[XB_TMO], 1u); break; } } } } while (0)
struct XcdBarrier { unsigned* bar; unsigned x; volatile LAS unsigned* st; };
__device__ __forceinline__ XcdBarrier xcd_barrier_post(unsigned* bar, volatile LAS unsigned* st) {
    XcdBarrier b; b.bar = bar; b.x = xb_xcc_id(); b.st = st;
    if (threadIdx.x == 0) (void)xb_add(&bar[XB_XCNT(b.x)], 1u);
    return b;
}
__device__ __forceinline__ void xcd_barrier_complete(unsigned* bar, unsigned x, unsigned& nloc, unsigned& nx) {
    const unsigned G = gridDim.x * gridDim.y * gridDim.z;
    unsigned sum, cnt, mine, sp = 0u;
    for (;;) {
        sum = 0u; cnt = 0u; mine = 0u;
#pragma unroll
        for (unsigned j = 0; j < 16; ++j) { const unsigned c = xb_ld(&bar[XB_XCNT(j)]); sum += c; cnt += (c > 0u) ? 1u : 0u; mine = (j == x) ? c : mine; }
        if (sum == G) break;
        __builtin_amdgcn_s_sleep(1);
        if ((++sp & 255u) == 0u) { if (xb_ld(&bar[XB_TMO])) break; if (sp > XB_SPIN_CAP) { atomicAdd(&bar[XB_TMO], 1u); break; } }
    }
    nloc = mine > 0u ? mine : 1u; nx = cnt > 0u ? cnt : 1u;
}
__device__ __attribute__((noinline)) void xcd_barrier(unsigned* bar_, unsigned x_, volatile LAS unsigned* st_) {
    XcdBarrier b; b.bar = bar_; b.x = x_; b.st = st_;
    asm volatile("s_waitcnt vmcnt(0)" ::: "memory");
    __syncthreads();
    if (threadIdx.x == 0) {
        unsigned* bar = b.bar;
        __builtin_amdgcn_s_waitcnt(0);
        unsigned nloc = b.st[0], nx = b.st[1];
        if (nloc == 0u) { xcd_barrier_complete(bar, b.x, nloc, nx); b.st[0] = nloc; b.st[1] = nx; }
        const unsigned old = xb_add(&bar[XB_XSUB(b.x)], 1u);
        const unsigned gen = old / nloc;
        if (old + 1u == (gen + 1u) * nloc) {
            __builtin_amdgcn_fence(__ATOMIC_RELEASE, "agent");
            asm volatile("s_waitcnt vmcnt(0)" ::: "memory");
            const unsigned og = xb_add(&bar[XB_TOP], 1u);
            const unsigned tg = og / nx;
            if (og + 1u == (tg + 1u) * nx) xb_add(&bar[XB_TOPGEN], 1u);
            else XB_SPIN(xb_ld(&bar[XB_TOPGEN]) == tg, bar);
            __builtin_amdgcn_fence(__ATOMIC_ACQUIRE, "agent");
            xb_add(&bar[XB_XGEN(b.x)], 1u);
            asm volatile("s_waitcnt vmcnt(0)" ::: "memory");
        } else {
            XB_SPIN(xb_ld(&bar[XB_XGEN(b.x)]) == gen, bar);
            __builtin_amdgcn_fence(__ATOMIC_ACQUIRE, "agent");
            asm volatile("s_waitcnt vmcnt(0)" ::: "memory");
        }
    }
    __syncthreads();
}

struct Args { const float* in[28]; float* out; unsigned char* ws; int ph_lo, ph_hi, li, pad; };
enum { I_X = 0, I_C, I_ADAW, I_ADAB, I_N1G, I_WIN, I_CONVW, I_CONVB, I_WR, I_BR, I_WI, I_BI, I_LAM, I_LNG, I_LNB, I_SGUW, I_SGUB, I_GNL, I_GNS, I_WOUT, I_N2G, I_RW, I_RB, I_WGU, I_BGU, I_WDN, I_BDN, I_FG };
constexpr int NPH = 11;

template <int CTRL> __device__ __forceinline__ float dppf(float v) { return __builtin_bit_cast(float, __builtin_amdgcn_update_dpp(0, __builtin_bit_cast(int, v), CTRL, 0xF, 0xF, true)); }
__device__ __forceinline__ float xor16f(float v, float& own) { const unsigned a = __builtin_bit_cast(unsigned, v); const auto r = __builtin_amdgcn_permlane16_swap(a, a, false, false); own = __builtin_bit_cast(float, (unsigned)r[0]); return __builtin_bit_cast(float, (unsigned)r[1]); }
__device__ __forceinline__ float xor32f(float v, float& own) { const unsigned a = __builtin_bit_cast(unsigned, v); const auto r = __builtin_amdgcn_permlane32_swap(a, a, false, false); own = __builtin_bit_cast(float, (unsigned)r[0]); return __builtin_bit_cast(float, (unsigned)r[1]); }
__device__ __forceinline__ float sum32(float v) {
    v += dppf<0xB1>(v); v += dppf<0x4E>(v); v += dppf<0x141>(v); v += dppf<0x140>(v); float o; const float p = xor16f(v, o); return o + p; }
__device__ __forceinline__ float max32(float v) {
    v = fmaxf(v, dppf<0xB1>(v)); v = fmaxf(v, dppf<0x4E>(v)); v = fmaxf(v, dppf<0x141>(v)); v = fmaxf(v, dppf<0x140>(v)); float o; const float p = xor16f(v, o); return fmaxf(o, p); }
__device__ __forceinline__ float wave_sum(float v) { v = sum32(v); float o; const float p = xor32f(v, o); return o + p; }

struct P0Item { const float* src; size_t step; unsigned char* dst; const float* ksc; int k0, kind; };
__device__ __forceinline__ void p0_load(f32x4 (&v)[16], const P0Item& it) {
#pragma unroll
    for (int i = 0; i < 16; ++i) v[i] = __builtin_nontemporal_load((const f32x4*)(it.src + (size_t)i * it.step));
}
__device__ __forceinline__ void p0_process(const f32x4 (&v)[16], const P0Item& it, LAS float* scr, int lane) {
    if (it.kind == 0) {
#pragma unroll
        for (int i = 0; i < 16; ++i) { const int kk = 4 * i + (lane >> 4); f32x4 w = v[i];
            if (it.ksc) w = w * it.ksc[it.k0 + kk];
            LAS float* d = scr + kk * 65 + 4 * (lane & 15); d[0] = w.x; d[1] = w.y; d[2] = w.z; d[3] = w.w; }
        LDS_WAIT();
        const int c = lane & 7;
#pragma unroll
        for (int j = 0; j < 8; ++j) { const int n = (lane >> 3) + 8 * j; const LAS float* s = scr + (8 * c) * 65 + n;
            v4u o; o.x = pk2(s[0 * 65], s[1 * 65]); o.y = pk2(s[2 * 65], s[3 * 65]); o.z = pk2(s[4 * 65], s[5 * 65]); o.w = pk2(s[6 * 65], s[7 * 65]);
            *(v4u*)(it.dst + ((size_t)n * D + it.k0 + 8 * c) * 2) = o; }
        LDS_WAIT();
    } else {
#pragma unroll
        for (int i = 0; i < 16; ++i) { const int kk = 8 * i + (lane >> 3); const f32x4 w = v[i] * pg8::W8_SCALE;
            LAS float* d = scr + kk * 33 + 4 * (lane & 7); d[0] = w.x; d[1] = w.y; d[2] = w.z; d[3] = w.w; }
        LDS_WAIT();
#pragma unroll
        for (int j = 0; j < 8; ++j) { const int n = (lane & 7) + 8 * (j & 3), c = (lane >> 3) + 8 * (j >> 2); const LAS float* s = scr + (8 * c) * 33 + n;
            v2u o; o.x = pg8::pk4_fp8(s[0 * 33], s[1 * 33], s[2 * 33], s[3 * 33]); o.y = pg8::pk4_fp8(s[4 * 33], s[5 * 33], s[6 * 33], s[7 * 33]);
            *(v2u*)(it.dst + (size_t)n * D + it.k0 + 8 * c) = o; }
        LDS_WAIT();
    }
}
__device__ __forceinline__ void p0_prologue(const Args& a, LAS unsigned char* lds, int tid, int lane, int wave, int vcu, int G) {
    unsigned char* ws = a.ws;
    for (int u = vcu; u < 256; u += G) {
        const int cb = u & 15, ks = u >> 4;
        if (tid < 384) { const int col = cb * 384 + tid; float a0 = 0.f, a1 = 0.f, a2 = 0.f, a3 = 0.f; const float* cc = a.in[I_C];
            for (int k = 0; k < 64; ++k) { const int kk = ks * 64 + k; const float w = a.in[I_ADAW][(size_t)kk * 6144 + col];
                const float c0 = cc[kk], c1 = cc[1024 + kk], c2 = cc[2048 + kk], c3 = cc[3072 + kk];
                a0 += c0 * sigmoidf_(c0) * w; a1 += c1 * sigmoidf_(c1) * w; a2 += c2 * sigmoidf_(c2) * w; a3 += c3 * sigmoidf_(c3) * w; }
            float* mp = (float*)(ws + WS_MODP) + (size_t)(ks * 4) * 6144 + col;
            mp[0] = a0; mp[6144] = a1; mp[2 * 6144] = a2; mp[3 * 6144] = a3; }
    }
    for (int j = vcu; j < 48; j += G) {
        if (j < 16) { const int m = j >> 3, h = j & 7; const float* src = a.in[m ? I_WI : I_WR] + h * 4096; bf16* dst = (bf16*)(ws + WS_WRT) + (m * 8 + h) * 4096;
            for (int idx = tid; idx < 4096; idx += 512) { const int o = idx >> 6, i = idx & 63; dst[idx] = (bf16)f2bf(src[i * 64 + o] * (-1.4426950409f)); } }
        else { const int q = j - 16; bf16* dst = (bf16*)(ws + WS_WM);
            for (int idx = q * 4096 + tid; idx < (q + 1) * 4096; idx += 512) { const int t = (idx >> 7) & 127, s = idx & 127; dst[idx] = s <= t ? (bf16)f2bf(a.in[I_SGUW][idx]) : (bf16)0; } }
    }
    LAS float* scr = (LAS float*)(lds + wave * 16896);
    const int gw = vcu * NWAVES + wave, NGW = G * NWAVES;
    constexpr int I_IN = 16 * 32, I_OUT = 16 * 16, I_GU = 32 * 16 * 32, I_DN = 32 * 16 * 16, NITEMS = I_IN + I_OUT + I_GU + I_DN;
    const float* pWIN = a.in[I_WIN]; const float* pWOUT = a.in[I_WOUT]; const float* pWGU = a.in[I_WGU]; const float* pWDN = a.in[I_WDN]; const float* pGNL = a.in[I_GNL]; const float* pGNS = a.in[I_GNS];
    auto decode = [&](int it0, P0Item& o) {
        int r = it0;
        if (r < I_IN) { const int kb = r >> 5, nb = r & 31; o.kind = 0; o.k0 = 64 * kb; o.ksc = nullptr;
            o.src = pWIN + (size_t)(64 * kb + (lane >> 4)) * NPROJ + 64 * nb + 4 * (lane & 15); o.step = (size_t)4 * NPROJ; o.dst = ws + WS_WINT + (size_t)(64 * nb) * D * 2; return; }
        r -= I_IN;
        if (r < I_OUT) { const int kb = r >> 4, nb = r & 15; o.kind = 0; o.k0 = 64 * kb; o.ksc = o.k0 < DL ? pGNL : pGNS - DL;
            o.src = pWOUT + (size_t)(64 * kb + (lane >> 4)) * D + 64 * nb + 4 * (lane & 15); o.step = (size_t)4 * D; o.dst = ws + WS_WOUTT + (size_t)(64 * nb) * D * 2; return; }
        r -= I_OUT;
        if (r < I_GU) { const int e = r >> 9, q = r & 511, kb = q >> 6, nb = q & 63; const int n0 = 32 * nb, n1 = n0 & 1023; const int rd = (n1 >> 7) * 256 + (n0 >= 1024 ? 128 : 0) + (n1 & 127);
            o.kind = 1; o.k0 = 128 * kb; o.ksc = nullptr;
            o.src = pWGU + (size_t)e * D * 2048 + (size_t)(128 * kb + (lane >> 3)) * 2048 + n0 + 4 * (lane & 7); o.step = (size_t)8 * 2048; o.dst = ws + WS_WGUT + ((size_t)e * 2048 + rd) * D; return; }
        r -= I_GU;
        { const int e = r >> 8, q = r & 255, kb = q >> 5, nb = q & 31; o.kind = 1; o.k0 = 128 * kb; o.ksc = nullptr;
            o.src = pWDN + (size_t)e * D * D + (size_t)(128 * kb + (lane >> 3)) * D + 32 * nb + 4 * (lane & 7); o.step = (size_t)8 * D; o.dst = ws + WS_WDNT + ((size_t)e * D + 32 * nb) * D; }
    };
    int it = gw;
    if (it < NITEMS) {
        P0Item cur; f32x4 vc[16]; decode(it, cur); p0_load(vc, cur);
        for (;;) {
            const int itn = it + NGW; const bool more = itn < NITEMS;
            P0Item nxt = cur; f32x4 vn[16];
            if (more) { decode(itn, nxt); p0_load(vn, nxt); }
            p0_process(vc, cur, scr, lane);
            if (!more) break;
            cur = nxt; it = itn;
#pragma unroll
            for (int i = 0; i < 16; ++i) vc[i] = vn[i];
        }
    }
}
__device__ __forceinline__ void p1_modz(const Args& a, LAS unsigned char* lds, int tid, int lane, int wave, int vcu, int G) {
    const float* modp = (const float*)(a.ws + WS_MODP); float* mod = (float*)(a.ws + WS_MOD); bf16* Z = (bf16*)(a.ws + WS_Z); bf16* XB = (bf16*)(a.ws + WS_XB);
    for (int idx = vcu * 512 + tid; idx < 4 * 6144; idx += G * 512) { const int b = idx / 6144, n = idx - b * 6144; float s = a.in[I_ADAB][n];
#pragma unroll
        for (int ks = 0; ks < 16; ++ks) s += modp[(size_t)(ks * 4 + b) * 6144 + n];
        mod[idx] = s; }
    const int wpb = G / 4, b = vcu / wpb;
    LAS float* SHs = (LAS float*)lds; LAS float* SCs = (LAS float*)(lds + 4096);
    for (int k = tid; k < 2048; k += 512) { float s = a.in[I_ADAB][k];
#pragma unroll
        for (int ks = 0; ks < 16; ++ks) s += modp[(size_t)(ks * 4 + b) * 6144 + k];
        if (k < 1024) SHs[k] = s; else SCs[k - 1024] = (1.f + s) * a.in[I_N1G][k - 1024]; }
    __syncthreads();
    const int lw = (vcu - b * wpb) * NWAVES + wave, nlw = wpb * NWAVES;
#ifndef P1_NR
#define P1_NR 4
#endif
    for (int t = lw; t < SEQ; t += P1_NR * nlw) {
        f32x4 v[P1_NR][4]; float s[P1_NR];
#pragma unroll
        for (int q = 0; q < P1_NR; ++q) { const int tq_ = min(t + q * nlw, SEQ - 1); const f32x4* xr = (const f32x4*)(a.in[I_X] + ((size_t)b * SEQ + tq_) * D) + lane;
#pragma unroll
            for (int j = 0; j < 4; ++j) v[q][j] = __builtin_nontemporal_load(xr + 64 * j); }
#pragma unroll
        for (int q = 0; q < P1_NR; ++q) { s[q] = 0.f;
#pragma unroll
            for (int j = 0; j < 4; ++j) s[q] += (v[q][j].x * v[q][j].x + v[q][j].y * v[q][j].y) + (v[q][j].z * v[q][j].z + v[q][j].w * v[q][j].w);
            s[q] = rsqrtf(wave_sum(s[q]) * (1.f / D) + EPS); }
#pragma unroll
        for (int q = 0; q < P1_NR; ++q) if (t + q * nlw < SEQ) { v2u* o8 = (v2u*)(Z + ((size_t)b * SEQ + t + q * nlw) * D) + lane; v2u* x8 = (v2u*)(XB + ((size_t)b * SEQ + t + q * nlw) * D) + lane;
#pragma unroll
            for (int j = 0; j < 4; ++j) { const f32x4 g = *(const LAS f32x4*)(SCs + 4 * lane + 256 * j), sh = *(const LAS f32x4*)(SHs + 4 * lane + 256 * j); const f32x4 z = v[q][j] * s[q] * g + sh;
                v2u w; w.x = pk2(z.x, z.y); w.y = pk2(z.z, z.w); o8[64 * j] = w;
                v2u xw; xw.x = pk2(v[q][j].x, v[q][j].y); xw.y = pk2(v[q][j].z, v[q][j].w); x8[64 * j] = xw; } }
    }
    __syncthreads();
}
constexpr int XS = 516;
template <bool PASSB>
__device__ __forceinline__ void lru_unit(const Args& a, LAS unsigned char* lds, int tid, int lane, int wave, int unit) {
    const int b = unit >> 6, tb = unit & 63; const size_t row0 = (size_t)b * SEQ + tb * 64;
    const bf16* P = (const bf16*)(a.ws + WS_PROJ); float* agg = (float*)(a.ws + WS_AGG); bf16* HEADS = (bf16*)(a.ws + WS_HEADS); unsigned* phg = (unsigned*)(a.ws + WS_O32);
    LAS float* xcf = (LAS float*)lds; LAS float* Al = (LAS float*)(lds + 33280); LAS float* Bl = (LAS float*)(lds + 66560);
    LAS float* cst = (LAS float*)(lds + 99840); LAS float* rsl = (LAS float*)(lds + 108032);
    const int ch = tid, h = wave, tq = lane & 15, kq = lane >> 4;
    bf16 xan[16], yan[16];
#pragma unroll
    for (int i = 0; i < 16; ++i) { xan[i] = __builtin_nontemporal_load(P + (row0 + i) * NPROJ + ch); if (PASSB) yan[i] = P[(row0 + i) * NPROJ + 512 + ch]; }
    const float cw0 = a.in[I_CONVW][ch], cw1 = a.in[I_CONVW][DL + ch], cw2 = a.in[I_CONVW][2 * DL + ch], cw3 = a.in[I_CONVW][3 * DL + ch], cb = a.in[I_CONVB][ch];
    { const float sp = log1pf(expf(-a.in[I_LAM][ch]));
      cst[ch] = a.in[I_BR][ch] * (-1.4426950409f); cst[512 + ch] = a.in[I_BI][ch] * (-1.4426950409f); cst[1024 + ch] = sp * (-8.f * 1.4426950409f); cst[1536 + ch] = sp * (-16.f); }
    bf16x8 wrf[4][2], wif[4][2];
    { const bf16* wrt = (const bf16*)(a.ws + WS_WRT) + h * 4096; const bf16* wit = wrt + 8 * 4096;
#pragma unroll
      for (int ct = 0; ct < 4; ++ct)
#pragma unroll
          for (int ks = 0; ks < 2; ++ks) { const int off = (16 * ct + tq) * 64 + ks * 32 + 8 * kq; wrf[ct][ks] = *(const bf16x8*)(wrt + off); wif[ct][ks] = *(const bf16x8*)(wit + off); } }
    float x1 = 0.f, x2 = 0.f, x3 = 0.f;
    if (tb > 0) { x1 = bf2f(P[(row0 - 1) * NPROJ + ch]); x2 = bf2f(P[(row0 - 2) * NPROJ + ch]); x3 = bf2f(P[(row0 - 3) * NPROJ + ch]); }
    float hs = 0.f, pp = 1.f;
    if (PASSB) { const float* ag = agg + ((size_t)(b * 64) * 512 + ch) * 2;
        for (int c0 = 0; c0 < tb; c0 += 32) { float2 ph[32];
#pragma unroll
            for (int j = 0; j < 32; ++j) { ph[j].x = 1.f; ph[j].y = 0.f; if (c0 + j < tb) ph[j] = *(const float2*)(ag + (size_t)(c0 + j) * 1024); }
#pragma unroll
            for (int j = 0; j < 32; ++j) hs = ph[j].x * hs + ph[j].y; } }
    __syncthreads();
    for (int sub = 0; sub < 4; ++sub) {
        const size_t r0 = row0 + sub * 16;
        float xav[16], o[16];
#pragma unroll
        for (int i = 0; i < 16; ++i) { xav[i] = bf2f(xan[i]); if (PASSB) o[i] = bf2f(yan[i]); }
        if (sub < 3) {
#pragma unroll
            for (int i = 0; i < 16; ++i) { xan[i] = __builtin_nontemporal_load(P + (r0 + 16 + i) * NPROJ + ch); if (PASSB) yan[i] = P[(r0 + 16 + i) * NPROJ + 512 + ch]; } }
#pragma unroll
        for (int i = 0; i < 16; ++i) { const float xa = xav[i]; xcf[i * XS + ch] = cw0 * x3 + cw1 * x2 + cw2 * x1 + cw3 * xa + cb; x3 = x2; x2 = x1; x1 = xa; }
        __syncthreads();
        {
            bf16x8 xb[2];
#pragma unroll
            for (int ks = 0; ks < 2; ++ks) { const LAS float* p = xcf + tq * XS + h * 64 + ks * 32 + 8 * kq; const f32x4 lo = *(const LAS f32x4*)p, hi = *(const LAS f32x4*)(p + 4);
                const v4u w = {pk2(lo.x, lo.y), pk2(lo.z, lo.w), pk2(hi.x, hi.y), pk2(hi.z, hi.w)}; xb[ks] = __builtin_bit_cast(bf16x8, w); }
#pragma unroll
            for (int ct = 0; ct < 4; ++ct) { f32x4 rec = {0.f, 0.f, 0.f, 0.f}, inp = {0.f, 0.f, 0.f, 0.f};
#pragma unroll
                for (int ks = 0; ks < 2; ++ks) { rec = __builtin_amdgcn_mfma_f32_16x16x32_bf16(wrf[ct][ks], xb[ks], rec, 0, 0, 0); inp = __builtin_amdgcn_mfma_f32_16x16x32_bf16(wif[ct][ks], xb[ks], inp, 0, 0, 0); }
                const int cbase = h * 64 + 16 * ct + 4 * kq;
                const f32x4 xc4 = *(const LAS f32x4*)(xcf + tq * XS + cbase), br4 = *(const LAS f32x4*)(cst + cbase), bi4 = *(const LAS f32x4*)(cst + 512 + cbase), spa4 = *(const LAS f32x4*)(cst + 1024 + cbase), spy4 = *(const LAS f32x4*)(cst + 1536 + cbase);
                f32x4 av, bt;
                {
                    const f32x4 er = rec + br4, ei = inp + bi4; f32x4 rr, ig;
#pragma unroll
                    for (int r = 0; r < 4; ++r) { rr[r] = __builtin_amdgcn_rcpf(1.f + __builtin_amdgcn_exp2f(er[r])); ig[r] = __builtin_amdgcn_rcpf(1.f + __builtin_amdgcn_exp2f(ei[r])); }
                    const f32x4 y = rr * spy4, l2 = rr * spa4;
#pragma unroll
                    for (int r = 0; r < 4; ++r) av[r] = __builtin_amdgcn_exp2f(l2[r]);
                    f32x4 ser = -y * (y * (y * (y * (y * 0.0083333338f + 0.041666668f) + 0.16666667f) + 0.5f) + 1.f), big = (f32x4){1.f, 1.f, 1.f, 1.f} - av * av; f32x4 em;
                    asm volatile("" : "+v"(ser), "+v"(big));
#pragma unroll
                    for (int r = 0; r < 4; ++r) em[r] = __builtin_amdgcn_sqrtf(y[r] > -0.25f ? ser[r] : big[r]);
                    bt = em * ig * xc4; }
                *(LAS f32x4*)(Al + tq * XS + cbase) = av; *(LAS f32x4*)(Bl + tq * XS + cbase) = bt; }
        }
        __syncthreads();
#pragma unroll
        for (int i = 0; i < 16; ++i) { const float av = Al[i * XS + ch], bt = Bl[i * XS + ch]; hs = av * hs + bt; if (PASSB) o[i] *= hs; else { pp *= av; phg[(r0 + i) * 512 + ch] = pk2(pp, hs); } }
        if (PASSB) {
#pragma unroll
            for (int i = 0; i < 16; ++i) Al[i * XS + ch] = o[i];
            __syncthreads();
            { const int t = tid >> 5, part = tid & 31; float s = 0.f;
#pragma unroll
              for (int j = 0; j < 16; ++j) { const float v = Al[t * XS + part + 32 * j]; s += v * v; }
              s = sum32(s);
              if (part == 0) rsl[t] = rsqrtf(s * (1.f / 512.f) + EPS); }
            __syncthreads();
#pragma unroll
            for (int i = 0; i < 16; ++i) HEADS[(r0 + i) * D + ch] = f2bf1(o[i] * rsl[i]);
        }
        __syncthreads();
    }
    if (!PASSB) { float2 ph; ph.x = pp; ph.y = hs; *(float2*)(agg + ((size_t)(b * 64 + tb) * 512 + ch) * 2) = ph; }
}
__device__ __forceinline__ void lru_passb_unit(const Args& a, LAS unsigned char* lds, int tid, int lane, int wave, int unit) {
    const int b = unit >> 6, tb = unit & 63; const size_t row0 = (size_t)b * SEQ + tb * 64;
    const bf16* P = (const bf16*)(a.ws + WS_PROJ); const float* agg = (const float*)(a.ws + WS_AGG); bf16* HEADS = (bf16*)(a.ws + WS_HEADS); const unsigned* phg = (const unsigned*)(a.ws + WS_O32);
    LAS float* ol = (LAS float*)lds; LAS float* rsl = (LAS float*)(lds + 33280);
    const int ch = tid;
    unsigned phn[16]; bf16 yan[16];
#pragma unroll
    for (int i = 0; i < 16; ++i) { phn[i] = __builtin_nontemporal_load(phg + (row0 + i) * 512 + ch); yan[i] = __builtin_nontemporal_load(P + (row0 + i) * NPROJ + 512 + ch); }
    float carry = 0.f;
    { const float* ag = agg + ((size_t)(b * 64) * 512 + ch) * 2;
      for (int c0 = 0; c0 < tb; c0 += 32) { float2 ph[32];
#pragma unroll
          for (int j = 0; j < 32; ++j) { ph[j].x = 1.f; ph[j].y = 0.f; if (c0 + j < tb) ph[j] = *(const float2*)(ag + (size_t)(c0 + j) * 1024); }
#pragma unroll
          for (int j = 0; j < 32; ++j) carry = ph[j].x * carry + ph[j].y; } }
    for (int sub = 0; sub < 4; ++sub) {
        const size_t r0 = row0 + sub * 16; float o[16];
#pragma unroll
        for (int i = 0; i < 16; ++i) o[i] = (bfhi(phn[i]) + bflo(phn[i]) * carry) * bf2f(yan[i]);
        if (sub < 3) {
#pragma unroll
            for (int i = 0; i < 16; ++i) { phn[i] = __builtin_nontemporal_load(phg + (r0 + 16 + i) * 512 + ch); yan[i] = __builtin_nontemporal_load(P + (r0 + 16 + i) * NPROJ + 512 + ch); } }
#pragma unroll
        for (int i = 0; i < 16; ++i) ol[i * XS + ch] = o[i];
        __syncthreads();
        { const int t = tid >> 5, part = tid & 31; float sq = 0.f;
#pragma unroll
          for (int j = 0; j < 16; ++j) { const float v = ol[t * XS + part + 32 * j]; sq += v * v; }
          sq = sum32(sq);
          if (part == 0) rsl[t] = rsqrtf(sq * (1.f / 512.f) + EPS); }
        __syncthreads();
#pragma unroll
        for (int i = 0; i < 16; ++i) HEADS[(r0 + i) * D + ch] = f2bf1(o[i] * rsl[i]);
        __syncthreads();
    }
}
__device__ __forceinline__ void sgu_unit(const Args& a, LAS unsigned char* lds, int tid, int lane, int wave, int unit) {
    constexpr int RS = 132;
    const int th = unit & 1, bn = unit >> 1, Ks = 64 * (th + 1); const size_t rowbase = (size_t)bn * CHUNK;
    const bf16* P = (const bf16*)(a.ws + WS_PROJ); bf16* HEADS = (bf16*)(a.ws + WS_HEADS); const bf16* WM = (const bf16*)(a.ws + WS_WM);
    LAS bf16* vnT = (LAS bf16*)lds; LAS float* ssq = (LAS float*)(lds + 135168);
    bf16x8 wfr[4][4];
    { const bf16* wmh0 = WM + (size_t)wave * 16384 + (size_t)(64 * th + (lane & 15)) * 128 + 8 * (lane >> 4);
#pragma unroll
      for (int rt = 0; rt < 4; ++rt)
#pragma unroll
          for (int ks = 0; ks < 4; ++ks) { wfr[rt][ks] = (bf16x8){0, 0, 0, 0, 0, 0, 0, 0}; if (32 * ks < Ks && 32 * ks <= 64 * th + 16 * rt + 15) wfr[rt][ks] = *(const bf16x8*)(wmh0 + rt * 16 * 128 + 32 * ks); } }
    {
        float lg[8], lb[8];
#pragma unroll
        for (int j = 0; j < 8; ++j) { lg[j] = a.in[I_LNG][lane + 64 * j]; lb[j] = a.in[I_LNB][lane + 64 * j]; }
        for (int s8 = 8 * wave; s8 < Ks; s8 += 8 * NWAVES) { float v[8][8]; float mean[8], rstd[8];
#pragma unroll
            for (int q = 0; q < 8; ++q) { const bf16* prow = P + (rowbase + s8 + q) * NPROJ + 1536;
#pragma unroll
                for (int j = 0; j < 8; ++j) v[q][j] = bf2f(__builtin_nontemporal_load(prow + lane + 64 * j)); }
#pragma unroll
            for (int q = 0; q < 8; ++q) { float sm = 0.f;
#pragma unroll
                for (int j = 0; j < 8; ++j) sm += v[q][j];
                mean[q] = sm; }
#pragma unroll
            for (int q = 0; q < 8; ++q) { mean[q] = wave_sum(mean[q]) * (1.f / 512.f); float qq = 0.f;
#pragma unroll
                for (int j = 0; j < 8; ++j) { v[q][j] -= mean[q]; qq += v[q][j] * v[q][j]; }
                rstd[q] = qq; }
#pragma unroll
            for (int q = 0; q < 8; ++q) rstd[q] = rsqrtf(wave_sum(rstd[q]) * (1.f / 512.f) + EPS);
#pragma unroll
            for (int j = 0; j < 8; ++j) {
#pragma unroll
                for (int g = 0; g < 2; ++g) { v2u w; w.x = pk2(v[4 * g][j] * rstd[4 * g] * lg[j] + lb[j], v[4 * g + 1][j] * rstd[4 * g + 1] * lg[j] + lb[j]); w.y = pk2(v[4 * g + 2][j] * rstd[4 * g + 2] * lg[j] + lb[j], v[4 * g + 3][j] * rstd[4 * g + 3] * lg[j] + lb[j]);
                    *(LAS v2u*)(vnT + (lane + 64 * j) * RS + s8 + 4 * g) = w; } } }
    }
    __syncthreads();
    const int h = wave, tq = lane & 15, kq = lane >> 4;
    f32x4 acc[4][4];
#pragma unroll
    for (int rt = 0; rt < 4; ++rt)
#pragma unroll
        for (int ct = 0; ct < 4; ++ct) acc[rt][ct] = (f32x4){0.f, 0.f, 0.f, 0.f};
    v2u uw[4][4]; float bias4[4];
#pragma unroll
    for (int rt = 0; rt < 4; ++rt) { const int t = 64 * th + 16 * rt + tq; bias4[rt] = a.in[I_SGUB][h * CHUNK + t]; const bf16* urow = P + (rowbase + t) * NPROJ + 1024 + h * 64 + 4 * kq;
#pragma unroll
        for (int ct = 0; ct < 4; ++ct) uw[rt][ct] = __builtin_nontemporal_load((const v2u*)(urow + 16 * ct)); }
#pragma unroll
    for (int ks = 0; ks < 4; ++ks) { if (32 * ks >= Ks) break;
        bf16x8 vf[4];
#pragma unroll
        for (int ct = 0; ct < 4; ++ct) { const LAS bf16* p = vnT + (h * 64 + 16 * ct + tq) * RS + 32 * ks + 8 * kq; const bf16x4 lo = *(const LAS bf16x4*)p, hi = *(const LAS bf16x4*)(p + 4);
            vf[ct] = (bf16x8){lo[0], lo[1], lo[2], lo[3], hi[0], hi[1], hi[2], hi[3]}; }
#pragma unroll
        for (int rt = 0; rt < 4; ++rt) if (32 * ks <= 64 * th + 16 * rt + 15) { const bf16x8 wf = wfr[rt][ks];
#pragma unroll
            for (int ct = 0; ct < 4; ++ct) acc[rt][ct] = __builtin_amdgcn_mfma_f32_16x16x32_bf16(vf[ct], wf, acc[rt][ct], 0, 0, 0); }
    }
#pragma unroll
    for (int rt = 0; rt < 4; ++rt) { const float bias = bias4[rt]; float sl = 0.f;
#pragma unroll
        for (int ct = 0; ct < 4; ++ct) { const v2u uq = uw[rt][ct];
            f32x4 o; o.x = bflo(uq.x) * (acc[rt][ct].x + bias); o.y = bfhi(uq.x) * (acc[rt][ct].y + bias); o.z = bflo(uq.y) * (acc[rt][ct].z + bias); o.w = bfhi(uq.y) * (acc[rt][ct].w + bias);
            acc[rt][ct] = o; sl += (o.x * o.x + o.y * o.y) + (o.z * o.z + o.w * o.w); }
        { float o_; const float p_ = xor16f(sl, o_); sl = o_ + p_; } { float o_; const float p_ = xor32f(sl, o_); sl = o_ + p_; }
        if (kq == 0) ssq[(16 * rt + tq) * 8 + h] = sl; }
    __syncthreads();
#pragma unroll
    for (int rt = 0; rt < 4; ++rt) { const int tl = 16 * rt + tq; const f32x4 s0 = *(const LAS f32x4*)(ssq + tl * 8), s1 = *(const LAS f32x4*)(ssq + tl * 8 + 4);
        const float rs = rsqrtf(((s0.x + s0.y) + (s0.z + s0.w) + (s1.x + s1.y) + (s1.z + s1.w)) * (1.f / 512.f) + EPS);
        bf16* hrow = HEADS + (rowbase + 64 * th + tl) * D + DL + h * 64 + 4 * kq;
#pragma unroll
        for (int ct = 0; ct < 4; ++ct) { v2u w; w.x = pk2(acc[rt][ct].x * rs, acc[rt][ct].y * rs); w.y = pk2(acc[rt][ct].z * rs, acc[rt][ct].w * rs); *(v2u*)(hrow + 16 * ct) = w; } }
    __syncthreads();
}
template <int DRY>
__device__ __forceinline__ void router_unit(const Args& a, LAS unsigned char* lds, int tid, int lane, int wave, int unit) {
    const int tok0 = unit * 64, b = tok0 / SEQ;
    const bf16* HB = (const bf16*)(a.ws + WS_PROJ); const float* mod = (const float*)(a.ws + WS_MOD) + b * 6144; unsigned char* Z = a.ws + WS_Z;
    int* toke = (int*)(a.ws + WS_TOKE); float* gatee = (float*)(a.ws + WS_GATEE); int* pos = (int*)(a.ws + WS_POS); unsigned* cursor = (unsigned*)(a.ws + WS_CTL) + CW_CUR;
    LAS int* asg_e = (LAS int*)(lds + 139648); LAS float* asg_g = (LAS float*)(lds + 140672); LAS int* offl = (LAS int*)(lds + 141696);
    LAS float* RW = (LAS float*)lds; LAS float* part = (LAS float*)lds; LAS float* GK = (LAS float*)(lds + 131072); LAS float* SH = (LAS float*)(lds + 135168); LAS float* rsl = (LAS float*)(lds + 139264); LAS int* hist = (LAS int*)(lds + 139520);
    for (int k = tid; k < D; k += 512) { GK[k] = a.in[I_N2G][k] * (1.f + mod[4096 + k]); SH[k] = mod[3072 + k]; }
    if (tid < 32) hist[tid] = 0;
    { const float* rwg = a.in[I_RW];
#pragma unroll
      for (int p = 0; p < 16; ++p) { const int piece = wave * 16 + p; __builtin_amdgcn_global_load_lds((const unsigned*)(rwg + piece * 256 + ((lane * 4) ^ ((p & 1) << 4))), (LAS unsigned*)(lds + piece * 1024), 16, 0, 0); } }
    __syncthreads();
    for (int i0 = 0; i0 < 8; i0 += 4) {
        f32x4 v[4][4]; float rs[4];
#pragma unroll
        for (int q = 0; q < 4; ++q) { const size_t ro = (size_t)(tok0 + wave * 8 + i0 + q) * D + 4 * lane;
#pragma unroll
            for (int j = 0; j < 4; ++j) { const v2u d = *(const v2u*)(HB + ro + 256 * j); f32x4 xv; xv.x = bflo(d.x); xv.y = bfhi(d.x); xv.z = bflo(d.y); xv.w = bfhi(d.y); v[q][j] = xv; } }
#pragma unroll
        for (int q = 0; q < 4; ++q) { float s = 0.f;
#pragma unroll
            for (int j = 0; j < 4; ++j) s += (v[q][j].x * v[q][j].x + v[q][j].y * v[q][j].y) + (v[q][j].z * v[q][j].z + v[q][j].w * v[q][j].w);
            rs[q] = rsqrtf(wave_sum(s) * (1.f / D) + EPS); }
#pragma unroll
        for (int q = 0; q < 4; ++q) { const int tl = wave * 8 + i0 + q; unsigned* o4 = (unsigned*)(Z + (size_t)(tok0 + tl) * D) + lane;
#pragma unroll
            for (int j = 0; j < 4; ++j) { const f32x4 g = *(const LAS f32x4*)(GK + 4 * lane + 256 * j), sh = *(const LAS f32x4*)(SH + 4 * lane + 256 * j); const f32x4 z = v[q][j] * rs[q] * g + sh;
                o4[64 * j] = pg8::pk4_fp8(z.x, z.y, z.z, z.w); }
            if (lane == 0) rsl[tl] = rs[q]; } }
    v4u dvv[16];
    { const int tt = wave & 3, kh = wave >> 2, ti = lane & 15, kq = lane >> 4; const bf16* drow = HB + (size_t)(tok0 + tt * 16 + ti) * D + kh * 512 + 8 * kq;
#pragma unroll
      for (int blk = 0; blk < 16; ++blk) dvv[blk] = *(const v4u*)(drow + blk * 32); }
    VM_WAIT();
    __syncthreads();
    if (DRY == 3) { if (dvv[0].x == 0x12345u && dvv[15].w == 0x54321u && dvv[7].y == 0x777u) rsl[0] = 0.f; __syncthreads(); return; }
    {
        const int tt = wave & 3, kh = wave >> 2, ti = lane & 15, kq = lane >> 4; const float rs = rsl[tt * 16 + ti];
        f32x4 c0 = {0.f, 0.f, 0.f, 0.f}, c1 = {0.f, 0.f, 0.f, 0.f};
        const int kb = kh * 512 + 8 * kq; const int o0 = (kq & 1) ? 16 : 0, o1 = 16 - o0;
#pragma unroll
        for (int blk = 0; blk < 16; ++blk) { const int k0 = kb + blk * 32; const v4u dv = dvv[blk];
            float w0[8], w1[8];
#pragma unroll
            for (int s = 0; s < 8; ++s) { const LAS float* w = RW + (k0 + s) * NE + ti; w0[s] = w[o0]; w1[s] = w[o1]; }
            f32x4 ha, hb2; ha.x = bflo(dv.x); ha.y = bfhi(dv.x); ha.z = bflo(dv.y); ha.w = bfhi(dv.y); hb2.x = bflo(dv.z); hb2.y = bfhi(dv.z); hb2.z = bflo(dv.w); hb2.w = bfhi(dv.w);
            const f32x4 za = ha * rs * *(const LAS f32x4*)(GK + k0) + *(const LAS f32x4*)(SH + k0), zb = hb2 * rs * *(const LAS f32x4*)(GK + k0 + 4) + *(const LAS f32x4*)(SH + k0 + 4);
#pragma unroll
            for (int s = 0; s < 4; ++s) { c0 = __builtin_amdgcn_mfma_f32_16x16x4f32(za[s], w0[s], c0, 0, 0, 0); c1 = __builtin_amdgcn_mfma_f32_16x16x4f32(za[s], w1[s], c1, 0, 0, 0); }
#pragma unroll
            for (int s = 0; s < 4; ++s) { c0 = __builtin_amdgcn_mfma_f32_16x16x4f32(zb[s], w0[4 + s], c0, 0, 0, 0); c1 = __builtin_amdgcn_mfma_f32_16x16x4f32(zb[s], w1[4 + s], c1, 0, 0, 0); } }
        __syncthreads();
#pragma unroll
        for (int r = 0; r < 4; ++r) { LAS float* p = part + (kh * 64 + tt * 16 + kq * 4 + r) * 33; p[ti] = c0[r]; p[16 + ti] = c1[r]; }
    }
    __syncthreads();
    if (DRY == 2) return;
    {
        const int e = lane & 31, hs = lane & 32; const float rbv = a.in[I_RB][e];
        float v[4], den[4], m0[4], myex[4]; int myk[4];
#pragma unroll
        for (int p = 0; p < 4; ++p) { const int tl = wave * 8 + 2 * p + (lane >> 5); v[p] = part[tl * 33 + e] + part[(64 + tl) * 33 + e] + rbv; den[p] = 0.f; m0[p] = 0.f; myex[p] = 0.f; myk[p] = -1; }
#pragma unroll
        for (int k = 0; k < 4; ++k) { float m[4];
#pragma unroll
            for (int p = 0; p < 4; ++p) m[p] = max32(v[p]);
#pragma unroll
            for (int p = 0; p < 4; ++p) { const unsigned long long bal = __ballot(v[p] == m[p]); const int idx = __ffs((unsigned)(bal >> hs)) - 1;
                if (k == 0) m0[p] = m[p];
                const float ex = expf(m[p] - m0[p]); den[p] += ex;
                if (e == idx) { v[p] = -INFINITY; myk[p] = k; myex[p] = ex; } } }
#pragma unroll
        for (int p = 0; p < 4; ++p) if (myk[p] >= 0) { const int tl = wave * 8 + 2 * p + (lane >> 5); const int r = __hip_atomic_fetch_add(hist + e, 1, __ATOMIC_RELAXED, __HIP_MEMORY_SCOPE_WORKGROUP); asg_e[tl * 4 + myk[p]] = e | (r << 8); asg_g[tl * 4 + myk[p]] = myex[p] / den[p]; }
    }
    __syncthreads();
    if (DRY == 1) return;
    if (tid < 32) offl[tid] = (int)__hip_atomic_fetch_add(cursor + tid, (unsigned)hist[tid], __ATOMIC_RELAXED, __HIP_MEMORY_SCOPE_AGENT);
    __syncthreads();
    if (tid < 256) { const int ev = asg_e[tid], e = ev & 255, r = ev >> 8; const int idx = e * pg8::ELIST + offl[e] + r; toke[idx] = tok0 + (tid >> 2); gatee[idx] = asg_g[tid]; pos[tok0 * 4 + tid] = idx; }
    __syncthreads();
}
__device__ __forceinline__ void moe_tables(const Args& a, LAS unsigned char* lds, int tid) {
    LAS int* tp = (LAS int*)(lds + TBL_OFF); LAS int* eb = tp + 36; LAS int* tot = tp + 72; unsigned* cursor = (unsigned*)(a.ws + WS_CTL) + CW_CUR;
    if (tid < 32) tot[tid] = (int)__hip_atomic_load(cursor + tid, __ATOMIC_RELAXED, __HIP_MEMORY_SCOPE_AGENT);
    __syncthreads();
    if (tid == 0) { int s = 0, r = 0; for (int e = 0; e < NE; ++e) { tp[e] = s; eb[e] = r; s += (tot[e] + 255) >> 8; r += tot[e]; } tp[NE] = s; eb[NE] = r; }
    __syncthreads();
}
__device__ __forceinline__ void final_rows(const Args& a, LAS unsigned char* lds, int lane, int wave, int vcu, int G, bool do_store) {
    const unsigned char* Y = a.ws + WS_Y; const int* pos = (const int*)(a.ws + WS_POS); const float* mod = (const float*)(a.ws + WS_MOD); const bf16* HB = (const bf16*)(a.ws + WS_PROJ);
    const LAS int* ebl = (const LAS int*)(lds + TBL_OFF) + 36;
    const int stride = G * NWAVES; constexpr int NQ = 4;
    int4 pn[NQ];
    { const int t0 = vcu * NWAVES + wave;
#pragma unroll
      for (int q = 0; q < NQ; ++q) pn[q] = *(const int4*)(pos + min(t0 + q * stride, NTOK - 1) * 4); }
    for (int tok0 = vcu * NWAVES + wave; tok0 < NTOK; tok0 += NQ * stride) {
        f32x4 v[NQ][4]; float s[NQ]; int4 pc[NQ];
#pragma unroll
        for (int q = 0; q < NQ; ++q) { pc[q] = pn[q]; pn[q] = *(const int4*)(pos + min(tok0 + (NQ + q) * stride, NTOK - 1) * 4); }
#pragma unroll
        for (int q = 0; q < NQ; ++q) { const int tok = min(tok0 + q * stride, NTOK - 1); const int b = tok / SEQ;
            int4 p = pc[q]; p.x = ebl[p.x >> 14] + (p.x & (pg8::ELIST - 1)); p.y = ebl[p.y >> 14] + (p.y & (pg8::ELIST - 1)); p.z = ebl[p.z >> 14] + (p.z & (pg8::ELIST - 1)); p.w = ebl[p.w >> 14] + (p.w & (pg8::ELIST - 1));
            const bf16* dr = HB + (size_t)tok * D;
#pragma unroll
            for (int j = 0; j < 4; ++j) { const int off = 4 * lane + 256 * j;
                const unsigned y0 = __builtin_nontemporal_load((const unsigned*)(Y + (size_t)p.x * D + off)), y1 = __builtin_nontemporal_load((const unsigned*)(Y + (size_t)p.y * D + off)), y2 = __builtin_nontemporal_load((const unsigned*)(Y + (size_t)p.z * D + off)), y3 = __builtin_nontemporal_load((const unsigned*)(Y + (size_t)p.w * D + off));
                typedef float f32x2_t __attribute__((ext_vector_type(2)));
                const f32x2_t a0 = __builtin_amdgcn_cvt_pk_f32_fp8(y0, false), a1 = __builtin_amdgcn_cvt_pk_f32_fp8(y0, true), b0 = __builtin_amdgcn_cvt_pk_f32_fp8(y1, false), b1 = __builtin_amdgcn_cvt_pk_f32_fp8(y1, true);
                const f32x2_t c0 = __builtin_amdgcn_cvt_pk_f32_fp8(y2, false), c1 = __builtin_amdgcn_cvt_pk_f32_fp8(y2, true), d0 = __builtin_amdgcn_cvt_pk_f32_fp8(y3, false), d1 = __builtin_amdgcn_cvt_pk_f32_fp8(y3, true);
                f32x4 m; m.x = ((a0.x + b0.x) + (c0.x + d0.x)) * (1.f / pg8::Y8_SCALE); m.y = ((a0.y + b0.y) + (c0.y + d0.y)) * (1.f / pg8::Y8_SCALE);
                m.z = ((a1.x + b1.x) + (c1.x + d1.x)) * (1.f / pg8::Y8_SCALE); m.w = ((a1.y + b1.y) + (c1.y + d1.y)) * (1.f / pg8::Y8_SCALE);
                const f32x4 g2 = *(const f32x4*)(mod + b * 6144 + 5120 + off); const v2u d = __builtin_nontemporal_load((const v2u*)(dr + off)); f32x4 hv; hv.x = bflo(d.x); hv.y = bfhi(d.x); hv.z = bflo(d.y); hv.w = bfhi(d.y); v[q][j] = hv + g2 * m; } }
#pragma unroll
        for (int q = 0; q < NQ; ++q) { s[q] = 0.f;
#pragma unroll
            for (int j = 0; j < 4; ++j) s[q] += (v[q][j].x * v[q][j].x + v[q][j].y * v[q][j].y) + (v[q][j].z * v[q][j].z + v[q][j].w * v[q][j].w); }
#pragma unroll
        for (int q = 0; q < NQ; ++q) s[q] = wave_sum(s[q]);
#pragma unroll
        for (int q = 0; q < NQ; ++q) if (do_store && tok0 + q * stride < NTOK) { const float rs = rsqrtf(s[q] * (1.f / D) + EPS); float* hr = a.out + (size_t)(tok0 + q * stride) * D;
#pragma unroll
            for (int j = 0; j < 4; ++j) { const int off = 4 * lane + 256 * j; const f32x4 fg = *(const f32x4*)(a.in[I_FG] + off); *(f32x4*)(hr + off) = v[q][j] * rs * fg; } }
    }
}

__global__ void __launch_bounds__(NWAVES * 64, 2) mega(Args args) {
    extern __shared__ __attribute__((aligned(16))) unsigned char lds_raw[];
    LAS unsigned char* lds = (LAS unsigned char*)lds_raw;
    volatile LAS unsigned* MISC = (volatile LAS unsigned*)(lds + MISC_OFF);
    const int tid = threadIdx.x, lane = tid & 63, wave = __builtin_amdgcn_readfirstlane(tid >> 6);
    const int G = gridDim.x; const int bx = blockIdx.x; const int vcu = (G % 8 == 0) ? (bx % 8) * (G / 8) + bx / 8 : bx;
    for (int u = tid; u < (LDS_BYTES - MISC_OFF) / 4; u += NWAVES * 64) ((LAS unsigned*)(lds + MISC_OFF))[u] = 0u;
    __syncthreads();
    const int lo = args.ph_lo, hi = args.ph_hi;
    XcdBarrier bar; bar.bar = (unsigned*)(args.ws + WS_CTL) + CW_BAR + args.li * XCD_BAR_WORDS; bar.x = 0; bar.st = nullptr;
    if (hi - lo > 1) bar = xcd_barrier_post((unsigned*)(args.ws + WS_CTL) + CW_BAR + args.li * XCD_BAR_WORDS, MISC + 8);
#ifndef PHMASK
#define PHMASK 0x7FF
#endif
#ifndef PHREP
#define PHREP 0
#endif
#define IN(k) (((PHMASK >> (k)) & 1) && lo <= (k) && (k) < hi)
#define NREP(k) (((PHREP >> (k)) & 1) ? 2 : 1)
#ifndef BARREP
#define BARREP 1
#endif
#define SEAM(k) do { if (IN(k) && IN((k) + 1)) { for (int _b = 0; _b < BARREP; ++_b) xcd_barrier(bar.bar, bar.x, bar.st); } } while (0)
    unsigned char* ws = args.ws;
#ifndef P3DUP
#define P3DUP 0
#endif
#ifndef DRYMODE
#define DRYMODE 1
#endif
#ifndef PHDUP
#define PHDUP -1
#endif
#define DUPBAR() xcd_barrier(bar.bar, bar.x, bar.st)
#define PH2(SH) do { pg8::DenseOrder S; S.init(ws + WS_Z, ws + WS_WINT, NTOK, NPROJ, D * 2, G, ((SH) ? ((bx + 4) & 255) : bx)); pg8::EpiInProj E{(bf16*)(ws + WS_PROJ)}; \
        pg8::gemm_phase<pg8::EpiInProj, pg8::DenseOrder, true>(lds + RING_OFF, D * 2, S, E); } while (0)
#define PH3(SH) do { for (int u = vcu; u < 256; u += G) lru_unit<false>(args, lds, tid, lane, wave, ((SH) ? ((u + 128) & 255) : u)); for (int u = vcu; u < 256; u += G) sgu_unit(args, lds, tid, lane, wave, ((SH) ? ((u + 128) & 255) : u)); } while (0)
#define PH4(SH) do { for (int u = vcu; u < 256; u += G) lru_passb_unit(args, lds, tid, lane, wave, ((SH) ? ((u + 128) & 255) : u)); } while (0)
#define PH5(SH) do { pg8::DenseOrder S; S.init(ws + WS_HEADS, ws + WS_WOUTT, NTOK, D, D * 2, G, ((SH) ? ((bx + 4) & 255) : bx)); pg8::EpiOutProj E{(const float*)(ws + WS_MOD), (const bf16*)(ws + WS_XB), (bf16*)(ws + WS_PROJ)}; \
        pg8::gemm_phase<pg8::EpiOutProj, pg8::DenseOrder, true>(lds + RING_OFF, D * 2, S, E); } while (0)
#define PH8(SH) do { moe_tables(args, lds, tid); pg8::MoeOrder S; S.init(ws + WS_Z, ws + WS_WGUT, (const LAS int*)(lds + TBL_OFF), (const LAS int*)(lds + TBL_OFF) + 36, 2048, D, G, ((SH) ? ((bx + 4) & 255) : bx)); \
        pg8::EpiSwiglu E{args.in[I_BGU], ws + WS_ACT, lds + EPI_OFF}; const pg8::GatherA ga{(const char*)(ws + WS_Z), (const int*)(ws + WS_TOKE), (LAS unsigned*)(lds + RT_OFF)}; \
        pg8::gemm_phase<pg8::EpiSwiglu, pg8::MoeOrder, true, true, true>(lds + RING_OFF, D, S, E, ga); } while (0)
#define PH9(SH) do { moe_tables(args, lds, tid); pg8::MoeOrder S; S.init(ws + WS_ACT, ws + WS_WDNT, (const LAS int*)(lds + TBL_OFF), (const LAS int*)(lds + TBL_OFF) + 36, D, D, G, ((SH) ? ((bx + 4) & 255) : bx)); \
        pg8::EpiDown E{args.in[I_BDN], (const float*)(ws + WS_GATEE), ws + WS_Y, lds + EPI_OFF}; pg8::gemm_phase<pg8::EpiDown, pg8::MoeOrder, true, true>(lds + RING_OFF, D, S, E); } while (0)
    if (IN(0)) { p0_prologue(args, lds, tid, lane, wave, vcu, G);
#if PHDUP == 0
        DUPBAR(); p0_prologue(args, lds, tid, lane, wave, vcu, G);
#endif
        SEAM(0); }
    if (IN(1)) { p1_modz(args, lds, tid, lane, wave, vcu, G);
#if PHDUP == 1
        DUPBAR(); p1_modz(args, lds, tid, lane, wave, vcu, G);
#endif
        SEAM(1); }
    if (IN(2)) {
#if PHDUP == 2
        PH2(1); DUPBAR();
#endif
        PH2(0); SEAM(2); }
    if (IN(3)) {
#if PHDUP == 3
        PH3(1); DUPBAR();
#endif
#if P3DUP == 1
        for (int u = vcu; u < 256; u += G) lru_unit<false>(args, lds, tid, lane, wave, (u + 128) & 255); DUPBAR();
#elif P3DUP == 2
        for (int u = vcu; u < 256; u += G) sgu_unit(args, lds, tid, lane, wave, (u + 128) & 255); DUPBAR();
#endif
        PH3(0);
        SEAM(3); }
    if (IN(4)) {
#if PHDUP == 4
        PH4(1); DUPBAR();
#endif
        PH4(0); SEAM(4); }
    if (IN(5)) {
#if PHDUP == 5
        PH5(1); DUPBAR();
#endif
        PH5(0); SEAM(5); }
    if (IN(6)) {
#if PHDUP == 6
        for (int u = vcu; u < 256; u += G) router_unit<DRYMODE>(args, lds, tid, lane, wave, (u + 128) & 255); DUPBAR();
#endif
        for (int u = vcu; u < 256; u += G) router_unit<0>(args, lds, tid, lane, wave, u); SEAM(6); }
    if (IN(8)) {
#if PHDUP == 8
        PH8(1); DUPBAR();
#endif
        PH8(0); SEAM(8); }
    if (IN(9)) {
#if PHDUP == 9
        PH9(1); DUPBAR();
#endif
        PH9(0); SEAM(9); }
    if (IN(10)) { moe_tables(args, lds, tid); final_rows(args, lds, lane, wave, vcu, G, true); }
#undef IN
#undef SEAM
}

extern "C" void kernel_launch(void* const* d_in, const int* in_sizes, int n_in, void* d_out, int out_size, void* d_ws, size_t ws_size, hipStream_t stream) {
    static int grid = 0;
    if (grid == 0) {
        if (n_in != 28 || out_size != NTOK * D || ws_size < WS_END) { fprintf(stderr, "kernel_launch: unexpected shapes (n_in %d out %d ws %zu)\n", n_in, out_size, ws_size); grid = -1; return; }
        int dev = 0, cus = 0, per_cu = 0;
        if (hipGetDevice(&dev) != hipSuccess || hipDeviceGetAttribute(&cus, hipDeviceAttributeMultiprocessorCount, dev) != hipSuccess) { grid = -1; return; }
        if (hipFuncSetAttribute((const void*)mega, hipFuncAttributeMaxDynamicSharedMemorySize, LDS_BYTES) != hipSuccess) { fprintf(stderr, "kernel_launch: hipFuncSetAttribute failed\n"); grid = -1; return; }
        if (hipOccupancyMaxActiveBlocksPerMultiprocessor(&per_cu, (const void*)mega, NWAVES * 64, LDS_BYTES) != hipSuccess || per_cu < 1) { fprintf(stderr, "kernel_launch: occupancy query says %d blocks per CU\n", per_cu); (void)hipGetLastError(); grid = -1; return; }
        grid = cus < 256 ? cus : 256;
        if (grid % 8 != 0) { fprintf(stderr, "kernel_launch: %d CUs; the phase programs need a grid that is a multiple of 8\n", cus); grid = -1; return; }
    }
    if (grid < 0) return;
    (void)hipMemsetAsync((unsigned char*)d_ws + WS_CTL, 0, CTL_ZERO_BYTES, stream);
    Args a{};
    for (int i = 0; i < 28; ++i) a.in[i] = (const float*)d_in[i];
    a.out = (float*)d_out; a.ws = (unsigned char*)d_ws; a.ph_lo = 0; a.ph_hi = NPH; a.li = 0;
    hipLaunchKernelGGL(mega, dim3(grid), dim3(NWAVES * 64), LDS_BYTES, stream, a);
}
```

```cpp
#include <hip/hip_runtime.h>
#include <cstdio>
#include <cstdint>

typedef unsigned short bf16;
constexpr int D = 1024, BATCH = 4, SEQ = 4096, NTOK = BATCH * SEQ, NPROJ = 2048, DL = 512, NH = 8, HD = 64, CHUNK = 128, NE = 32, TOPK = 4;
constexpr int NASSIGN = NTOK * TOPK;
constexpr float EPS = 1e-6f;

__device__ __forceinline__ unsigned f2bf(float f) { unsigned u = __builtin_bit_cast(unsigned, f); return (u + 0x7fffu + ((u >> 16) & 1u)) >> 16; }
__device__ __forceinline__ float bf2f(bf16 h) { return __builtin_bit_cast(float, (unsigned)h << 16); }
__device__ __forceinline__ float gelu_tanh(float x) { const float u = 1.5957691216057308f * (x + 0.044715f * x * x * x); return x / (1.f + __expf(-u)); }
__device__ __forceinline__ float sigmoidf_(float x) { return 1.f / (1.f + __expf(-x)); }

constexpr size_t MiB = 1u << 20;
constexpr size_t WS_CTL = 0;
constexpr size_t CTL_ZERO_BYTES = 20480;
constexpr size_t WS_MODP = 1 * MiB;
constexpr size_t WS_MOD = 3 * MiB;
constexpr size_t WS_AGG = 4 * MiB;
constexpr size_t WS_CNT = 5 * MiB;
constexpr size_t WS_TOPE = 6 * MiB;
constexpr size_t WS_GATE = 7 * MiB;
constexpr size_t WS_RANK = 8 * MiB;
constexpr size_t WS_POS = 9 * MiB;
constexpr size_t WS_GSORT = 10 * MiB;
constexpr size_t WS_TOKL = 11 * MiB;
constexpr size_t WS_STATS = 12 * MiB;
constexpr size_t WS_WRT = 13 * MiB;
constexpr size_t WS_WM = 14 * MiB;
constexpr size_t WS_Z = 16 * MiB;
constexpr size_t WS_HEADS = 48 * MiB;
constexpr size_t WS_PROJ = 80 * MiB;
constexpr size_t WS_ACT = 144 * MiB;
constexpr size_t WS_Y = 280 * MiB;
constexpr size_t WS_WINT = 416 * MiB;
constexpr size_t WS_WOUTT = 420 * MiB;
constexpr size_t WS_WGUT = 424 * MiB;
constexpr size_t WS_WDNT = 552 * MiB;
constexpr size_t WS_TOKE = 616 * MiB;
constexpr size_t WS_GATEE = 620 * MiB;
constexpr size_t WS_O32 = 752 * MiB;
constexpr size_t WS_XB = 784 * MiB;
constexpr size_t WS_END = 816 * MiB;
constexpr int CW_CNT = 0, CW_CUR = 64, CW_EBASE = 128;
constexpr int CW_BAR = 1024;

namespace pg8 {
#define PG8_LAS __attribute__((address_space(3)))
typedef unsigned short bf16_t;
typedef short bf16x8 __attribute__((ext_vector_type(8)));
typedef float f32x4 __attribute__((ext_vector_type(4)));
typedef unsigned u32x4 __attribute__((ext_vector_type(4)));
constexpr int BM = 256, BK = 64, HALF = 128, HTB = HALF * BK * 2, STAGE_BYTES = 8 * HTB, NXCD = 8, WGM = 8;
constexpr int ELIST = 16384;

__host__ __device__ __forceinline__ int lds_byte(int r, int c) { const int st = (r >> 4) * 2 + (c >> 5), rr = r & 15, cc = c & 31, ob = rr * 64 + cc * 2; return st * 1024 + (ob ^ (((ob >> 9) & 1) << 5)); }
__host__ __device__ __forceinline__ void stage_rc(int b, int& R, int& C) { const int st = b / 1024, sb = b % 1024, swz = sb ^ (((sb >> 9) & 1) << 5); R = (st >> 1) * 16 + swz / 64; C = (st & 1) * 32 + (swz % 64) / 2; }
__host__ __device__ __forceinline__ int perm32(int rho) { const int n = rho >> 4, i = rho & 15; return 8 * (i >> 2) + 4 * n + (i & 3); }

struct Unit { const char* A; const char* B; int row0, col0, nr, e, lrow0, half; };

struct DenseOrder {
    const char* A; const char* B; int nM, nN, nwg, G, c, pitch;
    __device__ __forceinline__ void init(const void* A_, const void* B_, int M, int N, int pitch_, int G_, int c_) { A = (const char*)A_; B = (const char*)B_; nM = M / BM; nN = N / BM; nwg = nM * nN; G = G_; c = c_; pitch = pitch_; }
    __device__ __forceinline__ bool next(int i, Unit& u) const {
        const long L = (long)i * G + c; if (L >= nwg) return false;
        int wgid = (int)L; { const int q = nwg / NXCD, r = nwg % NXCD, xcd = wgid % NXCD, off = wgid / NXCD; wgid = (xcd < r ? xcd * (q + 1) : r * (q + 1) + (xcd - r) * q) + off; }
        const int nig = WGM * nN, gid = wgid / nig, fm = gid * WGM, gsz = (nM - fm) < WGM ? (nM - fm) : WGM;
        const int pm = fm + ((wgid % nig) % gsz), pn = (wgid % nig) / gsz;
        u.A = A + (size_t)pm * BM * pitch; u.B = B + (size_t)pn * BM * pitch; u.row0 = pm * BM; u.col0 = pn * BM; u.nr = BM; u.e = 0; u.lrow0 = 0; u.half = 0; return true;
    }
};
struct MoeOrder {
    const char* A; const char* B; const PG8_LAS int* fpre; const PG8_LAS int* hpre; const PG8_LAS int* ebase; int NPN, nUF, nU, G, c, pitch, N;
    __device__ __forceinline__ void init(const void* A_, const void* B_, const PG8_LAS int* tbl, int N_, int pitch_, int G_, int c_) {
        A = (const char*)A_; B = (const char*)B_; fpre = tbl; ebase = tbl + 36; hpre = tbl + 108; N = N_; NPN = N_ / BM; pitch = pitch_; G = G_; c = c_;
        nUF = __builtin_amdgcn_readfirstlane(fpre[32]) * NPN; nU = nUF + __builtin_amdgcn_readfirstlane(hpre[32]) * NPN; }
    __device__ __forceinline__ bool next(int i, Unit& u) const {
        const long L = (long)i * G + c; if (L >= nU) return false;
        const int ln = threadIdx.x & 31; int e, pn, mt, hf;
        if (L < nUF) {
            int wgid = (int)L; { const int q = nUF / NXCD, r = nUF % NXCD, xcd = wgid % NXCD, off = wgid / NXCD; wgid = (xcd < r ? xcd * (q + 1) : r * (q + 1) + (xcd - r) * q) + off; }
            const unsigned long long bal = __ballot(fpre[ln + 1] * NPN <= wgid); e = __builtin_popcount((unsigned)bal); e = e > 31 ? 31 : e;
            const int tp0 = __builtin_amdgcn_readfirstlane(fpre[e]), tp1 = __builtin_amdgcn_readfirstlane(fpre[e + 1]);
            const int q2 = wgid - tp0 * NPN, nt = tp1 - tp0; pn = q2 / nt; mt = q2 - pn * nt; hf = 0;
        } else {
            const int lh = (int)L - nUF, idx = lh / NPN; pn = lh - idx * NPN;
            const unsigned long long bal = __ballot(hpre[ln + 1] <= idx); e = __builtin_popcount((unsigned)bal); e = e > 31 ? 31 : e; hf = 1; mt = -1;
        }
        const int eb = __builtin_amdgcn_readfirstlane(ebase[e]), cnt = __builtin_amdgcn_readfirstlane(ebase[e + 1]) - eb;
        if (hf) mt = ((cnt + BM - 1) >> 8) - 1;
        u.row0 = eb + BM * mt; u.nr = min(BM, cnt - BM * mt); u.col0 = pn * BM; u.e = e; u.lrow0 = e * ELIST + BM * mt; u.half = hf;
        u.A = A + (size_t)u.row0 * pitch; u.B = B + ((size_t)e * N + (size_t)pn * BM) * pitch; return true;
    }
};

__device__ __forceinline__ unsigned cvt_pk_bf16(float lo, float hi) { unsigned r; asm volatile("v_cvt_pk_bf16_f32 %0, %1, %2" : "=v"(r) : "v"(lo), "v"(hi)); return r; }
__device__ __forceinline__ float gelu_fast(float x) { const float u = x * (1.5957691216f + 0.0713548163f * x * x); return x * __builtin_amdgcn_rcpf(1.f + __builtin_amdgcn_exp2f(-1.4426950409f * u)); }
__device__ __forceinline__ f32x4 gelu4(const f32x4 x) {
    const f32x4 t = x * (x * x * (-0.0713548163f * 1.4426950409f) + (-1.5957691216f * 1.4426950409f)); f32x4 d;
#pragma unroll
    for (int q = 0; q < 4; ++q) d[q] = __builtin_amdgcn_rcpf(1.f + __builtin_amdgcn_exp2f(t[q]));
    return x * d;
}
__device__ __forceinline__ float sigm_fast(float x) { return __builtin_amdgcn_rcpf(1.f + __builtin_amdgcn_exp2f(-1.4426950409f * x)); }

struct EpiInProj {
    static constexpr bool PERM = true; bf16_t* O;
    __device__ __forceinline__ void prefetch(const Unit&, int, int) const {}
    __device__ __forceinline__ void operator()(const f32x4 (&acc)[2][2][4][2], const Unit& u, int wr, int wc, int fr, int fq) const {
        const int row0 = u.row0 + wr * 64 + fr, col0 = u.col0 + wc * 32 + 8 * fq; const bool act = u.col0 >= 512;
#pragma unroll
        for (int ai = 0; ai < 2; ++ai)
#pragma unroll
            for (int m = 0; m < 4; ++m) { bf16_t* rowp = O + (size_t)(row0 + ai * HALF + m * 16) * NPROJ + col0;
#pragma unroll
                for (int bj = 0; bj < 2; ++bj) { f32x4 v0 = acc[ai][bj][m][0], v1 = acc[ai][bj][m][1];
                    if (act) { v0 = gelu4(v0); v1 = gelu4(v1); }
                    u32x4 w; w.x = cvt_pk_bf16(v0[0], v0[1]); w.y = cvt_pk_bf16(v0[2], v0[3]); w.z = cvt_pk_bf16(v1[0], v1[1]); w.w = cvt_pk_bf16(v1[2], v1[3]);
                    *(u32x4*)(rowp + bj * HALF) = w; } }
    }
};
struct EpiOutProj {
    static constexpr bool PERM = true; const float* mod; const bf16_t* XB; bf16_t* O;
    __device__ __forceinline__ void prefetch(const Unit&, int, int) const {}
    __device__ __forceinline__ void operator()(const f32x4 (&acc)[2][2][4][2], const Unit& u, int wr, int wc, int fr, int fq) const {
        const int row0 = u.row0 + wr * 64 + fr, col0 = u.col0 + wc * 32 + 8 * fq; const int b = u.row0 / SEQ;
        f32x4 g[2][2];
#pragma unroll
        for (int bj = 0; bj < 2; ++bj)
#pragma unroll
            for (int n = 0; n < 2; ++n) g[bj][n] = *(const f32x4*)(mod + b * 6144 + 2048 + col0 + bj * HALF + 4 * n);
#pragma unroll
        for (int ai = 0; ai < 2; ++ai) {
            u32x4 xr[4][2];
#pragma unroll
            for (int m = 0; m < 4; ++m)
#pragma unroll
                for (int bj = 0; bj < 2; ++bj) xr[m][bj] = __builtin_nontemporal_load((const u32x4*)(XB + (size_t)(row0 + ai * HALF + m * 16) * D + col0 + bj * HALF));
#pragma unroll
            for (int m = 0; m < 4; ++m) { bf16_t* rowp = O + (size_t)(row0 + ai * HALF + m * 16) * D + col0;
#pragma unroll
                for (int bj = 0; bj < 2; ++bj) { const u32x4 xw = xr[m][bj]; f32x4 v0 = acc[ai][bj][m][0] * g[bj][0], v1 = acc[ai][bj][m][1] * g[bj][1];
                    v0[0] += __builtin_bit_cast(float, xw.x << 16); v0[1] += __builtin_bit_cast(float, xw.x & 0xffff0000u); v0[2] += __builtin_bit_cast(float, xw.y << 16); v0[3] += __builtin_bit_cast(float, xw.y & 0xffff0000u);
                    v1[0] += __builtin_bit_cast(float, xw.z << 16); v1[1] += __builtin_bit_cast(float, xw.z & 0xffff0000u); v1[2] += __builtin_bit_cast(float, xw.w << 16); v1[3] += __builtin_bit_cast(float, xw.w & 0xffff0000u);
                    u32x4 w; w.x = cvt_pk_bf16(v0[0], v0[1]); w.y = cvt_pk_bf16(v0[2], v0[3]); w.z = cvt_pk_bf16(v1[0], v1[1]); w.w = cvt_pk_bf16(v1[2], v1[3]);
                    *(u32x4*)(rowp + bj * HALF) = w; } }
            asm volatile("" ::: "memory"); }
    }
};
__device__ __forceinline__ unsigned pk4_fp8(float a, float b, float c, float d) { int w = 0; w = __builtin_amdgcn_cvt_pk_fp8_f32(a, b, w, false); w = __builtin_amdgcn_cvt_pk_fp8_f32(c, d, w, true); return (unsigned)w; }
constexpr float W8_SCALE = 64.f, A8_SCALE = 4.f;
typedef unsigned u32x2 __attribute__((ext_vector_type(2)));
__device__ __forceinline__ u32x4 pair16(const u32x2 wA, const u32x2 wB, const bool) {
    const auto r0 = __builtin_amdgcn_permlane16_swap(wA.x, wB.x, false, false), r1 = __builtin_amdgcn_permlane16_swap(wA.y, wB.y, false, false);
    return (u32x4){(unsigned)r0[0], (unsigned)r1[0], (unsigned)r0[1], (unsigned)r1[1]};
}
struct EpiSwiglu {
    static constexpr bool PERM = true; const float* bgu; unsigned char* ACT; PG8_LAS unsigned char* epl;
    __device__ __forceinline__ void prefetch(const Unit& u, int wid, int lane) const {
        if (wid == 0) { const float* src = bgu + u.e * 2048 + (lane >= 32 ? 1024 : 0) + (u.col0 >> 1) + 4 * (lane & 31);
            __builtin_amdgcn_global_load_lds((const unsigned*)src, (PG8_LAS unsigned*)epl, 16, 0, 0); }
    }
    __device__ __forceinline__ void operator()(const f32x4 (&acc)[2][2][4][2], const Unit& u, int wr, int wc, int fr, int fq) const {
        asm volatile("" : "+v"(fr), "+v"(fq));
        const int jl = wc * 32 + 8 * fq, j0 = (u.col0 >> 1) + jl; const bool odd = (fq & 1) != 0;
        f32x4 bg[2], bl[2];
#pragma unroll
        for (int n = 0; n < 2; ++n) { bg[n] = *(const PG8_LAS f32x4*)(epl + (jl + 4 * n) * 4); bl[n] = *(const PG8_LAS f32x4*)(epl + 512 + (jl + 4 * n) * 4); }
#pragma unroll
        for (int ai = 0; ai < 2; ++ai) if (ai == 0 || !u.half)
#pragma unroll
            for (int mp = 0; mp < 2; ++mp) { u32x2 w2[2];
#pragma unroll
                for (int h = 0; h < 2; ++h) { const int m = 2 * mp + h; f32x4 o[2];
#pragma unroll
                    for (int n = 0; n < 2; ++n) { const f32x4 g = __builtin_elementwise_min(acc[ai][0][m][n] * (1.f / W8_SCALE) + bg[n], (f32x4){7.f, 7.f, 7.f, 7.f});
                        const f32x4 l = __builtin_elementwise_min(__builtin_elementwise_max(acc[ai][1][m][n] * (1.f / W8_SCALE) + bl[n], (f32x4){-7.f, -7.f, -7.f, -7.f}), (f32x4){7.f, 7.f, 7.f, 7.f});
                        const f32x4 ex = g * (-1.702f * 1.4426950409f); f32x4 den;
#pragma unroll
                        for (int q = 0; q < 4; ++q) den[q] = __builtin_amdgcn_rcpf(1.f + __builtin_amdgcn_exp2f(ex[q]));
                        o[n] = (g * A8_SCALE) * den * (l + 1.f); }
                    w2[h].x = pk4_fp8(o[0][0], o[0][1], o[0][2], o[0][3]); w2[h].y = pk4_fp8(o[1][0], o[1][1], o[1][2], o[1][3]); }
                const u32x4 o16 = pair16(w2[0], w2[1], odd);
                const int r = ai * HALF + wr * 64 + (2 * mp + (odd ? 1 : 0)) * 16 + fr;
                if (r < u.nr) *(u32x4*)(ACT + (size_t)(u.row0 + r) * D + j0 - (odd ? 8 : 0)) = o16; }
    }
};
constexpr float Y8_SCALE = 8.f;
struct EpiDown {
    static constexpr bool PERM = true; const float* bd; const float* gs; unsigned char* Y; PG8_LAS unsigned char* epl;
    __device__ __forceinline__ void prefetch(const Unit& u, int wid, int lane) const {
        if (wid == 0) __builtin_amdgcn_global_load_lds((const unsigned*)(bd + u.e * D + u.col0 + 4 * lane), (PG8_LAS unsigned*)epl, 16, 0, 0);
        if (wid == 1) __builtin_amdgcn_global_load_lds((const unsigned*)(gs + u.lrow0 + 4 * lane), (PG8_LAS unsigned*)(epl + 1024), 16, 0, 0);
    }
    __device__ __forceinline__ void operator()(const f32x4 (&acc)[2][2][4][2], const Unit& u, int wr, int wc, int fr, int fq) const {
        asm volatile("" : "+v"(fr), "+v"(fq));
        const int cl = wc * 32 + 8 * fq, col0 = u.col0 + cl; const bool odd = (fq & 1) != 0;
        f32x4 bv[2][2];
#pragma unroll
        for (int bj = 0; bj < 2; ++bj)
#pragma unroll
            for (int n = 0; n < 2; ++n) bv[bj][n] = *(const PG8_LAS f32x4*)(epl + (cl + bj * HALF + 4 * n) * 4);
#pragma unroll
        for (int ai = 0; ai < 2; ++ai) if (ai == 0 || !u.half)
#pragma unroll
            for (int mp = 0; mp < 2; ++mp) { const int rb = ai * HALF + wr * 64 + 2 * mp * 16 + fr;
                const float gA = *(const PG8_LAS float*)(epl + 1024 + rb * 4) * Y8_SCALE, gB = *(const PG8_LAS float*)(epl + 1024 + (rb + 16) * 4) * Y8_SCALE;
                const int r = rb + (odd ? 16 : 0); unsigned char* rowp = Y + (size_t)(u.row0 + r) * D + col0 - (odd ? 8 : 0);
#pragma unroll
                for (int bj = 0; bj < 2; ++bj) { u32x2 w2[2];
#pragma unroll
                    for (int h = 0; h < 2; ++h) { const int m = 2 * mp + h; const float gt = h ? gB : gA;
                        const f32x4 v0 = (acc[ai][bj][m][0] * (1.f / (W8_SCALE * A8_SCALE)) + bv[bj][0]) * gt, v1 = (acc[ai][bj][m][1] * (1.f / (W8_SCALE * A8_SCALE)) + bv[bj][1]) * gt;
                        w2[h].x = pk4_fp8(v0[0], v0[1], v0[2], v0[3]); w2[h].y = pk4_fp8(v1[0], v1[1], v1[2], v1[3]); }
                    const u32x4 o16 = pair16(w2[0], w2[1], odd);
                    if (r < u.nr) *(u32x4*)(rowp + bj * HALF) = o16; } }
    }
};

typedef int v4i_t __attribute__((ext_vector_type(4)));
typedef int v8i_t __attribute__((ext_vector_type(8)));
struct GatherA { const char* base; const int* tokl; PG8_LAS unsigned* rt; };
template <class Epi, class Sched, bool ALIGN_EPI, bool FP8 = false, bool GATHER = false>
__device__ __forceinline__ void gemm_phase(PG8_LAS unsigned char* lds, const int pitch, const Sched& S, const Epi& E, const GatherA ga = GatherA{nullptr, nullptr, nullptr}) {
    const int tid = threadIdx.x, wid = __builtin_amdgcn_readfirstlane(tid >> 6), lane = tid & 63, wr = wid >> 2, wc = wid & 3, fr = lane & 15, fq = lane >> 4;
    const int nt = pitch / (BK * 2);
    unsigned voffA[2], voffB[2];
#pragma unroll
    for (int i = 0; i < 2; ++i) { int R, C; stage_rc(tid * 16 + i * 8192, R, C); const int Rb = Epi::PERM ? ((R & ~31) + perm32(R & 31)) : R;
        voffA[i] = GATHER ? (unsigned)(R * 65536 + C * 2) : (unsigned)(R * pitch + C * 2); voffB[i] = (unsigned)(Rb * pitch + C * 2); }
    const size_t kstep = (size_t)(BK * 2);
    const size_t hstep = (size_t)HALF * pitch;
    const unsigned ldsw = (unsigned)wid * 1024u;
    const int aoff = lds_byte(wr * 64 + fr, fq * 8), boff = lds_byte(wc * 32 + fr, fq * 8);
#define PG8_SA(b, h) (((b) * 2 + (h)) * HTB)
#define PG8_SB(b, h) ((4 + (b) * 2 + (h)) * HTB)
#define PG8_STAGE(bufoff, gbase, voff) do { _Pragma("unroll") for (int _i = 0; _i < 2; ++_i) \
        __builtin_amdgcn_global_load_lds((const unsigned*)((const char*)(gbase) + (voff)[_i]), (PG8_LAS unsigned*)(lds + (bufoff) + ldsw + _i * 8192), 16, 0, 0); } while (0)
#define PG8_STAGE_A(bufoff, gbase, par, half, kt) do { if constexpr (GATHER) { _Pragma("unroll") for (int _i = 0; _i < 2; ++_i) { const unsigned _tk = min(ga.rt[(par) * 256 + (half) * 128 + (voffA[_i] >> 16)], (unsigned)(NTOK - 1)); \
            __builtin_amdgcn_global_load_lds((const unsigned*)(ga.base + (size_t)_tk * pitch + (voffA[_i] & 0xffffu) + (kt) * (BK * 2)), (PG8_LAS unsigned*)(lds + (bufoff) + ldsw + _i * 8192), 16, 0, 0); } } \
        else PG8_STAGE(bufoff, gbase, voffA); } while (0)
#define PG8_GA_LOAD(par, row0_) do { if constexpr (GATHER) { if (wid == 2) __builtin_amdgcn_global_load_lds((const unsigned*)(ga.tokl + (row0_) + 4 * lane), (PG8_LAS unsigned*)(ga.rt + (par) * 256), 16, 0, 0); } } while (0)
#define PG8_CAT8(x0, x1) __builtin_shufflevector(x0, x1, 0, 1, 2, 3, 4, 5, 6, 7)
#define PG8_LDA(dst, b, h) do { if constexpr (FP8) { _Pragma("unroll") for (int m = 0; m < 4; ++m) { const v4i_t x0 = *(const PG8_LAS v4i_t*)(lds + PG8_SA(b, h) + aoff + m * 2048), x1 = *(const PG8_LAS v4i_t*)(lds + PG8_SA(b, h) + aoff + m * 2048 + 1024); dst##8[m] = PG8_CAT8(x0, x1); } } \
    else { _Pragma("unroll") for (int m = 0; m < 4; ++m) _Pragma("unroll") for (int k = 0; k < 2; ++k) dst[m][k] = *(const PG8_LAS bf16x8*)(lds + PG8_SA(b, h) + aoff + m * 2048 + k * 1024); } } while (0)
#define PG8_LDB(dst, b, h) do { if constexpr (FP8) { _Pragma("unroll") for (int n = 0; n < 2; ++n) { const v4i_t x0 = *(const PG8_LAS v4i_t*)(lds + PG8_SB(b, h) + boff + n * 2048), x1 = *(const PG8_LAS v4i_t*)(lds + PG8_SB(b, h) + boff + n * 2048 + 1024); dst##8[n] = PG8_CAT8(x0, x1); } } \
    else { _Pragma("unroll") for (int n = 0; n < 2; ++n) _Pragma("unroll") for (int k = 0; k < 2; ++k) dst[n][k] = *(const PG8_LAS bf16x8*)(lds + PG8_SB(b, h) + boff + n * 2048 + k * 1024); } } while (0)
#define PG8_MMA(ai, bj, At, Bt) do { __builtin_amdgcn_s_setprio(1); _Pragma("unroll") for (int m = 0; m < 4; ++m) _Pragma("unroll") for (int n = 0; n < 2; ++n) { \
        if constexpr (FP8) { asm volatile("v_mfma_f32_16x16x128_f8f6f4 %0, %1, %2, %0" : "+v"(acc[ai][bj][m][n]) : "v"(Bt##8[n]), "v"(At##8[m])); } \
        else { _Pragma("unroll") for (int k = 0; k < 2; ++k) acc[ai][bj][m][n] = __builtin_amdgcn_mfma_f32_16x16x32_bf16(Bt[n][k], At[m][k], acc[ai][bj][m][n], 0, 0, 0); } } \
        __builtin_amdgcn_s_setprio(0); } while (0)
#define PG8_WAIT_V(n) asm volatile("s_waitcnt vmcnt(" #n ")" ::: "memory")
#define PG8_WAIT_L(n) asm volatile("s_waitcnt lgkmcnt(" #n ")" ::: "memory")
#define PG8_BAR __builtin_amdgcn_s_barrier()
#define PG8_SCHED __builtin_amdgcn_sched_barrier(0)
    Unit cur, nxt; int ui = 0;
    if (!S.next(0, cur)) return;
    f32x4 acc[2][2][4][2];
#pragma unroll
    for (int a = 0; a < 2; ++a)
#pragma unroll
        for (int b = 0; b < 2; ++b)
#pragma unroll
            for (int m = 0; m < 4; ++m)
#pragma unroll
                for (int n = 0; n < 2; ++n) acc[a][b][m][n] = (f32x4){0.f, 0.f, 0.f, 0.f};
    bf16x8 At[4][2], B0[2][2], B1[2][2]; v8i_t At8[4], B08[2], B18[2];
    const char* cA = cur.A; const char* cB = cur.B;
    if constexpr (GATHER) { PG8_GA_LOAD(0, cur.lrow0); PG8_WAIT_V(0); PG8_BAR; }
    PG8_STAGE(PG8_SB(0, 0), cB, voffB); PG8_STAGE(PG8_SB(0, 1), cB + hstep, voffB); PG8_STAGE_A(PG8_SA(0, 0), cA, 0, 0, 0); PG8_STAGE_A(PG8_SA(0, 1), cA + hstep, 0, 1, 0);
    if (wr == 1) PG8_BAR;
    PG8_WAIT_V(2); PG8_BAR;
    PG8_STAGE(PG8_SB(1, 0), cB + kstep, voffB); PG8_STAGE_A(PG8_SA(1, 0), cA + kstep, 0, 0, 1); PG8_STAGE(PG8_SB(1, 1), cB + hstep + kstep, voffB);
    PG8_WAIT_V(6); PG8_BAR;
    for (;;) {
        bool has_next = false; const char* nA = cA; const char* nB = cB; const bool hf = cur.half != 0;
        for (int t = 0; t < nt; t += 2) {
            const bool last = (t == nt - 2);
            if (t == 2) {
                has_next = S.next(ui + 1, nxt); nA = has_next ? nxt.A : cA; nB = has_next ? nxt.B : cB;
                if (GATHER && has_next) { PG8_GA_LOAD((ui & 1) ^ 1, nxt.lrow0); PG8_SCHED; } }
            const char* a1 = cA + (size_t)(t + 1) * kstep;
            const char* a2 = last ? nA : cA + (size_t)(t + 2) * kstep; const char* b2 = last ? nB : cB + (size_t)(t + 2) * kstep;
            const char* a3 = a2 + kstep; const char* b3 = b2 + kstep;
            const int pc = ui & 1, p2 = (last && has_next) ? (pc ^ 1) : pc, k2 = last ? 0 : t + 2;
            if (last) { E.prefetch(cur, wid, lane); PG8_SCHED; }
            PG8_LDB(B0, 0, 0); PG8_LDB(B1, 0, 1); PG8_SCHED; PG8_LDA(At, 0, 0); PG8_STAGE_A(PG8_SA(1, 1), a1 + hstep, pc, 1, t + 1);
            PG8_WAIT_V(8); PG8_WAIT_L(0); PG8_BAR; PG8_MMA(0, 0, At, B0); PG8_MMA(0, 1, At, B1); PG8_BAR; PG8_SCHED;
            if (!hf) PG8_LDA(At, 0, 1); PG8_STAGE(PG8_SB(0, 0), b2, voffB); PG8_STAGE(PG8_SB(0, 1), b2 + hstep, voffB); PG8_STAGE_A(PG8_SA(0, 0), a2, p2, 0, k2);
            PG8_WAIT_V(8); PG8_WAIT_L(0); PG8_BAR; if (!hf) { PG8_MMA(1, 0, At, B0); PG8_MMA(1, 1, At, B1); } PG8_BAR; PG8_SCHED;
            PG8_LDB(B0, 1, 0); PG8_LDB(B1, 1, 1); PG8_SCHED; PG8_LDA(At, 1, 0); PG8_STAGE_A(PG8_SA(0, 1), a2 + hstep, p2, 1, k2);
            PG8_WAIT_V(8); PG8_WAIT_L(0); PG8_BAR; PG8_MMA(0, 0, At, B0); PG8_MMA(0, 1, At, B1); PG8_BAR; PG8_SCHED;
            if (!hf) PG8_LDA(At, 1, 1); PG8_STAGE(PG8_SB(1, 0), b3, voffB); PG8_STAGE(PG8_SB(1, 1), b3 + hstep, voffB); PG8_STAGE_A(PG8_SA(1, 0), a3, p2, 0, k2 + 1);
            PG8_WAIT_V(8); PG8_WAIT_L(0); PG8_BAR; if (!hf) { PG8_MMA(1, 0, At, B0); PG8_MMA(1, 1, At, B1); } PG8_BAR; PG8_SCHED;
        }
        if constexpr (ALIGN_EPI) { if (wr == 0) PG8_BAR; }
        if constexpr (FP8) asm volatile("s_nop 15\n\ts_nop 15" ::: "memory");
        E(acc, cur, wr, wc, fr, fq);
        if (!has_next) break;
#pragma unroll
        for (int a = 0; a < 2; ++a)
#pragma unroll
            for (int b = 0; b < 2; ++b)
#pragma unroll
                for (int m = 0; m < 4; ++m)
#pragma unroll
                    for (int n = 0; n < 2; ++n) acc[a][b][m][n] = (f32x4){0.f, 0.f, 0.f, 0.f};
        cur = nxt; cA = nA; cB = nB; ++ui;
        if constexpr (ALIGN_EPI) { if (wr == 1) PG8_BAR; }
    }
    PG8_WAIT_V(0);
    if constexpr (!ALIGN_EPI) { if (wr == 0) PG8_BAR; }
    PG8_BAR;
#undef PG8_SA
#undef PG8_SB
#undef PG8_STAGE
#undef PG8_STAGE_A
#undef PG8_GA_LOAD
#undef PG8_LDA
#undef PG8_LDB
#undef PG8_MMA
#undef PG8_CAT8
#undef PG8_WAIT_V
#undef PG8_WAIT_L
#undef PG8_BAR
#undef PG8_SCHED
}
}

constexpr int RING_OFF = 0, RING_BYTES = 131072;
constexpr int MISC_OFF = 143360, TBL_OFF = MISC_OFF + 256, EPI_OFF = MISC_OFF + 1024;
constexpr int _unused_tbl = 0;
constexpr int RT_OFF = 146432;
constexpr int LDS_BYTES = 151552;
constexpr int NWAVES = 8;

#define GAS __attribute__((address_space(1)))
#define LAS __attribute__((address_space(3)))
typedef unsigned v4u __attribute__((ext_vector_type(4)));
typedef unsigned v2u __attribute__((ext_vector_type(2)));
typedef float f32x4 __attribute__((ext_vector_type(4)));
typedef short bf16x8 __attribute__((ext_vector_type(8)));
typedef short bf16x4 __attribute__((ext_vector_type(4)));
typedef GAS unsigned gu32;
#define RLX_AGENT __ATOMIC_RELAXED, __HIP_MEMORY_SCOPE_AGENT
#define LDS_WAIT() asm volatile("s_waitcnt lgkmcnt(0)" ::: "memory")
#define VM_WAIT() asm volatile("s_waitcnt vmcnt(0)" ::: "memory")
__device__ __forceinline__ unsigned pk2(float lo, float hi) { unsigned r; asm("v_cvt_pk_bf16_f32 %0, %1, %2" : "=v"(r) : "v"(lo), "v"(hi)); return r; }
__device__ __forceinline__ bf16 f2bf1(float x) { return (bf16)(pk2(x, x) & 0xffffu); }
__device__ __forceinline__ float bflo(unsigned w) { return __builtin_bit_cast(float, w << 16); }
__device__ __forceinline__ float bfhi(unsigned w) { return __builtin_bit_cast(float, w & 0xffff0000u); }

#define XB_TMO      128
#define XB_XCNT(j)  (256  + 64 * (j))
#define XB_XSUB(j)  (1280 + 64 * (j))
#define XB_XGEN(j)  (2304 + 64 * (j))
#define XB_TOP      3328
#define XB_TOPGEN   3392
#define XCD_BAR_WORDS 3456
#define XB_SPIN_CAP (1u << 18)
__device__ __forceinline__ unsigned xb_ld(unsigned* p)              { return __hip_atomic_load(p, __ATOMIC_RELAXED, __HIP_MEMORY_SCOPE_AGENT); }
__device__ __forceinline__ unsigned xb_add(unsigned* p, unsigned v) { return __hip_atomic_fetch_add(p, v, __ATOMIC_RELAXED, __HIP_MEMORY_SCOPE_AGENT); }
__device__ __forceinline__ unsigned xb_xcc_id() { return (unsigned)__builtin_amdgcn_s_getreg((3 << 11) | 20) & 0xFu; }
#define XB_SPIN(cond, bar) do { unsigned _sp = 0; while (cond) { __builtin_amdgcn_s_sleep(1); \
    if ((++_sp & 255u) == 0u) { if (xb_ld(&(bar)[XB_TMO])) break; if (_sp > XB_SPIN_CAP) { atomicAdd(&(bar)[XB_TMO], 1u); break; } } } } while (0)
struct XcdBarrier { unsigned* bar; unsigned x; volatile LAS unsigned* st; };
__device__ __forceinline__ XcdBarrier xcd_barrier_post(unsigned* bar, volatile LAS unsigned* st) {
    XcdBarrier b; b.bar = bar; b.x = xb_xcc_id(); b.st = st;
    if (threadIdx.x == 0) (void)xb_add(&bar[XB_XCNT(b.x)], 1u);
    return b;
}
__device__ __forceinline__ void xcd_barrier_complete(unsigned* bar, unsigned x, unsigned& nloc, unsigned& nx) {
    const unsigned G = gridDim.x * gridDim.y * gridDim.z;
    unsigned sum, cnt, mine, sp = 0u;
    for (;;) {
        sum = 0u; cnt = 0u; mine = 0u;
#pragma unroll
        for (unsigned j = 0; j < 16; ++j) { const unsigned c = xb_ld(&bar[XB_XCNT(j)]); sum += c; cnt += (c > 0u) ? 1u : 0u; mine = (j == x) ? c : mine; }
        if (sum == G) break;
        __builtin_amdgcn_s_sleep(1);
        if ((++sp & 255u) == 0u) { if (xb_ld(&bar[XB_TMO])) break; if (sp > XB_SPIN_CAP) { atomicAdd(&bar[XB_TMO], 1u); break; } }
    }
    nloc = mine > 0u ? mine : 1u; nx = cnt > 0u ? cnt : 1u;
}
__device__ __attribute__((noinline)) void xcd_barrier(unsigned* bar_, unsigned x_, volatile LAS unsigned* st_) {
    XcdBarrier b; b.bar = bar_; b.x = x_; b.st = st_;
    asm volatile("s_waitcnt vmcnt(0)" ::: "memory");
    __syncthreads();
    if (threadIdx.x == 0) {
        unsigned* bar = b.bar;
        __builtin_amdgcn_s_waitcnt(0);
        unsigned nloc = b.st[0], nx = b.st[1];
        if (nloc == 0u) { xcd_barrier_complete(bar, b.x, nloc, nx); b.st[0] = nloc; b.st[1] = nx; }
        const unsigned old = xb_add(&bar[XB_XSUB(b.x)], 1u);
        const unsigned gen = old / nloc;
        if (old + 1u == (gen + 1u) * nloc) {
            __builtin_amdgcn_fence(__ATOMIC_RELEASE, "agent");
            asm volatile("s_waitcnt vmcnt(0)" ::: "memory");
            const unsigned og = xb_add(&bar[XB_TOP], 1u);
            const unsigned tg = og / nx;
            if (og + 1u == (tg + 1u) * nx) xb_add(&bar[XB_TOPGEN], 1u);
            else XB_SPIN(xb_ld(&bar[XB_TOPGEN]) == tg, bar);
            __builtin_amdgcn_fence(__ATOMIC_ACQUIRE, "agent");
            xb_add(&bar[XB_XGEN(b.x)], 1u);
            asm volatile("s_waitcnt vmcnt(0)" ::: "memory");
        } else {
            XB_SPIN(xb_ld(&bar[XB_XGEN(b.x)]) == gen, bar);
            __builtin_amdgcn_fence(__ATOMIC_ACQUIRE, "agent");
            asm volatile("s_waitcnt vmcnt(0)" ::: "memory");
        }
    }
    __syncthreads();
}

struct Args { const float* in[28]; float* out; unsigned char* ws; int ph_lo, ph_hi, li, pad; };
enum { I_X = 0, I_C, I_ADAW, I_ADAB, I_N1G, I_WIN, I_CONVW, I_CONVB, I_WR, I_BR, I_WI, I_BI, I_LAM, I_LNG, I_LNB, I_SGUW, I_SGUB, I_GNL, I_GNS, I_WOUT, I_N2G, I_RW, I_RB, I_WGU, I_BGU, I_WDN, I_BDN, I_FG };
constexpr int NPH = 11;

template <int CTRL> __device__ __forceinline__ float dppf(float v) { return __builtin_bit_cast(float, __builtin_amdgcn_update_dpp(0, __builtin_bit_cast(int, v), CTRL, 0xF, 0xF, true)); }
__device__ __forceinline__ float xor16f(float v, float& own) { const unsigned a = __builtin_bit_cast(unsigned, v); const auto r = __builtin_amdgcn_permlane16_swap(a, a, false, false); own = __builtin_bit_cast(float, (unsigned)r[0]); return __builtin_bit_cast(float, (unsigned)r[1]); }
__device__ __forceinline__ float xor32f(float v, float& own) { const unsigned a = __builtin_bit_cast(unsigned, v); const auto r = __builtin_amdgcn_permlane32_swap(a, a, false, false); own = __builtin_bit_cast(float, (unsigned)r[0]); return __builtin_bit_cast(float, (unsigned)r[1]); }
__device__ __forceinline__ float sum32(float v) {
    v += dppf<0xB1>(v); v += dppf<0x4E>(v); v += dppf<0x141>(v); v += dppf<0x140>(v); float o; const float p = xor16f(v, o); return o + p; }
__device__ __forceinline__ float max32(float v) {
    v = fmaxf(v, dppf<0xB1>(v)); v = fmaxf(v, dppf<0x4E>(v)); v = fmaxf(v, dppf<0x141>(v)); v = fmaxf(v, dppf<0x140>(v)); float o; const float p = xor16f(v, o); return fmaxf(o, p); }
__device__ __forceinline__ float wave_sum(float v) { v = sum32(v); float o; const float p = xor32f(v, o); return o + p; }

struct P0Item { const float* src; size_t step; unsigned char* dst; const float* ksc; int k0, kind; };
__device__ __forceinline__ void p0_load(f32x4 (&v)[16], const P0Item& it) {
#pragma unroll
    for (int i = 0; i < 16; ++i) v[i] = __builtin_nontemporal_load((const f32x4*)(it.src + (size_t)i * it.step));
}
__device__ __forceinline__ void p0_process(const f32x4 (&v)[16], const P0Item& it, LAS float* scr, int lane) {
    if (it.kind == 0) {
#pragma unroll
        for (int i = 0; i < 16; ++i) { const int kk = 4 * i + (lane >> 4); f32x4 w = v[i];
            if (it.ksc) w = w * it.ksc[it.k0 + kk];
            LAS float* d = scr + kk * 65 + 4 * (lane & 15); d[0] = w.x; d[1] = w.y; d[2] = w.z; d[3] = w.w; }
        LDS_WAIT();
        const int c = lane & 7;
#pragma unroll
        for (int j = 0; j < 8; ++j) { const int n = (lane >> 3) + 8 * j; const LAS float* s = scr + (8 * c) * 65 + n;
            v4u o; o.x = pk2(s[0 * 65], s[1 * 65]); o.y = pk2(s[2 * 65], s[3 * 65]); o.z = pk2(s[4 * 65], s[5 * 65]); o.w = pk2(s[6 * 65], s[7 * 65]);
            *(v4u*)(it.dst + ((size_t)n * D + it.k0 + 8 * c) * 2) = o; }
        LDS_WAIT();
    } else {
#pragma unroll
        for (int i = 0; i < 16; ++i) { const int kk = 8 * i + (lane >> 3); const f32x4 w = v[i] * pg8::W8_SCALE;
            LAS float* d = scr + kk * 33 + 4 * (lane & 7); d[0] = w.x; d[1] = w.y; d[2] = w.z; d[3] = w.w; }
        LDS_WAIT();
#pragma unroll
        for (int j = 0; j < 8; ++j) { const int n = (lane & 7) + 8 * (j & 3), c = (lane >> 3) + 8 * (j >> 2); const LAS float* s = scr + (8 * c) * 33 + n;
            v2u o; o.x = pg8::pk4_fp8(s[0 * 33], s[1 * 33], s[2 * 33], s[3 * 33]); o.y = pg8::pk4_fp8(s[4 * 33], s[5 * 33], s[6 * 33], s[7 * 33]);
            *(v2u*)(it.dst + (size_t)n * D + it.k0 + 8 * c) = o; }
        LDS_WAIT();
    }
}
__device__ __forceinline__ void p0_prologue(const Args& a, LAS unsigned char* lds, int tid, int lane, int wave, int vcu, int G) {
    unsigned char* ws = a.ws;
    for (int u = vcu; u < 256; u += G) {
        const int cb = u & 15, ks = u >> 4;
        if (tid < 384) { const int col = cb * 384 + tid; float a0 = 0.f, a1 = 0.f, a2 = 0.f, a3 = 0.f; const float* cc = a.in[I_C];
            for (int k = 0; k < 64; ++k) { const int kk = ks * 64 + k; const float w = a.in[I_ADAW][(size_t)kk * 6144 + col];
                const float c0 = cc[kk], c1 = cc[1024 + kk], c2 = cc[2048 + kk], c3 = cc[3072 + kk];
                a0 += c0 * sigmoidf_(c0) * w; a1 += c1 * sigmoidf_(c1) * w; a2 += c2 * sigmoidf_(c2) * w; a3 += c3 * sigmoidf_(c3) * w; }
            float* mp = (float*)(ws + WS_MODP) + (size_t)(ks * 4) * 6144 + col;
            mp[0] = a0; mp[6144] = a1; mp[2 * 6144] = a2; mp[3 * 6144] = a3; }
    }
    for (int j = vcu; j < 48; j += G) {
        if (j < 16) { const int m = j >> 3, h = j & 7; const float* src = a.in[m ? I_WI : I_WR] + h * 4096; bf16* dst = (bf16*)(ws + WS_WRT) + (m * 8 + h) * 4096;
            for (int idx = tid; idx < 4096; idx += 512) { const int o = idx >> 6, i = idx & 63; dst[idx] = (bf16)f2bf(src[i * 64 + o]); } }
        else { const int q = j - 16; bf16* dst = (bf16*)(ws + WS_WM);
            for (int idx = q * 4096 + tid; idx < (q + 1) * 4096; idx += 512) { const int t = (idx >> 7) & 127, s = idx & 127; dst[idx] = s <= t ? (bf16)f2bf(a.in[I_SGUW][idx]) : (bf16)0; } }
    }
    LAS float* scr = (LAS float*)(lds + wave * 16896);
    const int gw = vcu * NWAVES + wave, NGW = G * NWAVES;
    constexpr int I_IN = 16 * 32, I_OUT = 16 * 16, I_GU = 32 * 16 * 32, I_DN = 32 * 16 * 16, NITEMS = I_IN + I_OUT + I_GU + I_DN;
    const float* pWIN = a.in[I_WIN]; const float* pWOUT = a.in[I_WOUT]; const float* pWGU = a.in[I_WGU]; const float* pWDN = a.in[I_WDN]; const float* pGNL = a.in[I_GNL]; const float* pGNS = a.in[I_GNS];
    auto decode = [&](int it0, P0Item& o) {
        int r = it0;
        if (r < I_IN) { const int kb = r >> 5, nb = r & 31; o.kind = 0; o.k0 = 64 * kb; o.ksc = nullptr;
            o.src = pWIN + (size_t)(64 * kb + (lane >> 4)) * NPROJ + 64 * nb + 4 * (lane & 15); o.step = (size_t)4 * NPROJ; o.dst = ws + WS_WINT + (size_t)(64 * nb) * D * 2; return; }
        r -= I_IN;
        if (r < I_OUT) { const int kb = r >> 4, nb = r & 15; o.kind = 0; o.k0 = 64 * kb; o.ksc = o.k0 < DL ? pGNL : pGNS - DL;
            o.src = pWOUT + (size_t)(64 * kb + (lane >> 4)) * D + 64 * nb + 4 * (lane & 15); o.step = (size_t)4 * D; o.dst = ws + WS_WOUTT + (size_t)(64 * nb) * D * 2; return; }
        r -= I_OUT;
        if (r < I_GU) { const int e = r >> 9, q = r & 511, kb = q >> 6, nb = q & 63; const int n0 = 32 * nb, n1 = n0 & 1023; const int rd = (n1 >> 7) * 256 + (n0 >= 1024 ? 128 : 0) + (n1 & 127);
            o.kind = 1; o.k0 = 128 * kb; o.ksc = nullptr;
            o.src = pWGU + (size_t)e * D * 2048 + (size_t)(128 * kb + (lane >> 3)) * 2048 + n0 + 4 * (lane & 7); o.step = (size_t)8 * 2048; o.dst = ws + WS_WGUT + ((size_t)e * 2048 + rd) * D; return; }
        r -= I_GU;
        { const int e = r >> 8, q = r & 255, kb = q >> 5, nb = q & 31; o.kind = 1; o.k0 = 128 * kb; o.ksc = nullptr;
            o.src = pWDN + (size_t)e * D * D + (size_t)(128 * kb + (lane >> 3)) * D + 32 * nb + 4 * (lane & 7); o.step = (size_t)8 * D; o.dst = ws + WS_WDNT + ((size_t)e * D + 32 * nb) * D; }
    };
    int it = gw;
    if (it < NITEMS) {
        P0Item cur; f32x4 vc[16]; decode(it, cur); p0_load(vc, cur);
        for (;;) {
            const int itn = it + NGW; const bool more = itn < NITEMS;
            P0Item nxt = cur; f32x4 vn[16];
            if (more) { decode(itn, nxt); p0_load(vn, nxt); }
            p0_process(vc, cur, scr, lane);
            if (!more) break;
            cur = nxt; it = itn;
#pragma unroll
            for (int i = 0; i < 16; ++i) vc[i] = vn[i];
        }
    }
}
__device__ __forceinline__ void p1_modz(const Args& a, LAS unsigned char* lds, int tid, int lane, int wave, int vcu, int G) {
    const float* modp = (const float*)(a.ws + WS_MODP); float* mod = (float*)(a.ws + WS_MOD); bf16* Z = (bf16*)(a.ws + WS_Z); bf16* XB = (bf16*)(a.ws + WS_XB);
    for (int idx = vcu * 512 + tid; idx < 4 * 6144; idx += G * 512) { const int b = idx / 6144, n = idx - b * 6144; float s = a.in[I_ADAB][n];
#pragma unroll
        for (int ks = 0; ks < 16; ++ks) s += modp[(size_t)(ks * 4 + b) * 6144 + n];
        mod[idx] = s; }
    const int wpb = G / 4, b = vcu / wpb;
    LAS float* SHs = (LAS float*)lds; LAS float* SCs = (LAS float*)(lds + 4096);
    for (int k = tid; k < 2048; k += 512) { float s = a.in[I_ADAB][k];
#pragma unroll
        for (int ks = 0; ks < 16; ++ks) s += modp[(size_t)(ks * 4 + b) * 6144 + k];
        if (k < 1024) SHs[k] = s; else SCs[k - 1024] = (1.f + s) * a.in[I_N1G][k - 1024]; }
    __syncthreads();
    const int lw = (vcu - b * wpb) * NWAVES + wave, nlw = wpb * NWAVES;
#ifndef P1_NR
#define P1_NR 4
#endif
    for (int t = lw; t < SEQ; t += P1_NR * nlw) {
        f32x4 v[P1_NR][4]; float s[P1_NR];
#pragma unroll
        for (int q = 0; q < P1_NR; ++q) { const int tq_ = min(t + q * nlw, SEQ - 1); const f32x4* xr = (const f32x4*)(a.in[I_X] + ((size_t)b * SEQ + tq_) * D) + lane;
#pragma unroll
            for (int j = 0; j < 4; ++j) v[q][j] = __builtin_nontemporal_load(xr + 64 * j); }
#pragma unroll
        for (int q = 0; q < P1_NR; ++q) { s[q] = 0.f;
#pragma unroll
            for (int j = 0; j < 4; ++j) s[q] += (v[q][j].x * v[q][j].x + v[q][j].y * v[q][j].y) + (v[q][j].z * v[q][j].z + v[q][j].w * v[q][j].w);
            s[q] = rsqrtf(wave_sum(s[q]) * (1.f / D) + EPS); }
#pragma unroll
        for (int q = 0; q < P1_NR; ++q) if (t + q * nlw < SEQ) { v2u* o8 = (v2u*)(Z + ((size_t)b * SEQ + t + q * nlw) * D) + lane; v2u* x8 = (v2u*)(XB + ((size_t)b * SEQ + t + q * nlw) * D) + lane;
#pragma unroll
            for (int j = 0; j < 4; ++j) { const f32x4 g = *(const LAS f32x4*)(SCs + 4 * lane + 256 * j), sh = *(const LAS f32x4*)(SHs + 4 * lane + 256 * j); const f32x4 z = v[q][j] * s[q] * g + sh;
                v2u w; w.x = pk2(z.x, z.y); w.y = pk2(z.z, z.w); o8[64 * j] = w;
                v2u xw; xw.x = pk2(v[q][j].x, v[q][j].y); xw.y = pk2(v[q][j].z, v[q][j].w); x8[64 * j] = xw; } }
    }
    __syncthreads();
}
constexpr int XS = 516;
template <bool PASSB>
__device__ __forceinline__ void lru_unit(const Args& a, LAS unsigned char* lds, int tid, int lane, int wave, int unit) {
    const int b = unit >> 6, tb = unit & 63; const size_t row0 = (size_t)b * SEQ + tb * 64;
    const bf16* P = (const bf16*)(a.ws + WS_PROJ); float* agg = (float*)(a.ws + WS_AGG); bf16* HEADS = (bf16*)(a.ws + WS_HEADS); unsigned* phg = (unsigned*)(a.ws + WS_O32);
    LAS float* xcf = (LAS float*)lds; LAS float* Al = (LAS float*)(lds + 33280); LAS float* Bl = (LAS float*)(lds + 66560);
    LAS float* cst = (LAS float*)(lds + 99840); LAS float* rsl = (LAS float*)(lds + 105984);
    const int ch = tid, h = wave, tq = lane & 15, kq = lane >> 4;
    bf16 xan[16], yan[16];
#pragma unroll
    for (int i = 0; i < 16; ++i) { xan[i] = __builtin_nontemporal_load(P + (row0 + i) * NPROJ + ch); if (PASSB) yan[i] = P[(row0 + i) * NPROJ + 512 + ch]; }
    const float cw0 = a.in[I_CONVW][ch], cw1 = a.in[I_CONVW][DL + ch], cw2 = a.in[I_CONVW][2 * DL + ch], cw3 = a.in[I_CONVW][3 * DL + ch], cb = a.in[I_CONVB][ch];
    cst[ch] = a.in[I_BR][ch]; cst[512 + ch] = a.in[I_BI][ch]; cst[1024 + ch] = log1pf(expf(-a.in[I_LAM][ch]));
    bf16x8 wrf[4][2], wif[4][2];
    { const bf16* wrt = (const bf16*)(a.ws + WS_WRT) + h * 4096; const bf16* wit = wrt + 8 * 4096;
#pragma unroll
      for (int ct = 0; ct < 4; ++ct)
#pragma unroll
          for (int ks = 0; ks < 2; ++ks) { const int off = (16 * ct + tq) * 64 + ks * 32 + 8 * kq; wrf[ct][ks] = *(const bf16x8*)(wrt + off); wif[ct][ks] = *(const bf16x8*)(wit + off); } }
    float x1 = 0.f, x2 = 0.f, x3 = 0.f;
    if (tb > 0) { x1 = bf2f(P[(row0 - 1) * NPROJ + ch]); x2 = bf2f(P[(row0 - 2) * NPROJ + ch]); x3 = bf2f(P[(row0 - 3) * NPROJ + ch]); }
    float hs = 0.f, pp = 1.f;
    if (PASSB) { const float* ag = agg + ((size_t)(b * 64) * 512 + ch) * 2;
        for (int c0 = 0; c0 < tb; c0 += 32) { float2 ph[32];
#pragma unroll
            for (int j = 0; j < 32; ++j) { ph[j].x = 1.f; ph[j].y = 0.f; if (c0 + j < tb) ph[j] = *(const float2*)(ag + (size_t)(c0 + j) * 1024); }
#pragma unroll
            for (int j = 0; j < 32; ++j) hs = ph[j].x * hs + ph[j].y; } }
    __syncthreads();
    for (int sub = 0; sub < 4; ++sub) {
        const size_t r0 = row0 + sub * 16;
        float xav[16], o[16];
#pragma unroll
        for (int i = 0; i < 16; ++i) { xav[i] = bf2f(xan[i]); if (PASSB) o[i] = bf2f(yan[i]); }
        if (sub < 3) {
#pragma unroll
            for (int i = 0; i < 16; ++i) { xan[i] = __builtin_nontemporal_load(P + (r0 + 16 + i) * NPROJ + ch); if (PASSB) yan[i] = P[(r0 + 16 + i) * NPROJ + 512 + ch]; } }
#pragma unroll
        for (int i = 0; i < 16; ++i) { const float xa = xav[i]; xcf[i * XS + ch] = cw0 * x3 + cw1 * x2 + cw2 * x1 + cw3 * xa + cb; x3 = x2; x2 = x1; x1 = xa; }
        __syncthreads();
        {
            bf16x8 xb[2];
#pragma unroll
            for (int ks = 0; ks < 2; ++ks) { const LAS float* p = xcf + tq * XS + h * 64 + ks * 32 + 8 * kq; const f32x4 lo = *(const LAS f32x4*)p, hi = *(const LAS f32x4*)(p + 4);
                const v4u w = {pk2(lo.x, lo.y), pk2(lo.z, lo.w), pk2(hi.x, hi.y), pk2(hi.z, hi.w)}; xb[ks] = __builtin_bit_cast(bf16x8, w); }
#pragma unroll
            for (int ct = 0; ct < 4; ++ct) { f32x4 rec = {0.f, 0.f, 0.f, 0.f}, inp = {0.f, 0.f, 0.f, 0.f};
#pragma unroll
                for (int ks = 0; ks < 2; ++ks) { rec = __builtin_amdgcn_mfma_f32_16x16x32_bf16(wrf[ct][ks], xb[ks], rec, 0, 0, 0); inp = __builtin_amdgcn_mfma_f32_16x16x32_bf16(wif[ct][ks], xb[ks], inp, 0, 0, 0); }
                const int cbase = h * 64 + 16 * ct + 4 * kq;
                const f32x4 xc4 = *(const LAS f32x4*)(xcf + tq * XS + cbase), br4 = *(const LAS f32x4*)(cst + cbase), bi4 = *(const LAS f32x4*)(cst + 512 + cbase), sp4 = *(const LAS f32x4*)(cst + 1024 + cbase);
                f32x4 av, bt;
                {
                    const f32x4 er = (rec + br4) * (-1.4426950409f), ei = (inp + bi4) * (-1.4426950409f); f32x4 rr, ig;
#pragma unroll
                    for (int r = 0; r < 4; ++r) { rr[r] = __builtin_amdgcn_rcpf(1.f + __builtin_amdgcn_exp2f(er[r])); ig[r] = __builtin_amdgcn_rcpf(1.f + __builtin_amdgcn_exp2f(ei[r])); }
                    const f32x4 la = rr * sp4 * (-8.f), y = la * 2.f, l2 = la * 1.4426950409f;
#pragma unroll
                    for (int r = 0; r < 4; ++r) av[r] = __builtin_amdgcn_exp2f(l2[r]);
                    const f32x4 ser = -y * (y * (y * (y * (y * 0.0083333338f + 0.041666668f) + 0.16666667f) + 0.5f) + 1.f), big = (f32x4){1.f, 1.f, 1.f, 1.f} - av * av; f32x4 em;
#pragma unroll
                    for (int r = 0; r < 4; ++r) em[r] = __builtin_amdgcn_sqrtf(y[r] > -0.25f ? ser[r] : big[r]);
                    bt = em * ig * xc4; }
                *(LAS f32x4*)(Al + tq * XS + cbase) = av; *(LAS f32x4*)(Bl + tq * XS + cbase) = bt; }
        }
        __syncthreads();
#pragma unroll
        for (int i = 0; i < 16; ++i) { const float av = Al[i * XS + ch], bt = Bl[i * XS + ch]; hs = av * hs + bt; if (PASSB) o[i] *= hs; else { pp *= av; phg[(r0 + i) * 512 + ch] = pk2(pp, hs); } }
        if (PASSB) {
#pragma unroll
            for (int i = 0; i < 16; ++i) Al[i * XS + ch] = o[i];
            __syncthreads();
            { const int t = tid >> 5, part = tid & 31; float s = 0.f;
#pragma unroll
              for (int j = 0; j < 16; ++j) { const float v = Al[t * XS + part + 32 * j]; s += v * v; }
              s = sum32(s);
              if (part == 0) rsl[t] = rsqrtf(s * (1.f / 512.f) + EPS); }
            __syncthreads();
#pragma unroll
            for (int i = 0; i < 16; ++i) HEADS[(r0 + i) * D + ch] = f2bf1(o[i] * rsl[i]);
        }
        __syncthreads();
    }
    if (!PASSB) { float2 ph; ph.x = pp; ph.y = hs; *(float2*)(agg + ((size_t)(b * 64 + tb) * 512 + ch) * 2) = ph; }
}
__device__ __forceinline__ void lru_passb_unit(const Args& a, LAS unsigned char* lds, int tid, int lane, int wave, int unit) {
    const int b = unit >> 6, tb = unit & 63; const size_t row0 = (size_t)b * SEQ + tb * 64;
    const bf16* P = (const bf16*)(a.ws + WS_PROJ); const float* agg = (const float*)(a.ws + WS_AGG); bf16* HEADS = (bf16*)(a.ws + WS_HEADS); const unsigned* phg = (const unsigned*)(a.ws + WS_O32);
    LAS float* ol = (LAS float*)lds; LAS float* rsl = (LAS float*)(lds + 33280);
    const int ch = tid;
    unsigned phn[16]; bf16 yan[16];
#pragma unroll
    for (int i = 0; i < 16; ++i) { phn[i] = __builtin_nontemporal_load(phg + (row0 + i) * 512 + ch); yan[i] = __builtin_nontemporal_load(P + (row0 + i) * NPROJ + 512 + ch); }
    float carry = 0.f;
    { const float* ag = agg + ((size_t)(b * 64) * 512 + ch) * 2;
      for (int c0 = 0; c0 < tb; c0 += 32) { float2 ph[32];
#pragma unroll
          for (int j = 0; j < 32; ++j) { ph[j].x = 1.f; ph[j].y = 0.f; if (c0 + j < tb) ph[j] = *(const float2*)(ag + (size_t)(c0 + j) * 1024); }
#pragma unroll
          for (int j = 0; j < 32; ++j) carry = ph[j].x * carry + ph[j].y; } }
    for (int sub = 0; sub < 4; ++sub) {
        const size_t r0 = row0 + sub * 16; float o[16];
#pragma unroll
        for (int i = 0; i < 16; ++i) o[i] = (bfhi(phn[i]) + bflo(phn[i]) * carry) * bf2f(yan[i]);
        if (sub < 3) {
#pragma unroll
            for (int i = 0; i < 16; ++i) { phn[i] = __builtin_nontemporal_load(phg + (r0 + 16 + i) * 512 + ch); yan[i] = __builtin_nontemporal_load(P + (r0 + 16 + i) * NPROJ + 512 + ch); } }
#pragma unroll
        for (int i = 0; i < 16; ++i) ol[i * XS + ch] = o[i];
        __syncthreads();
        { const int t = tid >> 5, part = tid & 31; float sq = 0.f;
#pragma unroll
          for (int j = 0; j < 16; ++j) { const float v = ol[t * XS + part + 32 * j]; sq += v * v; }
          sq = sum32(sq);
          if (part == 0) rsl[t] = rsqrtf(sq * (1.f / 512.f) + EPS); }
        __syncthreads();
#pragma unroll
        for (int i = 0; i < 16; ++i) HEADS[(r0 + i) * D + ch] = f2bf1(o[i] * rsl[i]);
        __syncthreads();
    }
}
__device__ __forceinline__ void sgu_unit(const Args& a, LAS unsigned char* lds, int tid, int lane, int wave, int unit) {
    constexpr int RS = 132;
    const int th = unit & 1, bn = unit >> 1, Ks = 64 * (th + 1); const size_t rowbase = (size_t)bn * CHUNK;
    const bf16* P = (const bf16*)(a.ws + WS_PROJ); bf16* HEADS = (bf16*)(a.ws + WS_HEADS); const bf16* WM = (const bf16*)(a.ws + WS_WM);
    LAS bf16* vnT = (LAS bf16*)lds; LAS float* ssq = (LAS float*)(lds + 135168);
    bf16x8 wfr[4][4];
    { const bf16* wmh0 = WM + (size_t)wave * 16384 + (size_t)(64 * th + (lane & 15)) * 128 + 8 * (lane >> 4);
#pragma unroll
      for (int rt = 0; rt < 4; ++rt)
#pragma unroll
          for (int ks = 0; ks < 4; ++ks) { wfr[rt][ks] = (bf16x8){0, 0, 0, 0, 0, 0, 0, 0}; if (32 * ks < Ks && 32 * ks <= 64 * th + 16 * rt + 15) wfr[rt][ks] = *(const bf16x8*)(wmh0 + rt * 16 * 128 + 32 * ks); } }
    {
        float lg[8], lb[8];
#pragma unroll
        for (int j = 0; j < 8; ++j) { lg[j] = a.in[I_LNG][lane + 64 * j]; lb[j] = a.in[I_LNB][lane + 64 * j]; }
        for (int s8 = 8 * wave; s8 < Ks; s8 += 8 * NWAVES) { float v[8][8]; float mean[8], rstd[8];
#pragma unroll
            for (int q = 0; q < 8; ++q) { const bf16* prow = P + (rowbase + s8 + q) * NPROJ + 1536;
#pragma unroll
                for (int j = 0; j < 8; ++j) v[q][j] = bf2f(__builtin_nontemporal_load(prow + lane + 64 * j)); }
#pragma unroll
            for (int q = 0; q < 8; ++q) { float sm = 0.f;
#pragma unroll
                for (int j = 0; j < 8; ++j) sm += v[q][j];
                mean[q] = sm; }
#pragma unroll
            for (int q = 0; q < 8; ++q) { mean[q] = wave_sum(mean[q]) * (1.f / 512.f); float qq = 0.f;
#pragma unroll
                for (int j = 0; j < 8; ++j) { v[q][j] -= mean[q]; qq += v[q][j] * v[q][j]; }
                rstd[q] = qq; }
#pragma unroll
            for (int q = 0; q < 8; ++q) rstd[q] = rsqrtf(wave_sum(rstd[q]) * (1.f / 512.f) + EPS);
#pragma unroll
            for (int j = 0; j < 8; ++j) {
#pragma unroll
                for (int g = 0; g < 2; ++g) { v2u w; w.x = pk2(v[4 * g][j] * rstd[4 * g] * lg[j] + lb[j], v[4 * g + 1][j] * rstd[4 * g + 1] * lg[j] + lb[j]); w.y = pk2(v[4 * g + 2][j] * rstd[4 * g + 2] * lg[j] + lb[j], v[4 * g + 3][j] * rstd[4 * g + 3] * lg[j] + lb[j]);
                    *(LAS v2u*)(vnT + (lane + 64 * j) * RS + s8 + 4 * g) = w; } } }
    }
    __syncthreads();
    const int h = wave, tq = lane & 15, kq = lane >> 4;
    f32x4 acc[4][4];
#pragma unroll
    for (int rt = 0; rt < 4; ++rt)
#pragma unroll
        for (int ct = 0; ct < 4; ++ct) acc[rt][ct] = (f32x4){0.f, 0.f, 0.f, 0.f};
    v2u uw[4][4]; float bias4[4];
#pragma unroll
    for (int rt = 0; rt < 4; ++rt) { const int t = 64 * th + 16 * rt + tq; bias4[rt] = a.in[I_SGUB][h * CHUNK + t]; const bf16* urow = P + (rowbase + t) * NPROJ + 1024 + h * 64 + 4 * kq;
#pragma unroll
        for (int ct = 0; ct < 4; ++ct) uw[rt][ct] = __builtin_nontemporal_load((const v2u*)(urow + 16 * ct)); }
#pragma unroll
    for (int ks = 0; ks < 4; ++ks) { if (32 * ks >= Ks) break;
        bf16x8 vf[4];
#pragma unroll
        for (int ct = 0; ct < 4; ++ct) { const LAS bf16* p = vnT + (h * 64 + 16 * ct + tq) * RS + 32 * ks + 8 * kq; const bf16x4 lo = *(const LAS bf16x4*)p, hi = *(const LAS bf16x4*)(p + 4);
            vf[ct] = (bf16x8){lo[0], lo[1], lo[2], lo[3], hi[0], hi[1], hi[2], hi[3]}; }
#pragma unroll
        for (int rt = 0; rt < 4; ++rt) if (32 * ks <= 64 * th + 16 * rt + 15) { const bf16x8 wf = wfr[rt][ks];
#pragma unroll
            for (int ct = 0; ct < 4; ++ct) acc[rt][ct] = __builtin_amdgcn_mfma_f32_16x16x32_bf16(vf[ct], wf, acc[rt][ct], 0, 0, 0); }
    }
#pragma unroll
    for (int rt = 0; rt < 4; ++rt) { const float bias = bias4[rt]; float sl = 0.f;
#pragma unroll
        for (int ct = 0; ct < 4; ++ct) { const v2u uq = uw[rt][ct];
            f32x4 o; o.x = bflo(uq.x) * (acc[rt][ct].x + bias); o.y = bfhi(uq.x) * (acc[rt][ct].y + bias); o.z = bflo(uq.y) * (acc[rt][ct].z + bias); o.w = bfhi(uq.y) * (acc[rt][ct].w + bias);
            acc[rt][ct] = o; sl += (o.x * o.x + o.y * o.y) + (o.z * o.z + o.w * o.w); }
        { float o_; const float p_ = xor16f(sl, o_); sl = o_ + p_; } { float o_; const float p_ = xor32f(sl, o_); sl = o_ + p_; }
        if (kq == 0) ssq[(16 * rt + tq) * 8 + h] = sl; }
    __syncthreads();
#pragma unroll
    for (int rt = 0; rt < 4; ++rt) { const int tl = 16 * rt + tq; const f32x4 s0 = *(const LAS f32x4*)(ssq + tl * 8), s1 = *(const LAS f32x4*)(ssq + tl * 8 + 4);
        const float rs = rsqrtf(((s0.x + s0.y) + (s0.z + s0.w) + (s1.x + s1.y) + (s1.z + s1.w)) * (1.f / 512.f) + EPS);
        bf16* hrow = HEADS + (rowbase + 64 * th + tl) * D + DL + h * 64 + 4 * kq;
#pragma unroll
        for (int ct = 0; ct < 4; ++ct) { v2u w; w.x = pk2(acc[rt][ct].x * rs, acc[rt][ct].y * rs); w.y = pk2(acc[rt][ct].z * rs, acc[rt][ct].w * rs); *(v2u*)(hrow + 16 * ct) = w; } }
    __syncthreads();
}
template <int DRY>
__device__ __forceinline__ void router_unit(const Args& a, LAS unsigned char* lds, int tid, int lane, int wave, int unit) {
    const int tok0 = unit * 64, b = tok0 / SEQ;
    const bf16* HB = (const bf16*)(a.ws + WS_PROJ); const float* mod = (const float*)(a.ws + WS_MOD) + b * 6144; unsigned char* Z = a.ws + WS_Z;
    int* toke = (int*)(a.ws + WS_TOKE); float* gatee = (float*)(a.ws + WS_GATEE); int* pos = (int*)(a.ws + WS_POS); unsigned* cursor = (unsigned*)(a.ws + WS_CTL) + CW_CUR;
    LAS int* asg_e = (LAS int*)(lds + 139648); LAS float* asg_g = (LAS float*)(lds + 140672); LAS int* offl = (LAS int*)(lds + 141696);
    LAS float* RW = (LAS float*)lds; LAS float* part = (LAS float*)lds; LAS float* GK = (LAS float*)(lds + 131072); LAS float* SH = (LAS float*)(lds + 135168); LAS float* rsl = (LAS float*)(lds + 139264); LAS int* hist = (LAS int*)(lds + 139520);
    for (int k = tid; k < D; k += 512) { GK[k] = a.in[I_N2G][k] * (1.f + mod[4096 + k]); SH[k] = mod[3072 + k]; }
    if (tid < 32) hist[tid] = 0;
    { const float* rwg = a.in[I_RW];
#pragma unroll
      for (int p = 0; p < 16; ++p) { const int piece = wave * 16 + p; __builtin_amdgcn_global_load_lds((const unsigned*)(rwg + piece * 256 + ((lane * 4) ^ ((p & 1) << 4))), (LAS unsigned*)(lds + piece * 1024), 16, 0, 0); } }
    __syncthreads();
    for (int i0 = 0; i0 < 8; i0 += 4) {
        f32x4 v[4][4]; float rs[4];
#pragma unroll
        for (int q = 0; q < 4; ++q) { const size_t ro = (size_t)(tok0 + wave * 8 + i0 + q) * D + 4 * lane;
#pragma unroll
            for (int j = 0; j < 4; ++j) { const v2u d = *(const v2u*)(HB + ro + 256 * j); f32x4 xv; xv.x = bflo(d.x); xv.y = bfhi(d.x); xv.z = bflo(d.y); xv.w = bfhi(d.y); v[q][j] = xv; } }
#pragma unroll
        for (int q = 0; q < 4; ++q) { float s = 0.f;
#pragma unroll
            for (int j = 0; j < 4; ++j) s += (v[q][j].x * v[q][j].x + v[q][j].y * v[q][j].y) + (v[q][j].z * v[q][j].z + v[q][j].w * v[q][j].w);
            rs[q] = rsqrtf(wave_sum(s) * (1.f / D) + EPS); }
#pragma unroll
        for (int q = 0; q < 4; ++q) { const int tl = wave * 8 + i0 + q; unsigned* o4 = (unsigned*)(Z + (size_t)(tok0 + tl) * D) + lane;
#pragma unroll
            for (int j = 0; j < 4; ++j) { const f32x4 g = *(const LAS f32x4*)(GK + 4 * lane + 256 * j), sh = *(const LAS f32x4*)(SH + 4 * lane + 256 * j); const f32x4 z = v[q][j] * rs[q] * g + sh;
                o4[64 * j] = pg8::pk4_fp8(z.x, z.y, z.z, z.w); }
            if (lane == 0) rsl[tl] = rs[q]; } }
    v4u dvv[16];
    { const int tt = wave & 3, kh = wave >> 2, ti = lane & 15, kq = lane >> 4; const bf16* drow = HB + (size_t)(tok0 + tt * 16 + ti) * D + kh * 512 + 8 * kq;
#pragma unroll
      for (int blk = 0; blk < 16; ++blk) dvv[blk] = *(const v4u*)(drow + blk * 32); }
    VM_WAIT();
    __syncthreads();
    if (DRY == 3) { if (dvv[0].x == 0x12345u && dvv[15].w == 0x54321u && dvv[7].y == 0x777u) rsl[0] = 0.f; __syncthreads(); return; }
    {
        const int tt = wave & 3, kh = wave >> 2, ti = lane & 15, kq = lane >> 4; const float rs = rsl[tt * 16 + ti];
        f32x4 c0 = {0.f, 0.f, 0.f, 0.f}, c1 = {0.f, 0.f, 0.f, 0.f};
        const int kb = kh * 512 + 8 * kq; const int o0 = (kq & 1) ? 16 : 0, o1 = 16 - o0;
#pragma unroll
        for (int blk = 0; blk < 16; ++blk) { const int k0 = kb + blk * 32; const v4u dv = dvv[blk];
            float w0[8], w1[8];
#pragma unroll
            for (int s = 0; s < 8; ++s) { const LAS float* w = RW + (k0 + s) * NE + ti; w0[s] = w[o0]; w1[s] = w[o1]; }
            f32x4 ha, hb2; ha.x = bflo(dv.x); ha.y = bfhi(dv.x); ha.z = bflo(dv.y); ha.w = bfhi(dv.y); hb2.x = bflo(dv.z); hb2.y = bfhi(dv.z); hb2.z = bflo(dv.w); hb2.w = bfhi(dv.w);
            const f32x4 za = ha * rs * *(const LAS f32x4*)(GK + k0) + *(const LAS f32x4*)(SH + k0), zb = hb2 * rs * *(const LAS f32x4*)(GK + k0 + 4) + *(const LAS f32x4*)(SH + k0 + 4);
#pragma unroll
            for (int s = 0; s < 4; ++s) { c0 = __builtin_amdgcn_mfma_f32_16x16x4f32(za[s], w0[s], c0, 0, 0, 0); c1 = __builtin_amdgcn_mfma_f32_16x16x4f32(za[s], w1[s], c1, 0, 0, 0); }
#pragma unroll
            for (int s = 0; s < 4; ++s) { c0 = __builtin_amdgcn_mfma_f32_16x16x4f32(zb[s], w0[4 + s], c0, 0, 0, 0); c1 = __builtin_amdgcn_mfma_f32_16x16x4f32(zb[s], w1[4 + s], c1, 0, 0, 0); } }
        __syncthreads();
#pragma unroll
        for (int r = 0; r < 4; ++r) { LAS float* p = part + (kh * 64 + tt * 16 + kq * 4 + r) * 33; p[ti] = c0[r]; p[16 + ti] = c1[r]; }
    }
    __syncthreads();
    if (DRY == 2) return;
    {
        const int e = lane & 31, hs = lane & 32; const float rbv = a.in[I_RB][e];
        float v[4], den[4], m0[4], myex[4]; int myk[4];
#pragma unroll
        for (int p = 0; p < 4; ++p) { const int tl = wave * 8 + 2 * p + (lane >> 5); v[p] = part[tl * 33 + e] + part[(64 + tl) * 33 + e] + rbv; den[p] = 0.f; m0[p] = 0.f; myex[p] = 0.f; myk[p] = -1; }
#pragma unroll
        for (int k = 0; k < 4; ++k) { float m[4];
#pragma unroll
            for (int p = 0; p < 4; ++p) m[p] = max32(v[p]);
#pragma unroll
            for (int p = 0; p < 4; ++p) { const unsigned long long bal = __ballot(v[p] == m[p]); const int idx = __ffs((unsigned)(bal >> hs)) - 1;
                if (k == 0) m0[p] = m[p];
                const float ex = expf(m[p] - m0[p]); den[p] += ex;
                if (e == idx) { v[p] = -INFINITY; myk[p] = k; myex[p] = ex; } } }
#pragma unroll
        for (int p = 0; p < 4; ++p) if (myk[p] >= 0) { const int tl = wave * 8 + 2 * p + (lane >> 5); const int r = __hip_atomic_fetch_add(hist + e, 1, __ATOMIC_RELAXED, __HIP_MEMORY_SCOPE_WORKGROUP); asg_e[tl * 4 + myk[p]] = e | (r << 8); asg_g[tl * 4 + myk[p]] = myex[p] / den[p]; }
    }
    __syncthreads();
    if (DRY == 1) return;
    if (tid < 32) offl[tid] = (int)__hip_atomic_fetch_add(cursor + tid, (unsigned)hist[tid], __ATOMIC_RELAXED, __HIP_MEMORY_SCOPE_AGENT);
    __syncthreads();
    if (tid < 256) { const int ev = asg_e[tid], e = ev & 255, r = ev >> 8; const int idx = e * pg8::ELIST + offl[e] + r; toke[idx] = tok0 + (tid >> 2); gatee[idx] = asg_g[tid]; pos[tok0 * 4 + tid] = idx; }
    __syncthreads();
}
__device__ __forceinline__ void moe_tables(const Args& a, LAS unsigned char* lds, int tid) {
    LAS int* tp = (LAS int*)(lds + TBL_OFF); LAS int* eb = tp + 36; LAS int* tot = tp + 72; LAS int* hp = tp + 108; unsigned* cursor = (unsigned*)(a.ws + WS_CTL) + CW_CUR;
    if (tid < 32) tot[tid] = (int)__hip_atomic_load(cursor + tid, __ATOMIC_RELAXED, __HIP_MEMORY_SCOPE_AGENT);
    __syncthreads();
    if (tid == 0) { int s = 0, r = 0, hs = 0; for (int e = 0; e < NE; ++e) { tp[e] = s; eb[e] = r; hp[e] = hs; const int c_ = tot[e], nt = (c_ + 255) >> 8, hf = (c_ > 0 && c_ - 256 * (nt - 1) <= 128) ? 1 : 0; s += nt - hf; hs += hf; r += c_; } tp[NE] = s; eb[NE] = r; hp[NE] = hs; }
    __syncthreads();
}
__device__ __forceinline__ void final_rows(const Args& a, LAS unsigned char* lds, int lane, int wave, int vcu, int G, bool do_store) {
    const unsigned char* Y = a.ws + WS_Y; const int* pos = (const int*)(a.ws + WS_POS); const float* mod = (const float*)(a.ws + WS_MOD); const bf16* HB = (const bf16*)(a.ws + WS_PROJ);
    const LAS int* ebl = (const LAS int*)(lds + TBL_OFF) + 36;
    const int stride = G * NWAVES; constexpr int NQ = 4;
    int4 pn[NQ];
    { const int t0 = vcu * NWAVES + wave;
#pragma unroll
      for (int q = 0; q < NQ; ++q) pn[q] = *(const int4*)(pos + min(t0 + q * stride, NTOK - 1) * 4); }
    for (int tok0 = vcu * NWAVES + wave; tok0 < NTOK; tok0 += NQ * stride) {
        f32x4 v[NQ][4]; float s[NQ]; int4 pc[NQ];
#pragma unroll
        for (int q = 0; q < NQ; ++q) { pc[q] = pn[q]; pn[q] = *(const int4*)(pos + min(tok0 + (NQ + q) * stride, NTOK - 1) * 4); }
#pragma unroll
        for (int q = 0; q < NQ; ++q) { const int tok = min(tok0 + q * stride, NTOK - 1); const int b = tok / SEQ;
            int4 p = pc[q]; p.x = ebl[p.x >> 14] + (p.x & (pg8::ELIST - 1)); p.y = ebl[p.y >> 14] + (p.y & (pg8::ELIST - 1)); p.z = ebl[p.z >> 14] + (p.z & (pg8::ELIST - 1)); p.w = ebl[p.w >> 14] + (p.w & (pg8::ELIST - 1));
            const bf16* dr = HB + (size_t)tok * D;
#pragma unroll
            for (int j = 0; j < 4; ++j) { const int off = 4 * lane + 256 * j;
                const unsigned y0 = __builtin_nontemporal_load((const unsigned*)(Y + (size_t)p.x * D + off)), y1 = __builtin_nontemporal_load((const unsigned*)(Y + (size_t)p.y * D + off)), y2 = __builtin_nontemporal_load((const unsigned*)(Y + (size_t)p.z * D + off)), y3 = __builtin_nontemporal_load((const unsigned*)(Y + (size_t)p.w * D + off));
                typedef float f32x2_t __attribute__((ext_vector_type(2)));
                const f32x2_t a0 = __builtin_amdgcn_cvt_pk_f32_fp8(y0, false), a1 = __builtin_amdgcn_cvt_pk_f32_fp8(y0, true), b0 = __builtin_amdgcn_cvt_pk_f32_fp8(y1, false), b1 = __builtin_amdgcn_cvt_pk_f32_fp8(y1, true);
                const f32x2_t c0 = __builtin_amdgcn_cvt_pk_f32_fp8(y2, false), c1 = __builtin_amdgcn_cvt_pk_f32_fp8(y2, true), d0 = __builtin_amdgcn_cvt_pk_f32_fp8(y3, false), d1 = __builtin_amdgcn_cvt_pk_f32_fp8(y3, true);
                f32x4 m; m.x = ((a0.x + b0.x) + (c0.x + d0.x)) * (1.f / pg8::Y8_SCALE); m.y = ((a0.y + b0.y) + (c0.y + d0.y)) * (1.f / pg8::Y8_SCALE);
                m.z = ((a1.x + b1.x) + (c1.x + d1.x)) * (1.f / pg8::Y8_SCALE); m.w = ((a1.y + b1.y) + (c1.y + d1.y)) * (1.f / pg8::Y8_SCALE);
                const f32x4 g2 = *(const f32x4*)(mod + b * 6144 + 5120 + off); const v2u d = __builtin_nontemporal_load((const v2u*)(dr + off)); f32x4 hv; hv.x = bflo(d.x); hv.y = bfhi(d.x); hv.z = bflo(d.y); hv.w = bfhi(d.y); v[q][j] = hv + g2 * m; } }
#pragma unroll
        for (int q = 0; q < NQ; ++q) { s[q] = 0.f;
#pragma unroll
            for (int j = 0; j < 4; ++j) s[q] += (v[q][j].x * v[q][j].x + v[q][j].y * v[q][j].y) + (v[q][j].z * v[q][j].z + v[q][j].w * v[q][j].w); }
#pragma unroll
        for (int q = 0; q < NQ; ++q) s[q] = wave_sum(s[q]);
#pragma unroll
        for (int q = 0; q < NQ; ++q) if (do_store && tok0 + q * stride < NTOK) { const float rs = rsqrtf(s[q] * (1.f / D) + EPS); float* hr = a.out + (size_t)(tok0 + q * stride) * D;
#pragma unroll
            for (int j = 0; j < 4; ++j) { const int off = 4 * lane + 256 * j; const f32x4 fg = *(const f32x4*)(a.in[I_FG] + off); *(f32x4*)(hr + off) = v[q][j] * rs * fg; } }
    }
}

__global__ void __launch_bounds__(NWAVES * 64, 2) mega(Args args) {
    extern __shared__ __attribute__((aligned(16))) unsigned char lds_raw[];
    LAS unsigned char* lds = (LAS unsigned char*)lds_raw;
    volatile LAS unsigned* MISC = (volatile LAS unsigned*)(lds + MISC_OFF);
    const int tid = threadIdx.x, lane = tid & 63, wave = __builtin_amdgcn_readfirstlane(tid >> 6);
    const int G = gridDim.x; const int bx = blockIdx.x; const int vcu = (G % 8 == 0) ? (bx % 8) * (G / 8) + bx / 8 : bx;
    for (int u = tid; u < (LDS_BYTES - MISC_OFF) / 4; u += NWAVES * 64) ((LAS unsigned*)(lds + MISC_OFF))[u] = 0u;
    __syncthreads();
    const int lo = args.ph_lo, hi = args.ph_hi;
    XcdBarrier bar; bar.bar = (unsigned*)(args.ws + WS_CTL) + CW_BAR + args.li * XCD_BAR_WORDS; bar.x = 0; bar.st = nullptr;
    if (hi - lo > 1) bar = xcd_barrier_post((unsigned*)(args.ws + WS_CTL) + CW_BAR + args.li * XCD_BAR_WORDS, MISC + 8);
#ifndef PHMASK
#define PHMASK 0x7FF
#endif
#ifndef PHREP
#define PHREP 0
#endif
#define IN(k) (((PHMASK >> (k)) & 1) && lo <= (k) && (k) < hi)
#define NREP(k) (((PHREP >> (k)) & 1) ? 2 : 1)
#ifndef BARREP
#define BARREP 1
#endif
#define SEAM(k) do { if (IN(k) && IN((k) + 1)) { for (int _b = 0; _b < BARREP; ++_b) xcd_barrier(bar.bar, bar.x, bar.st); } } while (0)
    unsigned char* ws = args.ws;
#ifndef P3DUP
#define P3DUP 0
#endif
#ifndef DRYMODE
#define DRYMODE 1
#endif
#ifndef PHDUP
#define PHDUP -1
#endif
#define DUPBAR() xcd_barrier(bar.bar, bar.x, bar.st)
#define PH2(SH) do { pg8::DenseOrder S; S.init(ws + WS_Z, ws + WS_WINT, NTOK, NPROJ, D * 2, G, ((SH) ? ((bx + 4) & 255) : bx)); pg8::EpiInProj E{(bf16*)(ws + WS_PROJ)}; \
        pg8::gemm_phase<pg8::EpiInProj, pg8::DenseOrder, true>(lds + RING_OFF, D * 2, S, E); } while (0)
#define PH3(SH) do { for (int u = vcu; u < 256; u += G) lru_unit<false>(args, lds, tid, lane, wave, ((SH) ? ((u + 128) & 255) : u)); for (int u = vcu; u < 256; u += G) sgu_unit(args, lds, tid, lane, wave, ((SH) ? ((u + 128) & 255) : u)); } while (0)
#define PH4(SH) do { for (int u = vcu; u < 256; u += G) lru_passb_unit(args, lds, tid, lane, wave, ((SH) ? ((u + 128) & 255) : u)); } while (0)
#define PH5(SH) do { pg8::DenseOrder S; S.init(ws + WS_HEADS, ws + WS_WOUTT, NTOK, D, D * 2, G, ((SH) ? ((bx + 4) & 255) : bx)); pg8::EpiOutProj E{(const float*)(ws + WS_MOD), (const bf16*)(ws + WS_XB), (bf16*)(ws + WS_PROJ)}; \
        pg8::gemm_phase<pg8::EpiOutProj, pg8::DenseOrder, true>(lds + RING_OFF, D * 2, S, E); } while (0)
#define PH8(SH) do { moe_tables(args, lds, tid); pg8::MoeOrder S; S.init(ws + WS_Z, ws + WS_WGUT, (const LAS int*)(lds + TBL_OFF), 2048, D, G, ((SH) ? ((bx + 4) & 255) : bx)); \
        pg8::EpiSwiglu E{args.in[I_BGU], ws + WS_ACT, lds + EPI_OFF}; const pg8::GatherA ga{(const char*)(ws + WS_Z), (const int*)(ws + WS_TOKE), (LAS unsigned*)(lds + RT_OFF)}; \
        pg8::gemm_phase<pg8::EpiSwiglu, pg8::MoeOrder, true, true, true>(lds + RING_OFF, D, S, E, ga); } while (0)
#define PH9(SH) do { moe_tables(args, lds, tid); pg8::MoeOrder S; S.init(ws + WS_ACT, ws + WS_WDNT, (const LAS int*)(lds + TBL_OFF), D, D, G, ((SH) ? ((bx + 4) & 255) : bx)); \
        pg8::EpiDown E{args.in[I_BDN], (const float*)(ws + WS_GATEE), ws + WS_Y, lds + EPI_OFF}; pg8::gemm_phase<pg8::EpiDown, pg8::MoeOrder, true, true>(lds + RING_OFF, D, S, E); } while (0)
    if (IN(0)) { p0_prologue(args, lds, tid, lane, wave, vcu, G);
#if PHDUP == 0
        DUPBAR(); p0_prologue(args, lds, tid, lane, wave, vcu, G);
#endif
        SEAM(0); }
    if (IN(1)) { p1_modz(args, lds, tid, lane, wave, vcu, G);
#if PHDUP == 1
        DUPBAR(); p1_modz(args, lds, tid, lane, wave, vcu, G);
#endif
        SEAM(1); }
    if (IN(2)) {
#if PHDUP == 2
        PH2(1); DUPBAR();
#endif
        PH2(0); SEAM(2); }
    if (IN(3)) {
#if PHDUP == 3
        PH3(1); DUPBAR();
#endif
#if P3DUP == 1
        for (int u = vcu; u < 256; u += G) lru_unit<false>(args, lds, tid, lane, wave, (u + 128) & 255); DUPBAR();
#elif P3DUP == 2
        for (int u = vcu; u < 256; u += G) sgu_unit(args, lds, tid, lane, wave, (u + 128) & 255); DUPBAR();
#endif
        PH3(0);
        SEAM(3); }
    if (IN(4)) {
#if PHDUP == 4
        PH4(1); DUPBAR();
#endif
        PH4(0); SEAM(4); }
    if (IN(5)) {
#if PHDUP == 5
        PH5(1); DUPBAR();
#endif
        PH5(0); SEAM(5); }
    if (IN(6)) {
#if PHDUP == 6
        for (int u = vcu; u < 256; u += G) router_unit<DRYMODE>(args, lds, tid, lane, wave, (u + 128) & 255); DUPBAR();
#endif
        for (int u = vcu; u < 256; u += G) router_unit<0>(args, lds, tid, lane, wave, u); SEAM(6); }
    if (IN(8)) {
#if PHDUP == 8
        PH8(1); DUPBAR();
#endif
        PH8(0); SEAM(8); }
    if (IN(9)) {
#if PHDUP == 9
        PH9(1); DUPBAR();
#endif
        PH9(0); SEAM(9); }
    if (IN(10)) { moe_tables(args, lds, tid); final_rows(args, lds, lane, wave, vcu, G, true); }
#undef IN
#undef SEAM
}

extern "C" void kernel_launch(void* const* d_in, const int* in_sizes, int n_in, void* d_out, int out_size, void* d_ws, size_t ws_size, hipStream_t stream) {
    static int grid = 0;
    if (grid == 0) {
        if (n_in != 28 || out_size != NTOK * D || ws_size < WS_END) { fprintf(stderr, "kernel_launch: unexpected shapes (n_in %d out %d ws %zu)\n", n_in, out_size, ws_size); grid = -1; return; }
        int dev = 0, cus = 0, per_cu = 0;
        if (hipGetDevice(&dev) != hipSuccess || hipDeviceGetAttribute(&cus, hipDeviceAttributeMultiprocessorCount, dev) != hipSuccess) { grid = -1; return; }
        if (hipFuncSetAttribute((const void*)mega, hipFuncAttributeMaxDynamicSharedMemorySize, LDS_BYTES) != hipSuccess) { fprintf(stderr, "kernel_launch: hipFuncSetAttribute failed\n"); grid = -1; return; }
        if (hipOccupancyMaxActiveBlocksPerMultiprocessor(&per_cu, (const void*)mega, NWAVES * 64, LDS_BYTES) != hipSuccess || per_cu < 1) { fprintf(stderr, "kernel_launch: occupancy query says %d blocks per CU\n", per_cu); (void)hipGetLastError(); grid = -1; return; }
        grid = cus < 256 ? cus : 256;
        if (grid % 8 != 0) { fprintf(stderr, "kernel_launch: %d CUs; the phase programs need a grid that is a multiple of 8\n", cus); grid = -1; return; }
    }
    if (grid < 0) return;
    (void)hipMemsetAsync((unsigned char*)d_ws + WS_CTL, 0, CTL_ZERO_BYTES, stream);
    Args a{};
    for (int i = 0; i < 28; ++i) a.in[i] = (const float*)d_in[i];
    a.out = (float*)d_out; a.ws = (unsigned char*)d_ws; a.ph_lo = 0; a.ph_hi = NPH; a.li = 0;
    hipLaunchKernelGGL(mega, dim3(grid), dim3(NWAVES * 64), LDS_BYTES, stream, a);
}
```

```cpp
#include <hip/hip_runtime.h>
#include <cstdio>
#include <cstdint>

typedef unsigned short bf16;
constexpr int D = 1024, BATCH = 4, SEQ = 4096, NTOK = BATCH * SEQ, NPROJ = 2048, DL = 512, NH = 8, HD = 64, CHUNK = 128, NE = 32, TOPK = 4;
constexpr int NASSIGN = NTOK * TOPK;
constexpr float EPS = 1e-6f;

__device__ __forceinline__ unsigned f2bf(float f) { unsigned u = __builtin_bit_cast(unsigned, f); return (u + 0x7fffu + ((u >> 16) & 1u)) >> 16; }
__device__ __forceinline__ float bf2f(bf16 h) { return __builtin_bit_cast(float, (unsigned)h << 16); }
__device__ __forceinline__ float gelu_tanh(float x) { const float u = 1.5957691216057308f * (x + 0.044715f * x * x * x); return x / (1.f + __expf(-u)); }
__device__ __forceinline__ float sigmoidf_(float x) { return 1.f / (1.f + __expf(-x)); }

constexpr size_t MiB = 1u << 20;
constexpr size_t WS_CTL = 0;
constexpr size_t CTL_ZERO_BYTES = 20480;
constexpr size_t WS_MODP = 1 * MiB;
constexpr size_t WS_MOD = 3 * MiB;
constexpr size_t WS_AGG = 4 * MiB;
constexpr size_t WS_CNT = 5 * MiB;
constexpr size_t WS_TOPE = 6 * MiB;
constexpr size_t WS_GATE = 7 * MiB;
constexpr size_t WS_RANK = 8 * MiB;
constexpr size_t WS_POS = 9 * MiB;
constexpr size_t WS_GSORT = 10 * MiB;
constexpr size_t WS_TOKL = 11 * MiB;
constexpr size_t WS_STATS = 12 * MiB;
constexpr size_t WS_WRT = 13 * MiB;
constexpr size_t WS_WM = 14 * MiB;
constexpr size_t WS_Z = 16 * MiB;
constexpr size_t WS_HEADS = 48 * MiB;
constexpr size_t WS_PROJ = 80 * MiB;
constexpr size_t WS_ACT = 144 * MiB;
constexpr size_t WS_Y = 280 * MiB;
constexpr size_t WS_WINT = 416 * MiB;
constexpr size_t WS_WOUTT = 420 * MiB;
constexpr size_t WS_WGUT = 424 * MiB;
constexpr size_t WS_WDNT = 552 * MiB;
constexpr size_t WS_TOKE = 616 * MiB;
constexpr size_t WS_GATEE = 620 * MiB;
constexpr size_t WS_O32 = 752 * MiB;
constexpr size_t WS_XB = 784 * MiB;
constexpr size_t WS_END = 816 * MiB;
constexpr int CW_CNT = 0, CW_CUR = 64, CW_EBASE = 128;
constexpr int CW_BAR = 1024;

namespace pg8 {
#define PG8_LAS __attribute__((address_space(3)))
typedef unsigned short bf16_t;
typedef short bf16x8 __attribute__((ext_vector_type(8)));
typedef float f32x4 __attribute__((ext_vector_type(4)));
typedef unsigned u32x4 __attribute__((ext_vector_type(4)));
constexpr int BM = 256, BK = 64, HALF = 128, HTB = HALF * BK * 2, STAGE_BYTES = 8 * HTB, NXCD = 8, WGM = 8;
constexpr int ELIST = 16384;

__host__ __device__ __forceinline__ int lds_byte(int r, int c) { const int st = (r >> 4) * 2 + (c >> 5), rr = r & 15, cc = c & 31, ob = rr * 64 + cc * 2; return st * 1024 + (ob ^ (((ob >> 9) & 1) << 5)); }
__host__ __device__ __forceinline__ void stage_rc(int b, int& R, int& C) { const int st = b / 1024, sb = b % 1024, swz = sb ^ (((sb >> 9) & 1) << 5); R = (st >> 1) * 16 + swz / 64; C = (st & 1) * 32 + (swz % 64) / 2; }
__host__ __device__ __forceinline__ int perm32(int rho) { const int n = rho >> 4, i = rho & 15; return 8 * (i >> 2) + 4 * n + (i & 3); }

struct Unit { const char* A; const char* B; int row0, col0, nr, e, lrow0; };

struct DenseOrder {
    const char* A; const char* B; int nM, nN, nwg, G, c, pitch;
    __device__ __forceinline__ void init(const void* A_, const void* B_, int M, int N, int pitch_, int G_, int c_) { A = (const char*)A_; B = (const char*)B_; nM = M / BM; nN = N / BM; nwg = nM * nN; G = G_; c = c_; pitch = pitch_; }
    __device__ __forceinline__ bool next(int i, Unit& u) const {
        const long L = (long)i * G + c; if (L >= nwg) return false;
        int wgid = (int)L; { const int q = nwg / NXCD, r = nwg % NXCD, xcd = wgid % NXCD, off = wgid / NXCD; wgid = (xcd < r ? xcd * (q + 1) : r * (q + 1) + (xcd - r) * q) + off; }
        const int nig = WGM * nN, gid = wgid / nig, fm = gid * WGM, gsz = (nM - fm) < WGM ? (nM - fm) : WGM;
        const int pm = fm + ((wgid % nig) % gsz), pn = (wgid % nig) / gsz;
        u.A = A + (size_t)pm * BM * pitch; u.B = B + (size_t)pn * BM * pitch; u.row0 = pm * BM; u.col0 = pn * BM; u.nr = BM; u.e = 0; u.lrow0 = 0; return true;
    }
};
struct MoeOrder {
    const char* A; const char* B; const PG8_LAS int* tpre; const PG8_LAS int* ebase; int NPN, nU, G, c, pitch, N;
    __device__ __forceinline__ void init(const void* A_, const void* B_, const PG8_LAS int* tpre_, const PG8_LAS int* ebase_, int N_, int pitch_, int G_, int c_) {
        A = (const char*)A_; B = (const char*)B_; tpre = tpre_; ebase = ebase_; N = N_; NPN = N_ / BM; pitch = pitch_; G = G_; c = c_; nU = __builtin_amdgcn_readfirstlane(tpre_[32]) * NPN; }
    __device__ __forceinline__ bool next(int i, Unit& u) const {
        const long L = (long)i * G + c; if (L >= nU) return false;
        int wgid = (int)L; { const int q = nU / NXCD, r = nU % NXCD, xcd = wgid % NXCD, off = wgid / NXCD; wgid = (xcd < r ? xcd * (q + 1) : r * (q + 1) + (xcd - r) * q) + off; }
        const int ln = threadIdx.x & 31; const unsigned long long bal = __ballot(tpre[ln + 1] * NPN <= wgid);
        int e = __builtin_popcount((unsigned)bal); e = e > 31 ? 31 : e;
        const int tp0 = __builtin_amdgcn_readfirstlane(tpre[e]), tp1 = __builtin_amdgcn_readfirstlane(tpre[e + 1]);
        const int q2 = wgid - tp0 * NPN, nt = tp1 - tp0, pn = q2 / nt, mt = q2 - pn * nt;
        const int eb = __builtin_amdgcn_readfirstlane(ebase[e]), cnt = __builtin_amdgcn_readfirstlane(ebase[e + 1]) - eb;
        u.row0 = eb + BM * mt; u.nr = min(BM, cnt - BM * mt); u.col0 = pn * BM; u.e = e; u.lrow0 = e * ELIST + BM * mt;
        u.A = A + (size_t)u.row0 * pitch; u.B = B + ((size_t)e * N + (size_t)pn * BM) * pitch; return true;
    }
};

__device__ __forceinline__ unsigned cvt_pk_bf16(float lo, float hi) { unsigned r; asm volatile("v_cvt_pk_bf16_f32 %0, %1, %2" : "=v"(r) : "v"(lo), "v"(hi)); return r; }
__device__ __forceinline__ float gelu_fast(float x) { const float u = x * (1.5957691216f + 0.0713548163f * x * x); return x * __builtin_amdgcn_rcpf(1.f + __builtin_amdgcn_exp2f(-1.4426950409f * u)); }
__device__ __forceinline__ f32x4 gelu4(const f32x4 x) {
    const f32x4 t = x * (x * x * (-0.0713548163f * 1.4426950409f) + (-1.5957691216f * 1.4426950409f)); f32x4 d;
#pragma unroll
    for (int q = 0; q < 4; ++q) d[q] = __builtin_amdgcn_rcpf(1.f + __builtin_amdgcn_exp2f(t[q]));
    return x * d;
}
__device__ __forceinline__ float sigm_fast(float x) { return __builtin_amdgcn_rcpf(1.f + __builtin_amdgcn_exp2f(-1.4426950409f * x)); }

struct EpiInProj {
    static constexpr bool PERM = true; bf16_t* O;
    __device__ __forceinline__ void prefetch(const Unit&, int, int) const {}
    __device__ __forceinline__ void operator()(const f32x4 (&acc)[2][2][4][2], const Unit& u, int wr, int wc, int fr, int fq) const {
        const int row0 = u.row0 + wr * 64 + fr, col0 = u.col0 + wc * 32 + 8 * fq; const bool act = u.col0 >= 512;
#pragma unroll
        for (int ai = 0; ai < 2; ++ai)
#pragma unroll
            for (int m = 0; m < 4; ++m) { bf16_t* rowp = O + (size_t)(row0 + ai * HALF + m * 16) * NPROJ + col0;
#pragma unroll
                for (int bj = 0; bj < 2; ++bj) { f32x4 v0 = acc[ai][bj][m][0], v1 = acc[ai][bj][m][1];
                    if (act) { v0 = gelu4(v0); v1 = gelu4(v1); }
                    u32x4 w; w.x = cvt_pk_bf16(v0[0], v0[1]); w.y = cvt_pk_bf16(v0[2], v0[3]); w.z = cvt_pk_bf16(v1[0], v1[1]); w.w = cvt_pk_bf16(v1[2], v1[3]);
                    *(u32x4*)(rowp + bj * HALF) = w; } }
    }
};
struct EpiOutProj {
    static constexpr bool PERM = true; const float* mod; const bf16_t* XB; bf16_t* O;
    __device__ __forceinline__ void prefetch(const Unit&, int, int) const {}
    __device__ __forceinline__ void operator()(const f32x4 (&acc)[2][2][4][2], const Unit& u, int wr, int wc, int fr, int fq) const {
        const int row0 = u.row0 + wr * 64 + fr, col0 = u.col0 + wc * 32 + 8 * fq; const int b = u.row0 / SEQ;
        f32x4 g[2][2];
#pragma unroll
        for (int bj = 0; bj < 2; ++bj)
#pragma unroll
            for (int n = 0; n < 2; ++n) g[bj][n] = *(const f32x4*)(mod + b * 6144 + 2048 + col0 + bj * HALF + 4 * n);
#pragma unroll
        for (int ai = 0; ai < 2; ++ai) {
            u32x4 xr[4][2];
#pragma unroll
            for (int m = 0; m < 4; ++m)
#pragma unroll
                for (int bj = 0; bj < 2; ++bj) xr[m][bj] = __builtin_nontemporal_load((const u32x4*)(XB + (size_t)(row0 + ai * HALF + m * 16) * D + col0 + bj * HALF));
#pragma unroll
            for (int m = 0; m < 4; ++m) { bf16_t* rowp = O + (size_t)(row0 + ai * HALF + m * 16) * D + col0;
#pragma unroll
                for (int bj = 0; bj < 2; ++bj) { const u32x4 xw = xr[m][bj]; f32x4 v0 = acc[ai][bj][m][0] * g[bj][0], v1 = acc[ai][bj][m][1] * g[bj][1];
                    v0[0] += __builtin_bit_cast(float, xw.x << 16); v0[1] += __builtin_bit_cast(float, xw.x & 0xffff0000u); v0[2] += __builtin_bit_cast(float, xw.y << 16); v0[3] += __builtin_bit_cast(float, xw.y & 0xffff0000u);
                    v1[0] += __builtin_bit_cast(float, xw.z << 16); v1[1] += __builtin_bit_cast(float, xw.z & 0xffff0000u); v1[2] += __builtin_bit_cast(float, xw.w << 16); v1[3] += __builtin_bit_cast(float, xw.w & 0xffff0000u);
                    u32x4 w; w.x = cvt_pk_bf16(v0[0], v0[1]); w.y = cvt_pk_bf16(v0[2], v0[3]); w.z = cvt_pk_bf16(v1[0], v1[1]); w.w = cvt_pk_bf16(v1[2], v1[3]);
                    *(u32x4*)(rowp + bj * HALF) = w; } }
            asm volatile("" ::: "memory"); }
    }
};
__device__ __forceinline__ unsigned pk4_fp8(float a, float b, float c, float d) { int w = 0; w = __builtin_amdgcn_cvt_pk_fp8_f32(a, b, w, false); w = __builtin_amdgcn_cvt_pk_fp8_f32(c, d, w, true); return (unsigned)w; }
constexpr float W8_SCALE = 64.f, A8_SCALE = 4.f;
typedef unsigned u32x2 __attribute__((ext_vector_type(2)));
__device__ __forceinline__ u32x4 pair16(const u32x2 wA, const u32x2 wB, const bool) {
    const auto r0 = __builtin_amdgcn_permlane16_swap(wA.x, wB.x, false, false), r1 = __builtin_amdgcn_permlane16_swap(wA.y, wB.y, false, false);
    return (u32x4){(unsigned)r0[0], (unsigned)r1[0], (unsigned)r0[1], (unsigned)r1[1]};
}
struct EpiSwiglu {
    static constexpr bool PERM = true; const float* bgu; unsigned char* ACT; PG8_LAS unsigned char* epl;
    __device__ __forceinline__ void prefetch(const Unit& u, int wid, int lane) const {
        if (wid == 0) { const float* src = bgu + u.e * 2048 + (lane >= 32 ? 1024 : 0) + (u.col0 >> 1) + 4 * (lane & 31);
            __builtin_amdgcn_global_load_lds((const unsigned*)src, (PG8_LAS unsigned*)epl, 16, 0, 0); }
    }
    __device__ __forceinline__ void operator()(const f32x4 (&acc)[2][2][4][2], const Unit& u, int wr, int wc, int fr, int fq) const {
        asm volatile("" : "+v"(fr), "+v"(fq));
        const int jl = wc * 32 + 8 * fq, j0 = (u.col0 >> 1) + jl; const bool odd = (fq & 1) != 0;
        f32x4 bg[2], bl[2];
#pragma unroll
        for (int n = 0; n < 2; ++n) { bg[n] = *(const PG8_LAS f32x4*)(epl + (jl + 4 * n) * 4); bl[n] = *(const PG8_LAS f32x4*)(epl + 512 + (jl + 4 * n) * 4); }
#pragma unroll
        for (int ai = 0; ai < 2; ++ai)
#pragma unroll
            for (int mp = 0; mp < 2; ++mp) { u32x2 w2[2];
#pragma unroll
                for (int h = 0; h < 2; ++h) { const int m = 2 * mp + h; f32x4 o[2];
#pragma unroll
                    for (int n = 0; n < 2; ++n) { const f32x4 g = __builtin_elementwise_min(acc[ai][0][m][n] * (1.f / W8_SCALE) + bg[n], (f32x4){7.f, 7.f, 7.f, 7.f});
                        const f32x4 l = __builtin_elementwise_min(__builtin_elementwise_max(acc[ai][1][m][n] * (1.f / W8_SCALE) + bl[n], (f32x4){-7.f, -7.f, -7.f, -7.f}), (f32x4){7.f, 7.f, 7.f, 7.f});
                        const f32x4 ex = g * (-1.702f * 1.4426950409f); f32x4 den;
#pragma unroll
                        for (int q = 0; q < 4; ++q) den[q] = __builtin_amdgcn_rcpf(1.f + __builtin_amdgcn_exp2f(ex[q]));
                        o[n] = (g * A8_SCALE) * den * (l + 1.f); }
                    w2[h].x = pk4_fp8(o[0][0], o[0][1], o[0][2], o[0][3]); w2[h].y = pk4_fp8(o[1][0], o[1][1], o[1][2], o[1][3]); }
                const u32x4 o16 = pair16(w2[0], w2[1], odd);
                const int r = ai * HALF + wr * 64 + (2 * mp + (odd ? 1 : 0)) * 16 + fr;
                if (r < u.nr) *(u32x4*)(ACT + (size_t)(u.row0 + r) * D + j0 - (odd ? 8 : 0)) = o16; }
    }
};
constexpr float Y8_SCALE = 8.f;
struct EpiDown {
    static constexpr bool PERM = true; const float* bd; const float* gs; unsigned char* Y; PG8_LAS unsigned char* epl;
    __device__ __forceinline__ void prefetch(const Unit& u, int wid, int lane) const {
        if (wid == 0) __builtin_amdgcn_global_load_lds((const unsigned*)(bd + u.e * D + u.col0 + 4 * lane), (PG8_LAS unsigned*)epl, 16, 0, 0);
        if (wid == 1) __builtin_amdgcn_global_load_lds((const unsigned*)(gs + u.lrow0 + 4 * lane), (PG8_LAS unsigned*)(epl + 1024), 16, 0, 0);
    }
    __device__ __forceinline__ void operator()(const f32x4 (&acc)[2][2][4][2], const Unit& u, int wr, int wc, int fr, int fq) const {
        asm volatile("" : "+v"(fr), "+v"(fq));
        const int cl = wc * 32 + 8 * fq, col0 = u.col0 + cl; const bool odd = (fq & 1) != 0;
        f32x4 bv[2][2];
#pragma unroll
        for (int bj = 0; bj < 2; ++bj)
#pragma unroll
            for (int n = 0; n < 2; ++n) bv[bj][n] = *(const PG8_LAS f32x4*)(epl + (cl + bj * HALF + 4 * n) * 4);
#pragma unroll
        for (int ai = 0; ai < 2; ++ai)
#pragma unroll
            for (int mp = 0; mp < 2; ++mp) { const int rb = ai * HALF + wr * 64 + 2 * mp * 16 + fr;
                const float gA = *(const PG8_LAS float*)(epl + 1024 + rb * 4) * Y8_SCALE, gB = *(const PG8_LAS float*)(epl + 1024 + (rb + 16) * 4) * Y8_SCALE;
                const int r = rb + (odd ? 16 : 0); unsigned char* rowp = Y + (size_t)(u.row0 + r) * D + col0 - (odd ? 8 : 0);
#pragma unroll
                for (int bj = 0; bj < 2; ++bj) { u32x2 w2[2];
#pragma unroll
                    for (int h = 0; h < 2; ++h) { const int m = 2 * mp + h; const float gt = h ? gB : gA;
                        const f32x4 v0 = (acc[ai][bj][m][0] * (1.f / (W8_SCALE * A8_SCALE)) + bv[bj][0]) * gt, v1 = (acc[ai][bj][m][1] * (1.f / (W8_SCALE * A8_SCALE)) + bv[bj][1]) * gt;
                        w2[h].x = pk4_fp8(v0[0], v0[1], v0[2], v0[3]); w2[h].y = pk4_fp8(v1[0], v1[1], v1[2], v1[3]); }
                    const u32x4 o16 = pair16(w2[0], w2[1], odd);
                    if (r < u.nr) *(u32x4*)(rowp + bj * HALF) = o16; } }
    }
};

typedef int v4i_t __attribute__((ext_vector_type(4)));
typedef int v8i_t __attribute__((ext_vector_type(8)));
struct GatherA { const char* base; const int* tokl; PG8_LAS unsigned* rt; };
template <class Epi, class Sched, bool ALIGN_EPI, bool FP8 = false, bool GATHER = false>
__device__ __forceinline__ void gemm_phase(PG8_LAS unsigned char* lds, const int pitch, const Sched& S, const Epi& E, const GatherA ga = GatherA{nullptr, nullptr, nullptr}) {
    const int tid = threadIdx.x, wid = __builtin_amdgcn_readfirstlane(tid >> 6), lane = tid & 63, wr = wid >> 2, wc = wid & 3, fr = lane & 15, fq = lane >> 4;
    const int nt = pitch / (BK * 2);
    unsigned voffA[2], voffB[2];
#pragma unroll
    for (int i = 0; i < 2; ++i) { int R, C; stage_rc(tid * 16 + i * 8192, R, C); const int Rb = Epi::PERM ? ((R & ~31) + perm32(R & 31)) : R;
        voffA[i] = GATHER ? (unsigned)(R * 65536 + C * 2) : (unsigned)(R * pitch + C * 2); voffB[i] = (unsigned)(Rb * pitch + C * 2); }
    const size_t kstep = (size_t)(BK * 2);
    const size_t hstep = (size_t)HALF * pitch;
    const unsigned ldsw = (unsigned)wid * 1024u;
    const int aoff = lds_byte(wr * 64 + fr, fq * 8), boff = lds_byte(wc * 32 + fr, fq * 8);
#define PG8_SA(b, h) (((b) * 2 + (h)) * HTB)
#define PG8_SB(b, h) ((4 + (b) * 2 + (h)) * HTB)
#define PG8_STAGE(bufoff, gbase, voff) do { _Pragma("unroll") for (int _i = 0; _i < 2; ++_i) \
        __builtin_amdgcn_global_load_lds((const unsigned*)((const char*)(gbase) + (voff)[_i]), (PG8_LAS unsigned*)(lds + (bufoff) + ldsw + _i * 8192), 16, 0, 0); } while (0)
#define PG8_STAGE_A(bufoff, gbase, par, half, kt) do { if constexpr (GATHER) { _Pragma("unroll") for (int _i = 0; _i < 2; ++_i) { const unsigned _tk = min(ga.rt[(par) * 256 + (half) * 128 + (voffA[_i] >> 16)], (unsigned)(NTOK - 1)); \
            __builtin_amdgcn_global_load_lds((const unsigned*)(ga.base + (size_t)_tk * pitch + (voffA[_i] & 0xffffu) + (kt) * (BK * 2)), (PG8_LAS unsigned*)(lds + (bufoff) + ldsw + _i * 8192), 16, 0, 0); } } \
        else PG8_STAGE(bufoff, gbase, voffA); } while (0)
#define PG8_GA_LOAD(par, row0_) do { if constexpr (GATHER) { if (wid == 2) __builtin_amdgcn_global_load_lds((const unsigned*)(ga.tokl + (row0_) + 4 * lane), (PG8_LAS unsigned*)(ga.rt + (par) * 256), 16, 0, 0); } } while (0)
#define PG8_CAT8(x0, x1) __builtin_shufflevector(x0, x1, 0, 1, 2, 3, 4, 5, 6, 7)
#define PG8_LDA(dst, b, h) do { if constexpr (FP8) { _Pragma("unroll") for (int m = 0; m < 4; ++m) { const v4i_t x0 = *(const PG8_LAS v4i_t*)(lds + PG8_SA(b, h) + aoff + m * 2048), x1 = *(const PG8_LAS v4i_t*)(lds + PG8_SA(b, h) + aoff + m * 2048 + 1024); dst##8[m] = PG8_CAT8(x0, x1); } } \
    else { _Pragma("unroll") for (int m = 0; m < 4; ++m) _Pragma("unroll") for (int k = 0; k < 2; ++k) dst[m][k] = *(const PG8_LAS bf16x8*)(lds + PG8_SA(b, h) + aoff + m * 2048 + k * 1024); } } while (0)
#define PG8_LDB(dst, b, h) do { if constexpr (FP8) { _Pragma("unroll") for (int n = 0; n < 2; ++n) { const v4i_t x0 = *(const PG8_LAS v4i_t*)(lds + PG8_SB(b, h) + boff + n * 2048), x1 = *(const PG8_LAS v4i_t*)(lds + PG8_SB(b, h) + boff + n * 2048 + 1024); dst##8[n] = PG8_CAT8(x0, x1); } } \
    else { _Pragma("unroll") for (int n = 0; n < 2; ++n) _Pragma("unroll") for (int k = 0; k < 2; ++k) dst[n][k] = *(const PG8_LAS bf16x8*)(lds + PG8_SB(b, h) + boff + n * 2048 + k * 1024); } } while (0)
#define PG8_MMA(ai, bj, At, Bt) do { __builtin_amdgcn_s_setprio(1); _Pragma("unroll") for (int m = 0; m < 4; ++m) _Pragma("unroll") for (int n = 0; n < 2; ++n) { \
        if constexpr (FP8) { asm volatile("v_mfma_f32_16x16x128_f8f6f4 %0, %1, %2, %0" : "+v"(acc[ai][bj][m][n]) : "v"(Bt##8[n]), "v"(At##8[m])); } \
        else { _Pragma("unroll") for (int k = 0; k < 2; ++k) acc[ai][bj][m][n] = __builtin_amdgcn_mfma_f32_16x16x32_bf16(Bt[n][k], At[m][k], acc[ai][bj][m][n], 0, 0, 0); } } \
        __builtin_amdgcn_s_setprio(0); } while (0)
#define PG8_WAIT_V(n) asm volatile("s_waitcnt vmcnt(" #n ")" ::: "memory")
#define PG8_WAIT_L(n) asm volatile("s_waitcnt lgkmcnt(" #n ")" ::: "memory")
#define PG8_BAR __builtin_amdgcn_s_barrier()
#define PG8_SCHED __builtin_amdgcn_sched_barrier(0)
    Unit cur, nxt; int ui = 0;
    if (!S.next(0, cur)) return;
    f32x4 acc[2][2][4][2];
#pragma unroll
    for (int a = 0; a < 2; ++a)
#pragma unroll
        for (int b = 0; b < 2; ++b)
#pragma unroll
            for (int m = 0; m < 4; ++m)
#pragma unroll
                for (int n = 0; n < 2; ++n) acc[a][b][m][n] = (f32x4){0.f, 0.f, 0.f, 0.f};
    bf16x8 At[4][2], B0[2][2], B1[2][2]; v8i_t At8[4], B08[2], B18[2];
    const char* cA = cur.A; const char* cB = cur.B;
    if constexpr (GATHER) PG8_GA_LOAD(0, cur.lrow0);
    PG8_STAGE(PG8_SB(0, 0), cB, voffB); PG8_STAGE(PG8_SB(0, 1), cB + hstep, voffB);
    if constexpr (GATHER) { PG8_WAIT_V(4); PG8_BAR; }
    PG8_STAGE_A(PG8_SA(0, 0), cA, 0, 0, 0); PG8_STAGE_A(PG8_SA(0, 1), cA + hstep, 0, 1, 0);
    if (wr == 1) PG8_BAR;
    PG8_WAIT_V(2); PG8_BAR;
    PG8_STAGE(PG8_SB(1, 0), cB + kstep, voffB); PG8_STAGE_A(PG8_SA(1, 0), cA + kstep, 0, 0, 1); PG8_STAGE(PG8_SB(1, 1), cB + hstep + kstep, voffB);
    PG8_WAIT_V(6); PG8_BAR;
    for (;;) {
        bool has_next = false; const char* nA = cA; const char* nB = cB;
        for (int t = 0; t < nt; t += 2) {
            const bool last = (t == nt - 2);
            if (t == 2) {
                has_next = S.next(ui + 1, nxt); nA = has_next ? nxt.A : cA; nB = has_next ? nxt.B : cB;
                if (GATHER && has_next) { PG8_GA_LOAD((ui & 1) ^ 1, nxt.lrow0); PG8_SCHED; } }
            const char* a1 = cA + (size_t)(t + 1) * kstep;
            const char* a2 = last ? nA : cA + (size_t)(t + 2) * kstep; const char* b2 = last ? nB : cB + (size_t)(t + 2) * kstep;
            const char* a3 = a2 + kstep; const char* b3 = b2 + kstep;
            const int pc = ui & 1, p2 = (last && has_next) ? (pc ^ 1) : pc, k2 = last ? 0 : t + 2;
            if (last) { E.prefetch(cur, wid, lane); PG8_SCHED; }
            PG8_LDB(B0, 0, 0); PG8_LDB(B1, 0, 1); PG8_SCHED; PG8_LDA(At, 0, 0); PG8_STAGE_A(PG8_SA(1, 1), a1 + hstep, pc, 1, t + 1);
            PG8_WAIT_V(8); PG8_WAIT_L(0); PG8_BAR; PG8_MMA(0, 0, At, B0); PG8_MMA(0, 1, At, B1); PG8_BAR; PG8_SCHED;
            PG8_LDA(At, 0, 1); PG8_STAGE(PG8_SB(0, 0), b2, voffB); PG8_STAGE(PG8_SB(0, 1), b2 + hstep, voffB); PG8_STAGE_A(PG8_SA(0, 0), a2, p2, 0, k2);
            PG8_WAIT_V(8); PG8_WAIT_L(0); PG8_BAR; PG8_MMA(1, 0, At, B0); PG8_MMA(1, 1, At, B1); PG8_BAR; PG8_SCHED;
            PG8_LDB(B0, 1, 0); PG8_LDB(B1, 1, 1); PG8_SCHED; PG8_LDA(At, 1, 0); PG8_STAGE_A(PG8_SA(0, 1), a2 + hstep, p2, 1, k2);
            PG8_WAIT_V(8); PG8_WAIT_L(0); PG8_BAR; PG8_MMA(0, 0, At, B0); PG8_MMA(0, 1, At, B1); PG8_BAR; PG8_SCHED;
            PG8_LDA(At, 1, 1); PG8_STAGE(PG8_SB(1, 0), b3, voffB); PG8_STAGE(PG8_SB(1, 1), b3 + hstep, voffB); PG8_STAGE_A(PG8_SA(1, 0), a3, p2, 0, k2 + 1);
            PG8_WAIT_V(8); PG8_WAIT_L(0); PG8_BAR; PG8_MMA(1, 0, At, B0); PG8_MMA(1, 1, At, B1); PG8_BAR; PG8_SCHED;
        }
        if constexpr (ALIGN_EPI) { if (wr == 0) PG8_BAR; }
        if constexpr (FP8) asm volatile("s_nop 15\n\ts_nop 15" ::: "memory");
        E(acc, cur, wr, wc, fr, fq);
        if (!has_next) break;
#pragma unroll
        for (int a = 0; a < 2; ++a)
#pragma unroll
            for (int b = 0; b < 2; ++b)
#pragma unroll
                for (int m = 0; m < 4; ++m)
#pragma unroll
                    for (int n = 0; n < 2; ++n) acc[a][b][m][n] = (f32x4){0.f, 0.f, 0.f, 0.f};
        cur = nxt; cA = nA; cB = nB; ++ui;
        if constexpr (ALIGN_EPI) { if (wr == 1) PG8_BAR; }
    }
    PG8_WAIT_V(0);
    if constexpr (!ALIGN_EPI) { if (wr == 0) PG8_BAR; }
    PG8_BAR;
#undef PG8_SA
#undef PG8_SB
#undef PG8_STAGE
#undef PG8_STAGE_A
#undef PG8_GA_LOAD
#undef PG8_LDA
#undef PG8_LDB
#undef PG8_MMA
#undef PG8_CAT8
#undef PG8_WAIT_V
#undef PG8_WAIT_L
#undef PG8_BAR
#undef PG8_SCHED
}
}

constexpr int RING_OFF = 0, RING_BYTES = 131072;
constexpr int MISC_OFF = 143360, TBL_OFF = MISC_OFF + 256, EPI_OFF = MISC_OFF + 1024;
constexpr int _unused_tbl = 0;
constexpr int RT_OFF = 146432;
constexpr int LDS_BYTES = 151552;
constexpr int NWAVES = 8;

#define GAS __attribute__((address_space(1)))
#define LAS __attribute__((address_space(3)))
typedef unsigned v4u __attribute__((ext_vector_type(4)));
typedef unsigned v2u __attribute__((ext_vector_type(2)));
typedef float f32x4 __attribute__((ext_vector_type(4)));
typedef short bf16x8 __attribute__((ext_vector_type(8)));
typedef short bf16x4 __attribute__((ext_vector_type(4)));
typedef GAS unsigned gu32;
#define RLX_AGENT __ATOMIC_RELAXED, __HIP_MEMORY_SCOPE_AGENT
#define LDS_WAIT() asm volatile("s_waitcnt lgkmcnt(0)" ::: "memory")
#define VM_WAIT() asm volatile("s_waitcnt vmcnt(0)" ::: "memory")
#ifndef TPROBE
#define TPROBE 0
#endif
#ifndef TPN
#define TPN 4
#endif
#define TP_BEGIN(k) long long _tp0_##k = 0; if (TPROBE == (k)) _tp0_##k = (long long)__builtin_amdgcn_s_memrealtime()
#define TP_END(k) do { if (TPROBE == (k)) { const long long _t1 = (long long)__builtin_amdgcn_s_memrealtime(), _dt = _t1 - _tp0_##k; while ((long long)__builtin_amdgcn_s_memrealtime() - _t1 < (long long)TPN * _dt) __builtin_amdgcn_s_sleep(4); } } while (0)
__device__ __forceinline__ unsigned pk2(float lo, float hi) { unsigned r; asm("v_cvt_pk_bf16_f32 %0, %1, %2" : "=v"(r) : "v"(lo), "v"(hi)); return r; }
__device__ __forceinline__ bf16 f2bf1(float x) { return (bf16)(pk2(x, x) & 0xffffu); }
__device__ __forceinline__ float bflo(unsigned w) { return __builtin_bit_cast(float, w << 16); }
__device__ __forceinline__ float bfhi(unsigned w) { return __builtin_bit_cast(float, w & 0xffff0000u); }

#define XB_TMO      128
#define XB_XCNT(j)  (256  + 64 * (j))
#define XB_XSUB(j)  (1280 + 64 * (j))
#define XB_XGEN(j)  (2304 + 64 * (j))
#define XB_TOP      3328
#define XB_TOPGEN   3392
#define XCD_BAR_WORDS 3456
#define XB_SPIN_CAP (1u << 18)
__device__ __forceinline__ unsigned xb_ld(unsigned* p)              { return __hip_atomic_load(p, __ATOMIC_RELAXED, __HIP_MEMORY_SCOPE_AGENT); }
__device__ __forceinline__ unsigned xb_add(unsigned* p, unsigned v) { return __hip_atomic_fetch_add(p, v, __ATOMIC_RELAXED, __HIP_MEMORY_SCOPE_AGENT); }
__device__ __forceinline__ unsigned xb_xcc_id() { return (unsigned)__builtin_amdgcn_s_getreg((3 << 11) | 20) & 0xFu; }
#define XB_SPIN(cond, bar) do { unsigned _sp = 0; while (cond) { __builtin_amdgcn_s_sleep(1); \
    if ((++_sp & 255u) == 0u) { if (xb_ld(&(bar)[XB_TMO])) break; if (_sp > XB_SPIN_CAP) { atomicAdd(&(bar)[XB_TMO], 1u); break; } } } } while (0)
struct XcdBarrier { unsigned* bar; unsigned x; volatile LAS unsigned* st; };
__device__ __forceinline__ XcdBarrier xcd_barrier_post(unsigned* bar, volatile LAS unsigned* st) {
    XcdBarrier b; b.bar = bar; b.x = xb_xcc_id(); b.st = st;
    if (threadIdx.x == 0) (void)xb_add(&bar[XB_XCNT(b.x)], 1u);
    return b;
}
__device__ __forceinline__ void xcd_barrier_complete(unsigned* bar, unsigned x, unsigned& nloc, unsigned& nx) {
    const unsigned G = gridDim.x * gridDim.y * gridDim.z;
    unsigned sum, cnt, mine, sp = 0u;
    for (;;) {
        sum = 0u; cnt = 0u; mine = 0u;
#pragma unroll
        for (unsigned j = 0; j < 16; ++j) { const unsigned c = xb_ld(&bar[XB_XCNT(j)]); sum += c; cnt += (c > 0u) ? 1u : 0u; mine = (j == x) ? c : mine; }
        if (sum == G) break;
        __builtin_amdgcn_s_sleep(1);
        if ((++sp & 255u) == 0u) { if (xb_ld(&bar[XB_TMO])) break; if (sp > XB_SPIN_CAP) { atomicAdd(&bar[XB_TMO], 1u); break; } }
    }
    nloc = mine > 0u ? mine : 1u; nx = cnt > 0u ? cnt : 1u;
}
__device__ __attribute__((noinline)) void xcd_barrier(unsigned* bar_, unsigned x_, volatile LAS unsigned* st_) {
    XcdBarrier b; b.bar = bar_; b.x = x_; b.st = st_;
    asm volatile("s_waitcnt vmcnt(0)" ::: "memory");
    __syncthreads();
    if (threadIdx.x == 0) {
        unsigned* bar = b.bar;
        __builtin_amdgcn_s_waitcnt(0);
        unsigned nloc = b.st[0], nx = b.st[1];
        if (nloc == 0u) { xcd_barrier_complete(bar, b.x, nloc, nx); b.st[0] = nloc; b.st[1] = nx; }
        const unsigned old = xb_add(&bar[XB_XSUB(b.x)], 1u);
        const unsigned gen = old / nloc;
        if (old + 1u == (gen + 1u) * nloc) {
            __builtin_amdgcn_fence(__ATOMIC_RELEASE, "agent");
            asm volatile("s_waitcnt vmcnt(0)" ::: "memory");
            const unsigned og = xb_add(&bar[XB_TOP], 1u);
            const unsigned tg = og / nx;
            if (og + 1u == (tg + 1u) * nx) xb_add(&bar[XB_TOPGEN], 1u);
            else XB_SPIN(xb_ld(&bar[XB_TOPGEN]) == tg, bar);
            __builtin_amdgcn_fence(__ATOMIC_ACQUIRE, "agent");
            xb_add(&bar[XB_XGEN(b.x)], 1u);
            asm volatile("s_waitcnt vmcnt(0)" ::: "memory");
        } else {
            XB_SPIN(xb_ld(&bar[XB_XGEN(b.x)]) == gen, bar);
            __builtin_amdgcn_fence(__ATOMIC_ACQUIRE, "agent");
            asm volatile("s_waitcnt vmcnt(0)" ::: "memory");
        }
    }
    __syncthreads();
}

struct Args { const float* in[28]; float* out; unsigned char* ws; int ph_lo, ph_hi, li, pad; };
enum { I_X = 0, I_C, I_ADAW, I_ADAB, I_N1G, I_WIN, I_CONVW, I_CONVB, I_WR, I_BR, I_WI, I_BI, I_LAM, I_LNG, I_LNB, I_SGUW, I_SGUB, I_GNL, I_GNS, I_WOUT, I_N2G, I_RW, I_RB, I_WGU, I_BGU, I_WDN, I_BDN, I_FG };
constexpr int NPH = 11;

template <int CTRL> __device__ __forceinline__ float dppf(float v) { return __builtin_bit_cast(float, __builtin_amdgcn_update_dpp(0, __builtin_bit_cast(int, v), CTRL, 0xF, 0xF, true)); }
__device__ __forceinline__ float xor16f(float v, float& own) { const unsigned a = __builtin_bit_cast(unsigned, v); const auto r = __builtin_amdgcn_permlane16_swap(a, a, false, false); own = __builtin_bit_cast(float, (unsigned)r[0]); return __builtin_bit_cast(float, (unsigned)r[1]); }
__device__ __forceinline__ float xor32f(float v, float& own) { const unsigned a = __builtin_bit_cast(unsigned, v); const auto r = __builtin_amdgcn_permlane32_swap(a, a, false, false); own = __builtin_bit_cast(float, (unsigned)r[0]); return __builtin_bit_cast(float, (unsigned)r[1]); }
__device__ __forceinline__ float sum32(float v) {
    v += dppf<0xB1>(v); v += dppf<0x4E>(v); v += dppf<0x141>(v); v += dppf<0x140>(v); float o; const float p = xor16f(v, o); return o + p; }
__device__ __forceinline__ float max32(float v) {
    v = fmaxf(v, dppf<0xB1>(v)); v = fmaxf(v, dppf<0x4E>(v)); v = fmaxf(v, dppf<0x141>(v)); v = fmaxf(v, dppf<0x140>(v)); float o; const float p = xor16f(v, o); return fmaxf(o, p); }
__device__ __forceinline__ float wave_sum(float v) { v = sum32(v); float o; const float p = xor32f(v, o); return o + p; }

struct P0Item { const float* src; size_t step; unsigned char* dst; const float* ksc; int k0, kind; };
__device__ __forceinline__ void p0_load(f32x4 (&v)[16], const P0Item& it) {
#pragma unroll
    for (int i = 0; i < 16; ++i) v[i] = __builtin_nontemporal_load((const f32x4*)(it.src + (size_t)i * it.step));
}
__device__ __forceinline__ void p0_process(const f32x4 (&v)[16], const P0Item& it, LAS float* scr, int lane) {
    if (it.kind == 0) {
#pragma unroll
        for (int i = 0; i < 16; ++i) { const int kk = 4 * i + (lane >> 4); f32x4 w = v[i];
            if (it.ksc) w = w * it.ksc[it.k0 + kk];
            LAS float* d = scr + kk * 65 + 4 * (lane & 15); d[0] = w.x; d[1] = w.y; d[2] = w.z; d[3] = w.w; }
        LDS_WAIT();
        const int c = lane & 7;
#pragma unroll
        for (int j = 0; j < 8; ++j) { const int n = (lane >> 3) + 8 * j; const LAS float* s = scr + (8 * c) * 65 + n;
            v4u o; o.x = pk2(s[0 * 65], s[1 * 65]); o.y = pk2(s[2 * 65], s[3 * 65]); o.z = pk2(s[4 * 65], s[5 * 65]); o.w = pk2(s[6 * 65], s[7 * 65]);
            *(v4u*)(it.dst + ((size_t)n * D + it.k0 + 8 * c) * 2) = o; }
        LDS_WAIT();
    } else {
#pragma unroll
        for (int i = 0; i < 16; ++i) { const int kk = 8 * i + (lane >> 3); const f32x4 w = v[i] * pg8::W8_SCALE;
            LAS float* d = scr + kk * 33 + 4 * (lane & 7); d[0] = w.x; d[1] = w.y; d[2] = w.z; d[3] = w.w; }
        LDS_WAIT();
#pragma unroll
        for (int j = 0; j < 8; ++j) { const int n = (lane & 7) + 8 * (j & 3), c = (lane >> 3) + 8 * (j >> 2); const LAS float* s = scr + (8 * c) * 33 + n;
            v2u o; o.x = pg8::pk4_fp8(s[0 * 33], s[1 * 33], s[2 * 33], s[3 * 33]); o.y = pg8::pk4_fp8(s[4 * 33], s[5 * 33], s[6 * 33], s[7 * 33]);
            *(v2u*)(it.dst + (size_t)n * D + it.k0 + 8 * c) = o; }
        LDS_WAIT();
    }
}
__device__ __forceinline__ void p0_prologue(const Args& a, LAS unsigned char* lds, int tid, int lane, int wave, int vcu, int G) {
    unsigned char* ws = a.ws;
    TP_BEGIN(1);
    for (int u = vcu; u < 192; u += G) {
        const int cb = u % 12, ks = u / 12; LAS float* sl = (LAS float*)lds; LAS float* red = (LAS float*)(lds + 1024);
        const int g = tid >> 7, c4 = tid & 127; f32x4 w[16];
        { const float* src = a.in[I_ADAW] + (size_t)(ks * 64 + g) * 6144 + cb * 512 + 4 * c4;
#pragma unroll
          for (int i = 0; i < 16; ++i) w[i] = __builtin_nontemporal_load((const f32x4*)(src + (size_t)(4 * i) * 6144)); }
        if (tid < 256) { const float c = a.in[I_C][(tid >> 6) * 1024 + ks * 64 + (tid & 63)]; sl[tid] = c * sigmoidf_(c); }
        __syncthreads();
        f32x4 acc[4];
#pragma unroll
        for (int bb = 0; bb < 4; ++bb) acc[bb] = (f32x4){0.f, 0.f, 0.f, 0.f};
#pragma unroll
        for (int i = 0; i < 16; ++i) { const int kk = g + 4 * i;
#pragma unroll
            for (int bb = 0; bb < 4; ++bb) acc[bb] += w[i] * sl[bb * 64 + kk]; }
#pragma unroll
        for (int bb = 0; bb < 4; ++bb) *(LAS f32x4*)(red + (g * 4 + bb) * 512 + 4 * c4) = acc[bb];
        __syncthreads();
        float* mp = (float*)(ws + WS_MODP) + (size_t)(ks * 4) * 6144 + cb * 512 + tid;
#pragma unroll
        for (int bb = 0; bb < 4; ++bb) mp[bb * 6144] = (red[bb * 512 + tid] + red[(4 + bb) * 512 + tid]) + (red[(8 + bb) * 512 + tid] + red[(12 + bb) * 512 + tid]);
        __syncthreads();
    }
    TP_END(1); TP_BEGIN(2);
    for (int j = vcu; j < 48; j += G) {
        if (j < 16) { const int m = j >> 3, h = j & 7; const float* src = a.in[m ? I_WI : I_WR] + h * 4096; bf16* dst = (bf16*)(ws + WS_WRT) + (m * 8 + h) * 4096;
            for (int idx = tid; idx < 4096; idx += 512) { const int o = idx >> 6, i = idx & 63; dst[idx] = (bf16)f2bf(src[i * 64 + o]); } }
        else { const int q = j - 16; bf16* dst = (bf16*)(ws + WS_WM);
            for (int idx = q * 4096 + tid; idx < (q + 1) * 4096; idx += 512) { const int t = (idx >> 7) & 127, s = idx & 127; dst[idx] = s <= t ? (bf16)f2bf(a.in[I_SGUW][idx]) : (bf16)0; } }
    }
    TP_END(2); TP_BEGIN(3);
    LAS float* scr = (LAS float*)(lds + wave * 16896);
    const int gw = vcu * NWAVES + wave, NGW = G * NWAVES;
    constexpr int I_IN = 16 * 32, I_OUT = 16 * 16, I_GU = 32 * 16 * 32, I_DN = 32 * 16 * 16, NITEMS = I_IN + I_OUT + I_GU + I_DN;
    const float* pWIN = a.in[I_WIN]; const float* pWOUT = a.in[I_WOUT]; const float* pWGU = a.in[I_WGU]; const float* pWDN = a.in[I_WDN]; const float* pGNL = a.in[I_GNL]; const float* pGNS = a.in[I_GNS];
    auto decode = [&](int it0, P0Item& o) {
        int r = it0;
        if (r < I_IN) { const int kb = r >> 5, nb = r & 31; o.kind = 0; o.k0 = 64 * kb; o.ksc = nullptr;
            o.src = pWIN + (size_t)(64 * kb + (lane >> 4)) * NPROJ + 64 * nb + 4 * (lane & 15); o.step = (size_t)4 * NPROJ; o.dst = ws + WS_WINT + (size_t)(64 * nb) * D * 2; return; }
        r -= I_IN;
        if (r < I_OUT) { const int kb = r >> 4, nb = r & 15; o.kind = 0; o.k0 = 64 * kb; o.ksc = o.k0 < DL ? pGNL : pGNS - DL;
            o.src = pWOUT + (size_t)(64 * kb + (lane >> 4)) * D + 64 * nb + 4 * (lane & 15); o.step = (size_t)4 * D; o.dst = ws + WS_WOUTT + (size_t)(64 * nb) * D * 2; return; }
        r -= I_OUT;
        if (r < I_GU) { const int e = r >> 9, q = r & 511, kb = q >> 6, nb = q & 63; const int n0 = 32 * nb, n1 = n0 & 1023; const int rd = (n1 >> 7) * 256 + (n0 >= 1024 ? 128 : 0) + (n1 & 127);
            o.kind = 1; o.k0 = 128 * kb; o.ksc = nullptr;
            o.src = pWGU + (size_t)e * D * 2048 + (size_t)(128 * kb + (lane >> 3)) * 2048 + n0 + 4 * (lane & 7); o.step = (size_t)8 * 2048; o.dst = ws + WS_WGUT + ((size_t)e * 2048 + rd) * D; return; }
        r -= I_GU;
        { const int e = r >> 8, q = r & 255, kb = q >> 5, nb = q & 31; o.kind = 1; o.k0 = 128 * kb; o.ksc = nullptr;
            o.src = pWDN + (size_t)e * D * D + (size_t)(128 * kb + (lane >> 3)) * D + 32 * nb + 4 * (lane & 7); o.step = (size_t)8 * D; o.dst = ws + WS_WDNT + ((size_t)e * D + 32 * nb) * D; }
    };
    int it = gw;
    if (it < NITEMS) {
        P0Item cur; f32x4 vc[16]; decode(it, cur); p0_load(vc, cur);
        for (;;) {
            const int itn = it + NGW; const bool more = itn < NITEMS;
            P0Item nxt = cur; f32x4 vn[16];
            if (more) { decode(itn, nxt); p0_load(vn, nxt); }
            p0_process(vc, cur, scr, lane);
            if (!more) break;
            cur = nxt; it = itn;
#pragma unroll
            for (int i = 0; i < 16; ++i) vc[i] = vn[i];
        }
    }
    TP_END(3);
}
__device__ __forceinline__ void p1_modz(const Args& a, LAS unsigned char* lds, int tid, int lane, int wave, int vcu, int G) {
    const float* modp = (const float*)(a.ws + WS_MODP); float* mod = (float*)(a.ws + WS_MOD); bf16* Z = (bf16*)(a.ws + WS_Z); bf16* XB = (bf16*)(a.ws + WS_XB);
    for (int idx = vcu * 512 + tid; idx < 4 * 6144; idx += G * 512) { const int b = idx / 6144, n = idx - b * 6144; float s = a.in[I_ADAB][n];
#pragma unroll
        for (int ks = 0; ks < 16; ++ks) s += modp[(size_t)(ks * 4 + b) * 6144 + n];
        mod[idx] = s; }
    const int wpb = G / 4, b = vcu / wpb;
    LAS float* SHs = (LAS float*)lds; LAS float* SCs = (LAS float*)(lds + 4096);
    for (int k = tid; k < 2048; k += 512) { float s = a.in[I_ADAB][k];
#pragma unroll
        for (int ks = 0; ks < 16; ++ks) s += modp[(size_t)(ks * 4 + b) * 6144 + k];
        if (k < 1024) SHs[k] = s; else SCs[k - 1024] = (1.f + s) * a.in[I_N1G][k - 1024]; }
    __syncthreads();
    const int lw = (vcu - b * wpb) * NWAVES + wave, nlw = wpb * NWAVES;
#ifndef P1_NR
#define P1_NR 4
#endif
    for (int t = lw; t < SEQ; t += P1_NR * nlw) {
        f32x4 v[P1_NR][4]; float s[P1_NR];
#pragma unroll
        for (int q = 0; q < P1_NR; ++q) { const int tq_ = min(t + q * nlw, SEQ - 1); const f32x4* xr = (const f32x4*)(a.in[I_X] + ((size_t)b * SEQ + tq_) * D) + lane;
#pragma unroll
            for (int j = 0; j < 4; ++j) v[q][j] = __builtin_nontemporal_load(xr + 64 * j); }
#pragma unroll
        for (int q = 0; q < P1_NR; ++q) { s[q] = 0.f;
#pragma unroll
            for (int j = 0; j < 4; ++j) s[q] += (v[q][j].x * v[q][j].x + v[q][j].y * v[q][j].y) + (v[q][j].z * v[q][j].z + v[q][j].w * v[q][j].w);
            s[q] = rsqrtf(wave_sum(s[q]) * (1.f / D) + EPS); }
#pragma unroll
        for (int q = 0; q < P1_NR; ++q) if (t + q * nlw < SEQ) { v2u* o8 = (v2u*)(Z + ((size_t)b * SEQ + t + q * nlw) * D) + lane; v2u* x8 = (v2u*)(XB + ((size_t)b * SEQ + t + q * nlw) * D) + lane;
#pragma unroll
            for (int j = 0; j < 4; ++j) { const f32x4 g = *(const LAS f32x4*)(SCs + 4 * lane + 256 * j), sh = *(const LAS f32x4*)(SHs + 4 * lane + 256 * j); const f32x4 z = v[q][j] * s[q] * g + sh;
                v2u w; w.x = pk2(z.x, z.y); w.y = pk2(z.z, z.w); o8[64 * j] = w;
                v2u xw; xw.x = pk2(v[q][j].x, v[q][j].y); xw.y = pk2(v[q][j].z, v[q][j].w); x8[64 * j] = xw; } }
    }
    __syncthreads();
}
constexpr int XS = 516;
template <bool PASSB>
__device__ __forceinline__ void lru_unit(const Args& a, LAS unsigned char* lds, int tid, int lane, int wave, int unit) {
    const int b = unit >> 6, tb = unit & 63; const size_t row0 = (size_t)b * SEQ + tb * 64;
    const bf16* P = (const bf16*)(a.ws + WS_PROJ); float* agg = (float*)(a.ws + WS_AGG); bf16* HEADS = (bf16*)(a.ws + WS_HEADS); unsigned* phg = (unsigned*)(a.ws + WS_O32);
    LAS float* xcf = (LAS float*)lds; LAS float* Al = (LAS float*)(lds + 33280); LAS float* Bl = (LAS float*)(lds + 66560);
    LAS float* cst = (LAS float*)(lds + 99840); LAS float* rsl = (LAS float*)(lds + 105984);
    const int ch = tid, h = wave, tq = lane & 15, kq = lane >> 4;
    TP_BEGIN(311);
    bf16 xan[16], yan[16];
#pragma unroll
    for (int i = 0; i < 16; ++i) { xan[i] = __builtin_nontemporal_load(P + (row0 + i) * NPROJ + ch); if (PASSB) yan[i] = P[(row0 + i) * NPROJ + 512 + ch]; }
    const float cw0 = a.in[I_CONVW][ch], cw1 = a.in[I_CONVW][DL + ch], cw2 = a.in[I_CONVW][2 * DL + ch], cw3 = a.in[I_CONVW][3 * DL + ch], cb = a.in[I_CONVB][ch];
    cst[ch] = a.in[I_BR][ch]; cst[512 + ch] = a.in[I_BI][ch]; cst[1024 + ch] = log1pf(expf(-a.in[I_LAM][ch]));
    bf16x8 wrf[4][2], wif[4][2];
    { const bf16* wrt = (const bf16*)(a.ws + WS_WRT) + h * 4096; const bf16* wit = wrt + 8 * 4096;
#pragma unroll
      for (int ct = 0; ct < 4; ++ct)
#pragma unroll
          for (int ks = 0; ks < 2; ++ks) { const int off = (16 * ct + tq) * 64 + ks * 32 + 8 * kq; wrf[ct][ks] = *(const bf16x8*)(wrt + off); wif[ct][ks] = *(const bf16x8*)(wit + off); } }
    float x1 = 0.f, x2 = 0.f, x3 = 0.f;
    if (tb > 0) { x1 = bf2f(P[(row0 - 1) * NPROJ + ch]); x2 = bf2f(P[(row0 - 2) * NPROJ + ch]); x3 = bf2f(P[(row0 - 3) * NPROJ + ch]); }
    float hs = 0.f, pp = 1.f;
    if (PASSB) { const float* ag = agg + ((size_t)(b * 64) * 512 + ch) * 2;
        for (int c0 = 0; c0 < tb; c0 += 32) { float2 ph[32];
#pragma unroll
            for (int j = 0; j < 32; ++j) { ph[j].x = 1.f; ph[j].y = 0.f; if (c0 + j < tb) ph[j] = *(const float2*)(ag + (size_t)(c0 + j) * 1024); }
#pragma unroll
            for (int j = 0; j < 32; ++j) hs = ph[j].x * hs + ph[j].y; } }
    __syncthreads();
    TP_END(311);
    for (int sub = 0; sub < 4; ++sub) {
        TP_BEGIN(312);
        const size_t r0 = row0 + sub * 16;
        float xav[16], o[16];
#pragma unroll
        for (int i = 0; i < 16; ++i) { xav[i] = bf2f(xan[i]); if (PASSB) o[i] = bf2f(yan[i]); }
        if (sub < 3) {
#pragma unroll
            for (int i = 0; i < 16; ++i) { xan[i] = __builtin_nontemporal_load(P + (r0 + 16 + i) * NPROJ + ch); if (PASSB) yan[i] = P[(r0 + 16 + i) * NPROJ + 512 + ch]; } }
#pragma unroll
        for (int i = 0; i < 16; ++i) { const float xa = xav[i]; xcf[i * XS + ch] = cw0 * x3 + cw1 * x2 + cw2 * x1 + cw3 * xa + cb; x3 = x2; x2 = x1; x1 = xa; }
        __syncthreads();
        TP_END(312); TP_BEGIN(313);
        {
            bf16x8 xb[2];
#pragma unroll
            for (int ks = 0; ks < 2; ++ks) { const LAS float* p = xcf + tq * XS + h * 64 + ks * 32 + 8 * kq; const f32x4 lo = *(const LAS f32x4*)p, hi = *(const LAS f32x4*)(p + 4);
                const v4u w = {pk2(lo.x, lo.y), pk2(lo.z, lo.w), pk2(hi.x, hi.y), pk2(hi.z, hi.w)}; xb[ks] = __builtin_bit_cast(bf16x8, w); }
#pragma unroll
            for (int ct = 0; ct < 4; ++ct) { f32x4 rec = {0.f, 0.f, 0.f, 0.f}, inp = {0.f, 0.f, 0.f, 0.f};
#pragma unroll
                for (int ks = 0; ks < 2; ++ks) { rec = __builtin_amdgcn_mfma_f32_16x16x32_bf16(wrf[ct][ks], xb[ks], rec, 0, 0, 0); inp = __builtin_amdgcn_mfma_f32_16x16x32_bf16(wif[ct][ks], xb[ks], inp, 0, 0, 0); }
                const int cbase = h * 64 + 16 * ct + 4 * kq;
                const f32x4 xc4 = *(const LAS f32x4*)(xcf + tq * XS + cbase), br4 = *(const LAS f32x4*)(cst + cbase), bi4 = *(const LAS f32x4*)(cst + 512 + cbase), sp4 = *(const LAS f32x4*)(cst + 1024 + cbase);
                f32x4 av, bt;
                {
                    const f32x4 er = (rec + br4) * (-1.4426950409f), ei = (inp + bi4) * (-1.4426950409f); f32x4 rr, ig;
#pragma unroll
                    for (int r = 0; r < 4; ++r) { rr[r] = __builtin_amdgcn_rcpf(1.f + __builtin_amdgcn_exp2f(er[r])); ig[r] = __builtin_amdgcn_rcpf(1.f + __builtin_amdgcn_exp2f(ei[r])); }
                    const f32x4 la = rr * sp4 * (-8.f), y = la * 2.f, l2 = la * 1.4426950409f;
#pragma unroll
                    for (int r = 0; r < 4; ++r) av[r] = __builtin_amdgcn_exp2f(l2[r]);
                    const f32x4 ser = -y * (y * (y * (y * (y * 0.0083333338f + 0.041666668f) + 0.16666667f) + 0.5f) + 1.f), big = (f32x4){1.f, 1.f, 1.f, 1.f} - av * av; f32x4 em;
#pragma unroll
                    for (int r = 0; r < 4; ++r) em[r] = __builtin_amdgcn_sqrtf(y[r] > -0.25f ? ser[r] : big[r]);
                    bt = em * ig * xc4; }
                *(LAS f32x4*)(Al + tq * XS + cbase) = av; *(LAS f32x4*)(Bl + tq * XS + cbase) = bt; }
        }
        __syncthreads();
        TP_END(313); TP_BEGIN(314);
#pragma unroll
        for (int i = 0; i < 16; ++i) { const float av = Al[i * XS + ch], bt = Bl[i * XS + ch]; hs = av * hs + bt; if (PASSB) o[i] *= hs; else { pp *= av; phg[(r0 + i) * 512 + ch] = pk2(pp, hs); } }
        if (PASSB) {
#pragma unroll
            for (int i = 0; i < 16; ++i) Al[i * XS + ch] = o[i];
            __syncthreads();
            { const int t = tid >> 5, part = tid & 31; float s = 0.f;
#pragma unroll
              for (int j = 0; j < 16; ++j) { const float v = Al[t * XS + part + 32 * j]; s += v * v; }
              s = sum32(s);
              if (part == 0) rsl[t] = rsqrtf(s * (1.f / 512.f) + EPS); }
            __syncthreads();
#pragma unroll
            for (int i = 0; i < 16; ++i) HEADS[(r0 + i) * D + ch] = f2bf1(o[i] * rsl[i]);
        }
        __syncthreads();
        TP_END(314);
    }
    if (!PASSB) { float2 ph; ph.x = pp; ph.y = hs; *(float2*)(agg + ((size_t)(b * 64 + tb) * 512 + ch) * 2) = ph; }
}
__device__ __forceinline__ void lru_passb_unit(const Args& a, LAS unsigned char* lds, int tid, int lane, int wave, int unit) {
    const int b = unit >> 6, tb = unit & 63; const size_t row0 = (size_t)b * SEQ + tb * 64;
    const bf16* P = (const bf16*)(a.ws + WS_PROJ); const float* agg = (const float*)(a.ws + WS_AGG); bf16* HEADS = (bf16*)(a.ws + WS_HEADS); const unsigned* phg = (const unsigned*)(a.ws + WS_O32);
    LAS float* ol = (LAS float*)lds; LAS float* rsl = (LAS float*)(lds + 33280);
    const int ch = tid;
    unsigned phn[16]; bf16 yan[16];
#pragma unroll
    for (int i = 0; i < 16; ++i) { phn[i] = __builtin_nontemporal_load(phg + (row0 + i) * 512 + ch); yan[i] = __builtin_nontemporal_load(P + (row0 + i) * NPROJ + 512 + ch); }
    float carry = 0.f;
    { const float* ag = agg + ((size_t)(b * 64) * 512 + ch) * 2;
      float2 ph[63];
#pragma unroll
      for (int j = 0; j < 63; ++j) { ph[j].x = 1.f; ph[j].y = 0.f; if (j < tb) ph[j] = *(const float2*)(ag + (size_t)j * 1024); }
#pragma unroll
      for (int j = 0; j < 63; ++j) carry = ph[j].x * carry + ph[j].y; }
    for (int sub = 0; sub < 4; ++sub) {
        const size_t r0 = row0 + sub * 16; float o[16];
#pragma unroll
        for (int i = 0; i < 16; ++i) o[i] = (bfhi(phn[i]) + bflo(phn[i]) * carry) * bf2f(yan[i]);
        if (sub < 3) {
#pragma unroll
            for (int i = 0; i < 16; ++i) { phn[i] = __builtin_nontemporal_load(phg + (r0 + 16 + i) * 512 + ch); yan[i] = __builtin_nontemporal_load(P + (r0 + 16 + i) * NPROJ + 512 + ch); } }
#pragma unroll
        for (int i = 0; i < 16; ++i) ol[i * XS + ch] = o[i];
        __syncthreads();
        { const int t = tid >> 5, part = tid & 31; float sq = 0.f;
#pragma unroll
          for (int j = 0; j < 16; ++j) { const float v = ol[t * XS + part + 32 * j]; sq += v * v; }
          sq = sum32(sq);
          if (part == 0) rsl[t] = rsqrtf(sq * (1.f / 512.f) + EPS); }
        __syncthreads();
#pragma unroll
        for (int i = 0; i < 16; ++i) HEADS[(r0 + i) * D + ch] = f2bf1(o[i] * rsl[i]);
        __syncthreads();
    }
}
__device__ __forceinline__ void sgu_unit(const Args& a, LAS unsigned char* lds, int tid, int lane, int wave, int unit) {
    constexpr int RS = 132;
    const int th = unit & 1, bn = unit >> 1, Ks = 64 * (th + 1); const size_t rowbase = (size_t)bn * CHUNK;
    const bf16* P = (const bf16*)(a.ws + WS_PROJ); bf16* HEADS = (bf16*)(a.ws + WS_HEADS); const bf16* WM = (const bf16*)(a.ws + WS_WM);
    LAS bf16* vnT = (LAS bf16*)lds; LAS float* ssq = (LAS float*)(lds + 135168);
    bf16x8 wfr[4][4];
    { const bf16* wmh0 = WM + (size_t)wave * 16384 + (size_t)(64 * th + (lane & 15)) * 128 + 8 * (lane >> 4);
#pragma unroll
      for (int rt = 0; rt < 4; ++rt)
#pragma unroll
          for (int ks = 0; ks < 4; ++ks) { wfr[rt][ks] = (bf16x8){0, 0, 0, 0, 0, 0, 0, 0}; if (32 * ks < Ks && 32 * ks <= 64 * th + 16 * rt + 15) wfr[rt][ks] = *(const bf16x8*)(wmh0 + rt * 16 * 128 + 32 * ks); } }
    TP_BEGIN(321);
    {
        float lg[8], lb[8];
#pragma unroll
        for (int j = 0; j < 8; ++j) { lg[j] = a.in[I_LNG][lane + 64 * j]; lb[j] = a.in[I_LNB][lane + 64 * j]; }
        for (int s8 = 8 * wave; s8 < Ks; s8 += 8 * NWAVES) { float v[8][8]; float mean[8], rstd[8];
#pragma unroll
            for (int q = 0; q < 8; ++q) { const bf16* prow = P + (rowbase + s8 + q) * NPROJ + 1536;
#pragma unroll
                for (int j = 0; j < 8; ++j) v[q][j] = bf2f(__builtin_nontemporal_load(prow + lane + 64 * j)); }
#pragma unroll
            for (int q = 0; q < 8; ++q) { float sm = 0.f;
#pragma unroll
                for (int j = 0; j < 8; ++j) sm += v[q][j];
                mean[q] = sm; }
#pragma unroll
            for (int q = 0; q < 8; ++q) { mean[q] = wave_sum(mean[q]) * (1.f / 512.f); float qq = 0.f;
#pragma unroll
                for (int j = 0; j < 8; ++j) { v[q][j] -= mean[q]; qq += v[q][j] * v[q][j]; }
                rstd[q] = qq; }
#pragma unroll
            for (int q = 0; q < 8; ++q) rstd[q] = rsqrtf(wave_sum(rstd[q]) * (1.f / 512.f) + EPS);
#pragma unroll
            for (int j = 0; j < 8; ++j) {
#pragma unroll
                for (int g = 0; g < 2; ++g) { v2u w; w.x = pk2(v[4 * g][j] * rstd[4 * g] * lg[j] + lb[j], v[4 * g + 1][j] * rstd[4 * g + 1] * lg[j] + lb[j]); w.y = pk2(v[4 * g + 2][j] * rstd[4 * g + 2] * lg[j] + lb[j], v[4 * g + 3][j] * rstd[4 * g + 3] * lg[j] + lb[j]);
                    *(LAS v2u*)(vnT + (lane + 64 * j) * RS + s8 + 4 * g) = w; } } }
    }
    __syncthreads();
    TP_END(321);
    TP_BEGIN(322);
    const int h = wave, tq = lane & 15, kq = lane >> 4;
    f32x4 acc[4][4];
#pragma unroll
    for (int rt = 0; rt < 4; ++rt)
#pragma unroll
        for (int ct = 0; ct < 4; ++ct) acc[rt][ct] = (f32x4){0.f, 0.f, 0.f, 0.f};
    v2u uw[4][4]; float bias4[4];
#pragma unroll
    for (int rt = 0; rt < 4; ++rt) { const int t = 64 * th + 16 * rt + tq; bias4[rt] = a.in[I_SGUB][h * CHUNK + t]; const bf16* urow = P + (rowbase + t) * NPROJ + 1024 + h * 64 + 4 * kq;
#pragma unroll
        for (int ct = 0; ct < 4; ++ct) uw[rt][ct] = __builtin_nontemporal_load((const v2u*)(urow + 16 * ct)); }
#pragma unroll
    for (int ks = 0; ks < 4; ++ks) { if (32 * ks >= Ks) break;
        bf16x8 vf[4];
#pragma unroll
        for (int ct = 0; ct < 4; ++ct) { const LAS bf16* p = vnT + (h * 64 + 16 * ct + tq) * RS + 32 * ks + 8 * kq; const bf16x4 lo = *(const LAS bf16x4*)p, hi = *(const LAS bf16x4*)(p + 4);
            vf[ct] = (bf16x8){lo[0], lo[1], lo[2], lo[3], hi[0], hi[1], hi[2], hi[3]}; }
#pragma unroll
        for (int rt = 0; rt < 4; ++rt) if (32 * ks <= 64 * th + 16 * rt + 15) { const bf16x8 wf = wfr[rt][ks];
#pragma unroll
            for (int ct = 0; ct < 4; ++ct) acc[rt][ct] = __builtin_amdgcn_mfma_f32_16x16x32_bf16(vf[ct], wf, acc[rt][ct], 0, 0, 0); }
    }
    TP_END(322);
#pragma unroll
    for (int rt = 0; rt < 4; ++rt) { const float bias = bias4[rt]; float sl = 0.f;
#pragma unroll
        for (int ct = 0; ct < 4; ++ct) { const v2u uq = uw[rt][ct];
            f32x4 o; o.x = bflo(uq.x) * (acc[rt][ct].x + bias); o.y = bfhi(uq.x) * (acc[rt][ct].y + bias); o.z = bflo(uq.y) * (acc[rt][ct].z + bias); o.w = bfhi(uq.y) * (acc[rt][ct].w + bias);
            acc[rt][ct] = o; sl += (o.x * o.x + o.y * o.y) + (o.z * o.z + o.w * o.w); }
        { float o_; const float p_ = xor16f(sl, o_); sl = o_ + p_; } { float o_; const float p_ = xor32f(sl, o_); sl = o_ + p_; }
        if (kq == 0) ssq[(16 * rt + tq) * 8 + h] = sl; }
    __syncthreads();
#pragma unroll
    for (int rt = 0; rt < 4; ++rt) { const int tl = 16 * rt + tq; const f32x4 s0 = *(const LAS f32x4*)(ssq + tl * 8), s1 = *(const LAS f32x4*)(ssq + tl * 8 + 4);
        const float rs = rsqrtf(((s0.x + s0.y) + (s0.z + s0.w) + (s1.x + s1.y) + (s1.z + s1.w)) * (1.f / 512.f) + EPS);
        bf16* hrow = HEADS + (rowbase + 64 * th + tl) * D + DL + h * 64 + 4 * kq;
#pragma unroll
        for (int ct = 0; ct < 4; ++ct) { v2u w; w.x = pk2(acc[rt][ct].x * rs, acc[rt][ct].y * rs); w.y = pk2(acc[rt][ct].z * rs, acc[rt][ct].w * rs); *(v2u*)(hrow + 16 * ct) = w; } }
    __syncthreads();
}
constexpr int RW_PITCH = 2064, RW_IMG = 2 * 32 * RW_PITCH;
constexpr size_t WS_RWS = 12 * MiB, WS_CB = 12 * MiB + 786432;
__device__ __forceinline__ void router_tables(const Args& a, int tid, int lane, int wave, int c, int n) {
    const float* mod = (const float*)(a.ws + WS_MOD); const float* rw = a.in[I_RW]; const float* n2g = a.in[I_N2G];
    for (int idx = c * 512 + tid; idx < 4 * D * NE; idx += n * 512) { const int e = idx & 31, k = (idx >> 5) & 1023, b = idx >> 15;
        const float w = rw[k * NE + e] * (n2g[k] * (1.f + mod[b * 6144 + 4096 + k]));
        const unsigned hi = pk2(w, w) & 0xffffu; const float r = w - __builtin_bit_cast(float, hi << 16); const unsigned mid = pk2(r, r) & 0xffffu;
        bf16* img = (bf16*)(a.ws + WS_RWS + (size_t)b * RW_IMG) + e * (RW_PITCH / 2) + k; img[0] = (bf16)hi; img[RW_IMG / 4] = (bf16)mid; }
    for (int j = c * NWAVES + wave; j < 4 * NE; j += n * NWAVES) { const int b = j >> 5, e = j & 31; float sacc = 0.f;
        for (int k = lane; k < D; k += 64) sacc += mod[b * 6144 + 3072 + k] * rw[k * NE + e];
        sacc = wave_sum(sacc); if (lane == 0) ((float*)(a.ws + WS_CB))[j] = sacc + a.in[I_RB][e]; }
}
template <int DRY>
__device__ __forceinline__ void router_unit(const Args& a, LAS unsigned char* lds, int tid, int lane, int wave, int unit) {
    const int tok0 = unit * 64, b = tok0 / SEQ;
    TP_BEGIN(60); TP_BEGIN(61);
    const float rbv = ((const float*)(a.ws + WS_CB))[b * NE + (lane & 31)];
    const bf16* HB = (const bf16*)(a.ws + WS_PROJ); const float* mod = (const float*)(a.ws + WS_MOD) + b * 6144; unsigned char* Z = a.ws + WS_Z;
    int* toke = (int*)(a.ws + WS_TOKE); float* gatee = (float*)(a.ws + WS_GATEE); int* pos = (int*)(a.ws + WS_POS); unsigned* cursor = (unsigned*)(a.ws + WS_CTL) + CW_CUR;
    LAS int* asg_e = (LAS int*)(lds + 140672); LAS float* asg_g = (LAS float*)(lds + 141696); LAS int* offl = (LAS int*)(lds + 142720);
    LAS float* part = (LAS float*)lds; LAS float* GK = (LAS float*)(lds + 132096); LAS float* SH = (LAS float*)(lds + 136192); LAS float* rsl = (LAS float*)(lds + 140288); LAS int* hist = (LAS int*)(lds + 140544);
    for (int k = tid; k < D; k += 512) { GK[k] = a.in[I_N2G][k] * (1.f + mod[4096 + k]); SH[k] = mod[3072 + k]; }
    if (tid < 32) hist[tid] = 0;
    { const unsigned char* img = a.ws + WS_RWS + (size_t)b * RW_IMG + lane * 16;
#pragma unroll
      for (int p = 0; p < 16; ++p) { const int piece = wave * 16 + p; __builtin_amdgcn_global_load_lds((const unsigned*)(img + piece * 1024), (LAS unsigned*)(lds + piece * 1024), 16, 0, 0); }
      if (wave == 0) __builtin_amdgcn_global_load_lds((const unsigned*)(img + 128 * 1024), (LAS unsigned*)(lds + 128 * 1024), 16, 0, 0); }
    __syncthreads();
    TP_END(61); TP_BEGIN(62);
    v4u dvv[16];
    { const int tt = wave & 3, kh = wave >> 2, ti = lane & 15, kq = lane >> 4; const bf16* drow = HB + (size_t)(tok0 + tt * 16 + ti) * D + kh * 512 + 8 * kq;
#pragma unroll
      for (int blk = 0; blk < 16; ++blk) dvv[blk] = *(const v4u*)(drow + blk * 32); }
    for (int i0 = 0; i0 < 8; i0 += 4) {
        f32x4 v[4][4]; float rs[4];
#pragma unroll
        for (int q = 0; q < 4; ++q) { const size_t ro = (size_t)(tok0 + wave * 8 + i0 + q) * D + 4 * lane;
#pragma unroll
            for (int j = 0; j < 4; ++j) { const v2u d = *(const v2u*)(HB + ro + 256 * j); f32x4 xv; xv.x = bflo(d.x); xv.y = bfhi(d.x); xv.z = bflo(d.y); xv.w = bfhi(d.y); v[q][j] = xv; } }
#pragma unroll
        for (int q = 0; q < 4; ++q) { float s = 0.f;
#pragma unroll
            for (int j = 0; j < 4; ++j) s += (v[q][j].x * v[q][j].x + v[q][j].y * v[q][j].y) + (v[q][j].z * v[q][j].z + v[q][j].w * v[q][j].w);
            rs[q] = rsqrtf(wave_sum(s) * (1.f / D) + EPS); }
#pragma unroll
        for (int q = 0; q < 4; ++q) { const int tl = wave * 8 + i0 + q; unsigned* o4 = (unsigned*)(Z + (size_t)(tok0 + tl) * D) + lane;
#pragma unroll
            for (int j = 0; j < 4; ++j) { const f32x4 g = *(const LAS f32x4*)(GK + 4 * lane + 256 * j), sh = *(const LAS f32x4*)(SH + 4 * lane + 256 * j); const f32x4 z = v[q][j] * rs[q] * g + sh;
                o4[64 * j] = pg8::pk4_fp8(z.x, z.y, z.z, z.w); }
            if (lane == 0) rsl[tl] = rs[q]; } }
    TP_END(62); TP_BEGIN(63);
    asm volatile("s_waitcnt vmcnt(16)" ::: "memory");
    __syncthreads();
    TP_END(63); TP_BEGIN(64);
    if (DRY == 3) { if (dvv[0].x == 0x12345u && dvv[15].w == 0x54321u && dvv[7].y == 0x777u) rsl[0] = 0.f; __syncthreads(); return; }
    {
        const int tt = wave & 3, kh = wave >> 2, ti = lane & 15, kq = lane >> 4;
        f32x4 c0 = {0.f, 0.f, 0.f, 0.f}, c1 = {0.f, 0.f, 0.f, 0.f};
        const LAS unsigned char* bp = lds + ti * RW_PITCH + (kh * 512 + 8 * kq) * 2;
#pragma unroll
        for (int blk = 0; blk < 16; ++blk) { const bf16x8 av = __builtin_bit_cast(bf16x8, dvv[blk]);
            const bf16x8 b00 = *(const LAS bf16x8*)(bp + blk * 64), b01 = *(const LAS bf16x8*)(bp + blk * 64 + RW_IMG / 2), b10 = *(const LAS bf16x8*)(bp + blk * 64 + 16 * RW_PITCH), b11 = *(const LAS bf16x8*)(bp + blk * 64 + 16 * RW_PITCH + RW_IMG / 2);
            c0 = __builtin_amdgcn_mfma_f32_16x16x32_bf16(av, b00, c0, 0, 0, 0); c1 = __builtin_amdgcn_mfma_f32_16x16x32_bf16(av, b10, c1, 0, 0, 0);
            c0 = __builtin_amdgcn_mfma_f32_16x16x32_bf16(av, b01, c0, 0, 0, 0); c1 = __builtin_amdgcn_mfma_f32_16x16x32_bf16(av, b11, c1, 0, 0, 0); }
        __syncthreads();
#pragma unroll
        for (int r = 0; r < 4; ++r) { LAS float* p = part + (kh * 64 + tt * 16 + kq * 4 + r) * 33; p[ti] = c0[r]; p[16 + ti] = c1[r]; }
    }
    __syncthreads();
    TP_END(64); TP_BEGIN(65);
    if (DRY == 2) return;
    {
        const int e = lane & 31, hs = lane & 32;
        float v[4], m0[4], myv[4]; int myk[4];
#pragma unroll
        for (int p = 0; p < 4; ++p) { const int tl = wave * 8 + 2 * p + (lane >> 5); v[p] = (part[tl * 33 + e] + part[(64 + tl) * 33 + e]) * rsl[tl] + rbv; m0[p] = 0.f; myv[p] = 0.f; myk[p] = -1; }
#pragma unroll
        for (int k = 0; k < 4; ++k) { float m[4];
#pragma unroll
            for (int p = 0; p < 4; ++p) m[p] = max32(v[p]);
#pragma unroll
            for (int p = 0; p < 4; ++p) { const unsigned long long bal = __ballot(v[p] == m[p]); const int idx = __ffs((unsigned)(bal >> hs)) - 1;
                if (k == 0) m0[p] = m[p];
                if (e == idx) { v[p] = -INFINITY; myk[p] = k; myv[p] = m[p]; } } }
#pragma unroll
        for (int p = 0; p < 4; ++p) { const float myex = myk[p] >= 0 ? __builtin_amdgcn_exp2f((myv[p] - m0[p]) * 1.4426950409f) : 0.f; const float den = sum32(myex);
            if (myk[p] >= 0) { const int tl = wave * 8 + 2 * p + (lane >> 5); const int r = __hip_atomic_fetch_add(hist + e, 1, __ATOMIC_RELAXED, __HIP_MEMORY_SCOPE_WORKGROUP); asg_e[tl * 4 + myk[p]] = e | (r << 8); asg_g[tl * 4 + myk[p]] = myex * __builtin_amdgcn_rcpf(den); } }
    }
    __syncthreads();
    TP_END(65); TP_BEGIN(66);
    if (DRY == 1) return;
    if (tid < 32) offl[tid] = (int)__hip_atomic_fetch_add(cursor + tid, (unsigned)hist[tid], __ATOMIC_RELAXED, __HIP_MEMORY_SCOPE_AGENT);
    __syncthreads();
    if (tid < 256) { const int ev = asg_e[tid], e = ev & 255, r = ev >> 8; const int idx = e * pg8::ELIST + offl[e] + r; toke[idx] = tok0 + (tid >> 2); gatee[idx] = asg_g[tid]; pos[tok0 * 4 + tid] = idx; }
    __syncthreads();
    TP_END(66); TP_END(60);
}
__device__ __forceinline__ void moe_tables(const Args& a, LAS unsigned char* lds, int tid) {
    LAS int* tp = (LAS int*)(lds + TBL_OFF); LAS int* eb = tp + 36; LAS int* tot = tp + 72; unsigned* cursor = (unsigned*)(a.ws + WS_CTL) + CW_CUR;
    if (tid < 32) tot[tid] = (int)__hip_atomic_load(cursor + tid, __ATOMIC_RELAXED, __HIP_MEMORY_SCOPE_AGENT);
    __syncthreads();
    if (tid <= NE) { int s = 0, r = 0;
#pragma unroll
        for (int e = 0; e < NE; ++e) { const int c_ = tot[e]; if (e < tid) { s += (c_ + 255) >> 8; r += c_; } }
        tp[tid] = s; eb[tid] = r; }
    __syncthreads();
}
__device__ __forceinline__ void final_rows(const Args& a, LAS unsigned char* lds, int lane, int wave, int vcu, int G, bool do_store) {
    const unsigned char* Y = a.ws + WS_Y; const int* pos = (const int*)(a.ws + WS_POS); const float* mod = (const float*)(a.ws + WS_MOD); const bf16* HB = (const bf16*)(a.ws + WS_PROJ);
    const LAS int* ebl = (const LAS int*)(lds + TBL_OFF) + 36;
    const int stride = G * NWAVES; constexpr int NQ = 4;
    int4 pn[NQ];
    { const int t0 = vcu * NWAVES + wave;
#pragma unroll
      for (int q = 0; q < NQ; ++q) pn[q] = *(const int4*)(pos + min(t0 + q * stride, NTOK - 1) * 4); }
    for (int tok0 = vcu * NWAVES + wave; tok0 < NTOK; tok0 += NQ * stride) {
        f32x4 v[NQ][4]; float s[NQ]; int4 pc[NQ];
#pragma unroll
        for (int q = 0; q < NQ; ++q) { pc[q] = pn[q]; pn[q] = *(const int4*)(pos + min(tok0 + (NQ + q) * stride, NTOK - 1) * 4); }
#pragma unroll
        for (int q = 0; q < NQ; ++q) { const int tok = min(tok0 + q * stride, NTOK - 1); const int b = tok / SEQ;
            int4 p = pc[q]; p.x = ebl[p.x >> 14] + (p.x & (pg8::ELIST - 1)); p.y = ebl[p.y >> 14] + (p.y & (pg8::ELIST - 1)); p.z = ebl[p.z >> 14] + (p.z & (pg8::ELIST - 1)); p.w = ebl[p.w >> 14] + (p.w & (pg8::ELIST - 1));
            const bf16* dr = HB + (size_t)tok * D;
#pragma unroll
            for (int j = 0; j < 4; ++j) { const int off = 4 * lane + 256 * j;
                const unsigned y0 = __builtin_nontemporal_load((const unsigned*)(Y + (size_t)p.x * D + off)), y1 = __builtin_nontemporal_load((const unsigned*)(Y + (size_t)p.y * D + off)), y2 = __builtin_nontemporal_load((const unsigned*)(Y + (size_t)p.z * D + off)), y3 = __builtin_nontemporal_load((const unsigned*)(Y + (size_t)p.w * D + off));
                typedef float f32x2_t __attribute__((ext_vector_type(2)));
                const f32x2_t a0 = __builtin_amdgcn_cvt_pk_f32_fp8(y0, false), a1 = __builtin_amdgcn_cvt_pk_f32_fp8(y0, true), b0 = __builtin_amdgcn_cvt_pk_f32_fp8(y1, false), b1 = __builtin_amdgcn_cvt_pk_f32_fp8(y1, true);
                const f32x2_t c0 = __builtin_amdgcn_cvt_pk_f32_fp8(y2, false), c1 = __builtin_amdgcn_cvt_pk_f32_fp8(y2, true), d0 = __builtin_amdgcn_cvt_pk_f32_fp8(y3, false), d1 = __builtin_amdgcn_cvt_pk_f32_fp8(y3, true);
                f32x4 m; m.x = ((a0.x + b0.x) + (c0.x + d0.x)) * (1.f / pg8::Y8_SCALE); m.y = ((a0.y + b0.y) + (c0.y + d0.y)) * (1.f / pg8::Y8_SCALE);
                m.z = ((a1.x + b1.x) + (c1.x + d1.x)) * (1.f / pg8::Y8_SCALE); m.w = ((a1.y + b1.y) + (c1.y + d1.y)) * (1.f / pg8::Y8_SCALE);
                const f32x4 g2 = *(const f32x4*)(mod + b * 6144 + 5120 + off); const v2u d = __builtin_nontemporal_load((const v2u*)(dr + off)); f32x4 hv; hv.x = bflo(d.x); hv.y = bfhi(d.x); hv.z = bflo(d.y); hv.w = bfhi(d.y); v[q][j] = hv + g2 * m; } }
#pragma unroll
        for (int q = 0; q < NQ; ++q) { s[q] = 0.f;
#pragma unroll
            for (int j = 0; j < 4; ++j) s[q] += (v[q][j].x * v[q][j].x + v[q][j].y * v[q][j].y) + (v[q][j].z * v[q][j].z + v[q][j].w * v[q][j].w); }
#pragma unroll
        for (int q = 0; q < NQ; ++q) s[q] = wave_sum(s[q]);
#pragma unroll
        for (int q = 0; q < NQ; ++q) if (do_store && tok0 + q * stride < NTOK) { const float rs = rsqrtf(s[q] * (1.f / D) + EPS); float* hr = a.out + (size_t)(tok0 + q * stride) * D;
#pragma unroll
            for (int j = 0; j < 4; ++j) { const int off = 4 * lane + 256 * j; const f32x4 fg = *(const f32x4*)(a.in[I_FG] + off); *(f32x4*)(hr + off) = v[q][j] * rs * fg; } }
    }
}

__global__ void __launch_bounds__(NWAVES * 64, 2) mega(Args args) {
    extern __shared__ __attribute__((aligned(16))) unsigned char lds_raw[];
    LAS unsigned char* lds = (LAS unsigned char*)lds_raw;
    volatile LAS unsigned* MISC = (volatile LAS unsigned*)(lds + MISC_OFF);
    const int tid = threadIdx.x, lane = tid & 63, wave = __builtin_amdgcn_readfirstlane(tid >> 6);
    const int G = gridDim.x; const int bx = blockIdx.x; const int vcu = (G % 8 == 0) ? (bx % 8) * (G / 8) + bx / 8 : bx;
    for (int u = tid; u < (LDS_BYTES - MISC_OFF) / 4; u += NWAVES * 64) ((LAS unsigned*)(lds + MISC_OFF))[u] = 0u;
    __syncthreads();
    const int lo = args.ph_lo, hi = args.ph_hi;
    XcdBarrier bar; bar.bar = (unsigned*)(args.ws + WS_CTL) + CW_BAR + args.li * XCD_BAR_WORDS; bar.x = 0; bar.st = nullptr;
    if (hi - lo > 1) bar = xcd_barrier_post((unsigned*)(args.ws + WS_CTL) + CW_BAR + args.li * XCD_BAR_WORDS, MISC + 8);
#ifndef PHMASK
#define PHMASK 0x7FF
#endif
#ifndef PHREP
#define PHREP 0
#endif
#define IN(k) (((PHMASK >> (k)) & 1) && lo <= (k) && (k) < hi)
#define NREP(k) (((PHREP >> (k)) & 1) ? 2 : 1)
#ifndef BARREP
#define BARREP 1
#endif
#define SEAM(k) do { if (IN(k) && IN((k) + 1)) { for (int _b = 0; _b < BARREP; ++_b) xcd_barrier(bar.bar, bar.x, bar.st); } } while (0)
    unsigned char* ws = args.ws;
#ifndef P3DUP
#define P3DUP 0
#endif
#ifndef P3DUP
#define P3DUP 0
#endif
#ifndef DRYMODE
#define DRYMODE 1
#endif
#ifndef PHDUP
#define PHDUP -1
#endif
#define DUPBAR() xcd_barrier(bar.bar, bar.x, bar.st)
#define PH2(SH) do { pg8::DenseOrder S; S.init(ws + WS_Z, ws + WS_WINT, NTOK, NPROJ, D * 2, G, ((SH) ? ((bx + 4) & 255) : bx)); pg8::EpiInProj E{(bf16*)(ws + WS_PROJ)}; \
        pg8::gemm_phase<pg8::EpiInProj, pg8::DenseOrder, true>(lds + RING_OFF, D * 2, S, E); } while (0)
#define PH3(SH) do { { TP_BEGIN(31); for (int u = vcu; u < 256; u += G) lru_unit<false>(args, lds, tid, lane, wave, ((SH) ? ((u + 128) & 255) : u)); TP_END(31); } { TP_BEGIN(32); for (int u = vcu; u < 256; u += G) sgu_unit(args, lds, tid, lane, wave, ((SH) ? ((u + 128) & 255) : u)); TP_END(32); } } while (0)
#define PH4(SH) do { for (int u = vcu; u < 256; u += G) lru_passb_unit(args, lds, tid, lane, wave, ((SH) ? ((u + 128) & 255) : u)); } while (0)
#define PH5(SH) do { pg8::DenseOrder S; S.init(ws + WS_HEADS, ws + WS_WOUTT, NTOK, D, D * 2, G, ((SH) ? ((bx + 4) & 255) : bx)); pg8::EpiOutProj E{(const float*)(ws + WS_MOD), (const bf16*)(ws + WS_XB), (bf16*)(ws + WS_PROJ)}; \
        pg8::gemm_phase<pg8::EpiOutProj, pg8::DenseOrder, true>(lds + RING_OFF, D * 2, S, E); } while (0)
#define PH8(SH) do { moe_tables(args, lds, tid); pg8::MoeOrder S; S.init(ws + WS_Z, ws + WS_WGUT, (const LAS int*)(lds + TBL_OFF), (const LAS int*)(lds + TBL_OFF) + 36, 2048, D, G, ((SH) ? ((bx + 4) & 255) : bx)); \
        pg8::EpiSwiglu E{args.in[I_BGU], ws + WS_ACT, lds + EPI_OFF}; const pg8::GatherA ga{(const char*)(ws + WS_Z), (const int*)(ws + WS_TOKE), (LAS unsigned*)(lds + RT_OFF)}; \
        pg8::gemm_phase<pg8::EpiSwiglu, pg8::MoeOrder, true, true, true>(lds + RING_OFF, D, S, E, ga); } while (0)
#define PH9(SH) do { moe_tables(args, lds, tid); pg8::MoeOrder S; S.init(ws + WS_ACT, ws + WS_WDNT, (const LAS int*)(lds + TBL_OFF), (const LAS int*)(lds + TBL_OFF) + 36, D, D, G, ((SH) ? ((bx + 4) & 255) : bx)); \
        pg8::EpiDown E{args.in[I_BDN], (const float*)(ws + WS_GATEE), ws + WS_Y, lds + EPI_OFF}; pg8::gemm_phase<pg8::EpiDown, pg8::MoeOrder, true, true>(lds + RING_OFF, D, S, E); } while (0)
    if (IN(0)) { p0_prologue(args, lds, tid, lane, wave, vcu, G);
#if PHDUP == 0
        DUPBAR(); p0_prologue(args, lds, tid, lane, wave, vcu, G);
#endif
        SEAM(0); }
    if (IN(1)) { TP_BEGIN(10); p1_modz(args, lds, tid, lane, wave, vcu, G); TP_END(10);
#if PHDUP == 1
        DUPBAR(); p1_modz(args, lds, tid, lane, wave, vcu, G);
#endif
        SEAM(1); }
    if (IN(2)) {
#if PHDUP == 2
        PH2(1); DUPBAR();
#endif
        { TP_BEGIN(20); PH2(0); TP_END(20); } SEAM(2); }
    if (IN(3)) {
#if PHDUP == 3
        PH3(1); DUPBAR();
#endif
#if P3DUP == 1
        for (int u = vcu; u < 256; u += G) lru_unit<false>(args, lds, tid, lane, wave, (u + 128) & 255); DUPBAR();
#elif P3DUP == 2
        for (int u = vcu; u < 256; u += G) sgu_unit(args, lds, tid, lane, wave, (u + 128) & 255); DUPBAR();
#endif
#if P3DUP == 1
        for (int u = vcu; u < 256; u += G) lru_unit<false>(args, lds, tid, lane, wave, (u + 128) & 255); DUPBAR();
#elif P3DUP == 2
        for (int u = vcu; u < 256; u += G) sgu_unit(args, lds, tid, lane, wave, (u + 128) & 255); DUPBAR();
#endif
        PH3(0);
        if (G != 256) router_tables(args, tid, lane, wave, vcu, G); else if (!(vcu & 1)) router_tables(args, tid, lane, wave, vcu >> 1, 128);
        SEAM(3); }
    if (IN(4)) {
#if PHDUP == 4
        PH4(1); DUPBAR();
#endif
        { TP_BEGIN(40); PH4(0); TP_END(40); } SEAM(4); }
    if (IN(5)) {
#if PHDUP == 5
        PH5(1); DUPBAR();
#endif
        { TP_BEGIN(50); PH5(0); TP_END(50); } SEAM(5); }
    if (IN(6)) {
#if PHDUP == 6
        for (int u = vcu; u < 256; u += G) router_unit<DRYMODE>(args, lds, tid, lane, wave, (u + 128) & 255); DUPBAR();
#endif
        for (int u = vcu; u < 256; u += G) router_unit<0>(args, lds, tid, lane, wave, u); SEAM(6); }
    if (IN(8)) {
#if PHDUP == 8
        PH8(1); DUPBAR();
#endif
        PH8(0); SEAM(8); }
    if (IN(9)) {
#if PHDUP == 9
        PH9(1); DUPBAR();
#endif
        PH9(0); SEAM(9); }
    if (IN(10)) { TP_BEGIN(100); moe_tables(args, lds, tid); final_rows(args, lds, lane, wave, vcu, G, true); TP_END(100); }
#undef IN
#undef SEAM
}

extern "C" void kernel_launch(void* const* d_in, const int* in_sizes, int n_in, void* d_out, int out_size, void* d_ws, size_t ws_size, hipStream_t stream) {
    static int grid = 0;
    if (grid == 0) {
        if (n_in != 28 || out_size != NTOK * D || ws_size < WS_END) { fprintf(stderr, "kernel_launch: unexpected shapes (n_in %d out %d ws %zu)\n", n_in, out_size, ws_size); grid = -1; return; }
        int dev = 0, cus = 0, per_cu = 0;
        if (hipGetDevice(&dev) != hipSuccess || hipDeviceGetAttribute(&cus, hipDeviceAttributeMultiprocessorCount, dev) != hipSuccess) { grid = -1; return; }
        if (hipFuncSetAttribute((const void*)mega, hipFuncAttributeMaxDynamicSharedMemorySize, LDS_BYTES) != hipSuccess) { fprintf(stderr, "kernel_launch: hipFuncSetAttribute failed\n"); grid = -1; return; }
        if (hipOccupancyMaxActiveBlocksPerMultiprocessor(&per_cu, (const void*)mega, NWAVES * 64, LDS_BYTES) != hipSuccess || per_cu < 1) { fprintf(stderr, "kernel_launch: occupancy query says %d blocks per CU\n", per_cu); (void)hipGetLastError(); grid = -1; return; }
        grid = cus < 256 ? cus : 256;
        if (grid % 8 != 0) { fprintf(stderr, "kernel_launch: %d CUs; the phase programs need a grid that is a multiple of 8\n", cus); grid = -1; return; }
    }
    if (grid < 0) return;
    (void)hipMemsetAsync((unsigned char*)d_ws + WS_CTL, 0, CTL_ZERO_BYTES, stream);
    Args a{};
    for (int i = 0; i < 28; ++i) a.in[i] = (const float*)d_in[i];
    a.out = (float*)d_out; a.ws = (unsigned char*)d_ws; a.ph_lo = 0; a.ph_hi = NPH; a.li = 0;
    hipLaunchKernelGGL(mega, dim3(grid), dim3(NWAVES * 64), LDS_BYTES, stream, a);
}
```

```cpp
#include <hip/hip_runtime.h>
#include <cstdio>
#include <cstdint>

typedef unsigned short bf16;
constexpr int D = 1024, BATCH = 4, SEQ = 4096, NTOK = BATCH * SEQ, NPROJ = 2048, DL = 512, NH = 8, HD = 64, CHUNK = 128, NE = 32, TOPK = 4;
constexpr int NASSIGN = NTOK * TOPK;
constexpr float EPS = 1e-6f;

__device__ __forceinline__ unsigned f2bf(float f) { unsigned u = __builtin_bit_cast(unsigned, f); return (u + 0x7fffu + ((u >> 16) & 1u)) >> 16; }
__device__ __forceinline__ float bf2f(bf16 h) { return __builtin_bit_cast(float, (unsigned)h << 16); }
__device__ __forceinline__ float gelu_tanh(float x) { const float u = 1.5957691216057308f * (x + 0.044715f * x * x * x); return x / (1.f + __expf(-u)); }
__device__ __forceinline__ float sigmoidf_(float x) { return 1.f / (1.f + __expf(-x)); }

constexpr size_t MiB = 1u << 20;
constexpr size_t WS_CTL = 0;
constexpr size_t CTL_ZERO_BYTES = 20480;
constexpr size_t WS_MODP = 1 * MiB;
constexpr size_t WS_MOD = 3 * MiB;
constexpr size_t WS_AGG = 4 * MiB;
constexpr size_t WS_CNT = 5 * MiB;
constexpr size_t WS_TOPE = 6 * MiB;
constexpr size_t WS_GATE = 7 * MiB;
constexpr size_t WS_RANK = 8 * MiB;
constexpr size_t WS_POS = 9 * MiB;
constexpr size_t WS_GSORT = 10 * MiB;
constexpr size_t WS_TOKL = 11 * MiB;
constexpr size_t WS_STATS = 12 * MiB;
constexpr size_t WS_WRT = 13 * MiB;
constexpr size_t WS_WM = 14 * MiB;
constexpr size_t WS_Z = 16 * MiB;
constexpr size_t WS_HEADS = 48 * MiB;
constexpr size_t WS_PROJ = 80 * MiB;
constexpr size_t WS_ACT = 144 * MiB;
constexpr size_t WS_Y = 280 * MiB;
constexpr size_t WS_WINT = 416 * MiB;
constexpr size_t WS_WOUTT = 420 * MiB;
constexpr size_t WS_WGUT = 424 * MiB;
constexpr size_t WS_WDNT = 552 * MiB;
constexpr size_t WS_TOKE = 616 * MiB;
constexpr size_t WS_GATEE = 620 * MiB;
constexpr size_t WS_O32 = 752 * MiB;
constexpr size_t WS_XB = 784 * MiB;
constexpr size_t WS_END = 816 * MiB;
constexpr int CW_CNT = 0, CW_CUR = 64, CW_EBASE = 128;
constexpr int CW_BAR = 1024;

namespace pg8 {
#define PG8_LAS __attribute__((address_space(3)))
typedef unsigned short bf16_t;
typedef short bf16x8 __attribute__((ext_vector_type(8)));
typedef float f32x4 __attribute__((ext_vector_type(4)));
typedef unsigned u32x4 __attribute__((ext_vector_type(4)));
constexpr int BM = 256, BK = 64, HALF = 128, HTB = HALF * BK * 2, STAGE_BYTES = 8 * HTB, NXCD = 8, WGM = 8;
constexpr int ELIST = 16384;

__host__ __device__ __forceinline__ int lds_byte(int r, int c) { const int st = (r >> 4) * 2 + (c >> 5), rr = r & 15, cc = c & 31, ob = rr * 64 + cc * 2; return st * 1024 + (ob ^ (((ob >> 9) & 1) << 5)); }
__host__ __device__ __forceinline__ void stage_rc(int b, int& R, int& C) { const int st = b / 1024, sb = b % 1024, swz = sb ^ (((sb >> 9) & 1) << 5); R = (st >> 1) * 16 + swz / 64; C = (st & 1) * 32 + (swz % 64) / 2; }
__host__ __device__ __forceinline__ int perm32(int rho) { const int n = rho >> 4, i = rho & 15; return 8 * (i >> 2) + 4 * n + (i & 3); }

struct Unit { const char* A; const char* B; int row0, col0, nr, e, lrow0; };

struct DenseOrder {
    const char* A; const char* B; int nM, nN, nwg, G, c, pitch;
    __device__ __forceinline__ void init(const void* A_, const void* B_, int M, int N, int pitch_, int G_, int c_) { A = (const char*)A_; B = (const char*)B_; nM = M / BM; nN = N / BM; nwg = nM * nN; G = G_; c = c_; pitch = pitch_; }
    __device__ __forceinline__ bool next(int i, Unit& u) const {
        const long L = (long)i * G + c; if (L >= nwg) return false;
        int wgid = (int)L; { const int q = nwg / NXCD, r = nwg % NXCD, xcd = wgid % NXCD, off = wgid / NXCD; wgid = (xcd < r ? xcd * (q + 1) : r * (q + 1) + (xcd - r) * q) + off; }
        const int nig = WGM * nN, gid = wgid / nig, fm = gid * WGM, gsz = (nM - fm) < WGM ? (nM - fm) : WGM;
        const int pm = fm + ((wgid % nig) % gsz), pn = (wgid % nig) / gsz;
        u.A = A + (size_t)pm * BM * pitch; u.B = B + (size_t)pn * BM * pitch; u.row0 = pm * BM; u.col0 = pn * BM; u.nr = BM; u.e = 0; u.lrow0 = 0; return true;
    }
};
struct MoeOrder {
    const char* A; const char* B; const PG8_LAS int* tpre; const PG8_LAS int* ebase; int NPN, nU, G, c, pitch, N;
    __device__ __forceinline__ void init(const void* A_, const void* B_, const PG8_LAS int* tpre_, const PG8_LAS int* ebase_, int N_, int pitch_, int G_, int c_) {
        A = (const char*)A_; B = (const char*)B_; tpre = tpre_; ebase = ebase_; N = N_; NPN = N_ / BM; pitch = pitch_; G = G_; c = c_; nU = __builtin_amdgcn_readfirstlane(tpre_[32]) * NPN; }
    __device__ __forceinline__ bool next(int i, Unit& u) const {
        const long L = (long)i * G + c; if (L >= nU) return false;
        int wgid = (int)L; { const int q = nU / NXCD, r = nU % NXCD, xcd = wgid % NXCD, off = wgid / NXCD; wgid = (xcd < r ? xcd * (q + 1) : r * (q + 1) + (xcd - r) * q) + off; }
        const int ln = threadIdx.x & 31; const unsigned long long bal = __ballot(tpre[ln + 1] * NPN <= wgid);
        int e = __builtin_popcount((unsigned)bal); e = e > 31 ? 31 : e;
        const int tp0 = __builtin_amdgcn_readfirstlane(tpre[e]), tp1 = __builtin_amdgcn_readfirstlane(tpre[e + 1]);
        const int q2 = wgid - tp0 * NPN, nt = tp1 - tp0, pn = q2 / nt, mt = q2 - pn * nt;
        const int eb = __builtin_amdgcn_readfirstlane(ebase[e]), cnt = __builtin_amdgcn_readfirstlane(ebase[e + 1]) - eb;
        u.row0 = eb + BM * mt; u.nr = min(BM, cnt - BM * mt); u.col0 = pn * BM; u.e = e; u.lrow0 = e * ELIST + BM * mt;
        u.A = A + (size_t)u.row0 * pitch; u.B = B + ((size_t)e * N + (size_t)pn * BM) * pitch; return true;
    }
};

__device__ __forceinline__ unsigned cvt_pk_bf16(float lo, float hi) { unsigned r; asm volatile("v_cvt_pk_bf16_f32 %0, %1, %2" : "=v"(r) : "v"(lo), "v"(hi)); return r; }
__device__ __forceinline__ float gelu_fast(float x) { const float u = x * (1.5957691216f + 0.0713548163f * x * x); return x * __builtin_amdgcn_rcpf(1.f + __builtin_amdgcn_exp2f(-1.4426950409f * u)); }
__device__ __forceinline__ f32x4 gelu4(const f32x4 x) {
    const f32x4 t = x * (x * x * (-0.0713548163f * 1.4426950409f) + (-1.5957691216f * 1.4426950409f)); f32x4 d;
#pragma unroll
    for (int q = 0; q < 4; ++q) d[q] = __builtin_amdgcn_rcpf(1.f + __builtin_amdgcn_exp2f(t[q]));
    return x * d;
}
__device__ __forceinline__ float sigm_fast(float x) { return __builtin_amdgcn_rcpf(1.f + __builtin_amdgcn_exp2f(-1.4426950409f * x)); }

struct EpiInProj {
    static constexpr bool PERM = true; bf16_t* O;
    __device__ __forceinline__ void prefetch(const Unit&, int, int) const {}
    __device__ __forceinline__ void operator()(const f32x4 (&acc)[2][2][4][2], const Unit& u, int wr, int wc, int fr, int fq) const {
        const int row0 = u.row0 + wr * 64 + fr, col0 = u.col0 + wc * 32 + 8 * fq; const bool act = u.col0 >= 512;
#pragma unroll
        for (int ai = 0; ai < 2; ++ai)
#pragma unroll
            for (int m = 0; m < 4; ++m) { bf16_t* rowp = O + (size_t)(row0 + ai * HALF + m * 16) * NPROJ + col0;
#pragma unroll
                for (int bj = 0; bj < 2; ++bj) { f32x4 v0 = acc[ai][bj][m][0], v1 = acc[ai][bj][m][1];
                    if (act) { v0 = gelu4(v0); v1 = gelu4(v1); }
                    u32x4 w; w.x = cvt_pk_bf16(v0[0], v0[1]); w.y = cvt_pk_bf16(v0[2], v0[3]); w.z = cvt_pk_bf16(v1[0], v1[1]); w.w = cvt_pk_bf16(v1[2], v1[3]);
                    *(u32x4*)(rowp + bj * HALF) = w; } }
    }
};
struct EpiOutProj {
    static constexpr bool PERM = true; const float* mod; const bf16_t* XB; bf16_t* O;
    __device__ __forceinline__ void prefetch(const Unit&, int, int) const {}
    __device__ __forceinline__ void operator()(const f32x4 (&acc)[2][2][4][2], const Unit& u, int wr, int wc, int fr, int fq) const {
        const int row0 = u.row0 + wr * 64 + fr, col0 = u.col0 + wc * 32 + 8 * fq; const int b = u.row0 / SEQ;
        f32x4 g[2][2];
#pragma unroll
        for (int bj = 0; bj < 2; ++bj)
#pragma unroll
            for (int n = 0; n < 2; ++n) g[bj][n] = *(const f32x4*)(mod + b * 6144 + 2048 + col0 + bj * HALF + 4 * n);
#pragma unroll
        for (int ai = 0; ai < 2; ++ai) {
            u32x4 xr[4][2];
#pragma unroll
            for (int m = 0; m < 4; ++m)
#pragma unroll
                for (int bj = 0; bj < 2; ++bj) xr[m][bj] = __builtin_nontemporal_load((const u32x4*)(XB + (size_t)(row0 + ai * HALF + m * 16) * D + col0 + bj * HALF));
#pragma unroll
            for (int m = 0; m < 4; ++m) { bf16_t* rowp = O + (size_t)(row0 + ai * HALF + m * 16) * D + col0;
#pragma unroll
                for (int bj = 0; bj < 2; ++bj) { const u32x4 xw = xr[m][bj]; f32x4 v0 = acc[ai][bj][m][0] * g[bj][0], v1 = acc[ai][bj][m][1] * g[bj][1];
                    v0[0] += __builtin_bit_cast(float, xw.x << 16); v0[1] += __builtin_bit_cast(float, xw.x & 0xffff0000u); v0[2] += __builtin_bit_cast(float, xw.y << 16); v0[3] += __builtin_bit_cast(float, xw.y & 0xffff0000u);
                    v1[0] += __builtin_bit_cast(float, xw.z << 16); v1[1] += __builtin_bit_cast(float, xw.z & 0xffff0000u); v1[2] += __builtin_bit_cast(float, xw.w << 16); v1[3] += __builtin_bit_cast(float, xw.w & 0xffff0000u);
                    u32x4 w; w.x = cvt_pk_bf16(v0[0], v0[1]); w.y = cvt_pk_bf16(v0[2], v0[3]); w.z = cvt_pk_bf16(v1[0], v1[1]); w.w = cvt_pk_bf16(v1[2], v1[3]);
                    *(u32x4*)(rowp + bj * HALF) = w; } }
            asm volatile("" ::: "memory"); }
    }
};
__device__ __forceinline__ unsigned pk4_fp8(float a, float b, float c, float d) { int w = 0; w = __builtin_amdgcn_cvt_pk_fp8_f32(a, b, w, false); w = __builtin_amdgcn_cvt_pk_fp8_f32(c, d, w, true); return (unsigned)w; }
constexpr float W8_SCALE = 64.f, A8_SCALE = 4.f;
typedef unsigned u32x2 __attribute__((ext_vector_type(2)));
__device__ __forceinline__ u32x4 pair16(const u32x2 wA, const u32x2 wB, const bool) {
    const auto r0 = __builtin_amdgcn_permlane16_swap(wA.x, wB.x, false, false), r1 = __builtin_amdgcn_permlane16_swap(wA.y, wB.y, false, false);
    return (u32x4){(unsigned)r0[0], (unsigned)r1[0], (unsigned)r0[1], (unsigned)r1[1]};
}
struct EpiSwiglu {
    static constexpr bool PERM = true; const float* bgu; unsigned char* ACT; PG8_LAS unsigned char* epl;
    __device__ __forceinline__ void prefetch(const Unit& u, int wid, int lane) const {
        if (wid == 0) { const float* src = bgu + u.e * 2048 + (lane >= 32 ? 1024 : 0) + (u.col0 >> 1) + 4 * (lane & 31);
            __builtin_amdgcn_global_load_lds((const unsigned*)src, (PG8_LAS unsigned*)epl, 16, 0, 0); }
    }
    __device__ __forceinline__ void operator()(const f32x4 (&acc)[2][2][4][2], const Unit& u, int wr, int wc, int fr, int fq) const {
        asm volatile("" : "+v"(fr), "+v"(fq));
        const int jl = wc * 32 + 8 * fq, j0 = (u.col0 >> 1) + jl; const bool odd = (fq & 1) != 0;
        f32x4 bg[2], bl[2];
#pragma unroll
        for (int n = 0; n < 2; ++n) { bg[n] = *(const PG8_LAS f32x4*)(epl + (jl + 4 * n) * 4); bl[n] = *(const PG8_LAS f32x4*)(epl + 512 + (jl + 4 * n) * 4); }
#pragma unroll
        for (int ai = 0; ai < 2; ++ai)
#pragma unroll
            for (int mp = 0; mp < 2; ++mp) { u32x2 w2[2];
#pragma unroll
                for (int h = 0; h < 2; ++h) { const int m = 2 * mp + h; f32x4 o[2];
#pragma unroll
                    for (int n = 0; n < 2; ++n) { const f32x4 g = __builtin_elementwise_min(acc[ai][0][m][n] * (1.f / W8_SCALE) + bg[n], (f32x4){7.f, 7.f, 7.f, 7.f});
                        const f32x4 l = __builtin_elementwise_min(__builtin_elementwise_max(acc[ai][1][m][n] * (1.f / W8_SCALE) + bl[n], (f32x4){-7.f, -7.f, -7.f, -7.f}), (f32x4){7.f, 7.f, 7.f, 7.f});
                        const f32x4 ex = g * (-1.702f * 1.4426950409f); f32x4 den;
#pragma unroll
                        for (int q = 0; q < 4; ++q) den[q] = __builtin_amdgcn_rcpf(1.f + __builtin_amdgcn_exp2f(ex[q]));
                        o[n] = (g * A8_SCALE) * den * (l + 1.f); }
                    w2[h].x = pk4_fp8(o[0][0], o[0][1], o[0][2], o[0][3]); w2[h].y = pk4_fp8(o[1][0], o[1][1], o[1][2], o[1][3]); }
                const u32x4 o16 = pair16(w2[0], w2[1], odd);
                const int r = ai * HALF + wr * 64 + (2 * mp + (odd ? 1 : 0)) * 16 + fr;
                if (r < u.nr) *(u32x4*)(ACT + (size_t)(u.row0 + r) * D + j0 - (odd ? 8 : 0)) = o16; }
    }
};
constexpr float Y8_SCALE = 8.f;
struct EpiDown {
    static constexpr bool PERM = true; const float* bd; const float* gs; unsigned char* Y; PG8_LAS unsigned char* epl;
    __device__ __forceinline__ void prefetch(const Unit& u, int wid, int lane) const {
        if (wid == 0) __builtin_amdgcn_global_load_lds((const unsigned*)(bd + u.e * D + u.col0 + 4 * lane), (PG8_LAS unsigned*)epl, 16, 0, 0);
        if (wid == 1) __builtin_amdgcn_global_load_lds((const unsigned*)(gs + u.lrow0 + 4 * lane), (PG8_LAS unsigned*)(epl + 1024), 16, 0, 0);
    }
    __device__ __forceinline__ void operator()(const f32x4 (&acc)[2][2][4][2], const Unit& u, int wr, int wc, int fr, int fq) const {
        asm volatile("" : "+v"(fr), "+v"(fq));
        const int cl = wc * 32 + 8 * fq, col0 = u.col0 + cl; const bool odd = (fq & 1) != 0;
        f32x4 bv[2][2];
#pragma unroll
        for (int bj = 0; bj < 2; ++bj)
#pragma unroll
            for (int n = 0; n < 2; ++n) bv[bj][n] = *(const PG8_LAS f32x4*)(epl + (cl + bj * HALF + 4 * n) * 4);
#pragma unroll
        for (int ai = 0; ai < 2; ++ai)
#pragma unroll
            for (int mp = 0; mp < 2; ++mp) { const int rb = ai * HALF + wr * 64 + 2 * mp * 16 + fr;
                const float gA = *(const PG8_LAS float*)(epl + 1024 + rb * 4) * Y8_SCALE, gB = *(const PG8_LAS float*)(epl + 1024 + (rb + 16) * 4) * Y8_SCALE;
                const int r = rb + (odd ? 16 : 0); unsigned char* rowp = Y + (size_t)(u.row0 + r) * D + col0 - (odd ? 8 : 0);
#pragma unroll
                for (int bj = 0; bj < 2; ++bj) { u32x2 w2[2];
#pragma unroll
                    for (int h = 0; h < 2; ++h) { const int m = 2 * mp + h; const float gt = h ? gB : gA;
                        const f32x4 v0 = (acc[ai][bj][m][0] * (1.f / (W8_SCALE * A8_SCALE)) + bv[bj][0]) * gt, v1 = (acc[ai][bj][m][1] * (1.f / (W8_SCALE * A8_SCALE)) + bv[bj][1]) * gt;
                        w2[h].x = pk4_fp8(v0[0], v0[1], v0[2], v0[3]); w2[h].y = pk4_fp8(v1[0], v1[1], v1[2], v1[3]); }
                    const u32x4 o16 = pair16(w2[0], w2[1], odd);
                    if (r < u.nr) *(u32x4*)(rowp + bj * HALF) = o16; } }
    }
};

typedef int v4i_t __attribute__((ext_vector_type(4)));
typedef int v8i_t __attribute__((ext_vector_type(8)));
struct GatherA { const char* base; const int* tokl; PG8_LAS unsigned* rt; };
template <class Epi, class Sched, bool ALIGN_EPI, bool FP8 = false, bool GATHER = false>
__device__ __forceinline__ void gemm_phase(PG8_LAS unsigned char* lds, const int pitch, const Sched& S, const Epi& E, const GatherA ga = GatherA{nullptr, nullptr, nullptr}) {
    const int tid = threadIdx.x, wid = __builtin_amdgcn_readfirstlane(tid >> 6), lane = tid & 63, wr = wid >> 2, wc = wid & 3, fr = lane & 15, fq = lane >> 4;
    const int nt = pitch / (BK * 2);
    unsigned voffA[2], voffB[2];
#pragma unroll
    for (int i = 0; i < 2; ++i) { int R, C; stage_rc(tid * 16 + i * 8192, R, C); const int Rb = Epi::PERM ? ((R & ~31) + perm32(R & 31)) : R;
        voffA[i] = GATHER ? (unsigned)(R * 65536 + C * 2) : (unsigned)(R * pitch + C * 2); voffB[i] = (unsigned)(Rb * pitch + C * 2); }
    const size_t kstep = (size_t)(BK * 2);
    const size_t hstep = (size_t)HALF * pitch;
    const unsigned ldsw = (unsigned)wid * 1024u;
    const int aoff = lds_byte(wr * 64 + fr, fq * 8), boff = lds_byte(wc * 32 + fr, fq * 8);
#define PG8_SA(b, h) (((b) * 2 + (h)) * HTB)
#define PG8_SB(b, h) ((4 + (b) * 2 + (h)) * HTB)
#define PG8_STAGE(bufoff, gbase, voff) do { _Pragma("unroll") for (int _i = 0; _i < 2; ++_i) \
        __builtin_amdgcn_global_load_lds((const unsigned*)((const char*)(gbase) + (voff)[_i]), (PG8_LAS unsigned*)(lds + (bufoff) + ldsw + _i * 8192), 16, 0, 0); } while (0)
#define PG8_STAGE_A(bufoff, gbase, par, half, kt) do { if constexpr (GATHER) { _Pragma("unroll") for (int _i = 0; _i < 2; ++_i) { const unsigned _tk = min(ga.rt[(par) * 256 + (half) * 128 + (voffA[_i] >> 16)], (unsigned)(NTOK - 1)); \
            __builtin_amdgcn_global_load_lds((const unsigned*)(ga.base + (size_t)_tk * pitch + (voffA[_i] & 0xffffu) + (kt) * (BK * 2)), (PG8_LAS unsigned*)(lds + (bufoff) + ldsw + _i * 8192), 16, 0, 0); } } \
        else PG8_STAGE(bufoff, gbase, voffA); } while (0)
#define PG8_GA_LOAD(par, row0_) do { if constexpr (GATHER) { if (wid == 2) __builtin_amdgcn_global_load_lds((const unsigned*)(ga.tokl + (row0_) + 4 * lane), (PG8_LAS unsigned*)(ga.rt + (par) * 256), 16, 0, 0); } } while (0)
#define PG8_CAT8(x0, x1) __builtin_shufflevector(x0, x1, 0, 1, 2, 3, 4, 5, 6, 7)
#define PG8_LDA(dst, b, h) do { if constexpr (FP8) { _Pragma("unroll") for (int m = 0; m < 4; ++m) { const v4i_t x0 = *(const PG8_LAS v4i_t*)(lds + PG8_SA(b, h) + aoff + m * 2048), x1 = *(const PG8_LAS v4i_t*)(lds + PG8_SA(b, h) + aoff + m * 2048 + 1024); dst##8[m] = PG8_CAT8(x0, x1); } } \
    else { _Pragma("unroll") for (int m = 0; m < 4; ++m) _Pragma("unroll") for (int k = 0; k < 2; ++k) dst[m][k] = *(const PG8_LAS bf16x8*)(lds + PG8_SA(b, h) + aoff + m * 2048 + k * 1024); } } while (0)
#define PG8_LDB(dst, b, h) do { if constexpr (FP8) { _Pragma("unroll") for (int n = 0; n < 2; ++n) { const v4i_t x0 = *(const PG8_LAS v4i_t*)(lds + PG8_SB(b, h) + boff + n * 2048), x1 = *(const PG8_LAS v4i_t*)(lds + PG8_SB(b, h) + boff + n * 2048 + 1024); dst##8[n] = PG8_CAT8(x0, x1); } } \
    else { _Pragma("unroll") for (int n = 0; n < 2; ++n) _Pragma("unroll") for (int k = 0; k < 2; ++k) dst[n][k] = *(const PG8_LAS bf16x8*)(lds + PG8_SB(b, h) + boff + n * 2048 + k * 1024); } } while (0)
#define PG8_MMA(ai, bj, At, Bt) do { __builtin_amdgcn_s_setprio(1); _Pragma("unroll") for (int m = 0; m < 4; ++m) _Pragma("unroll") for (int n = 0; n < 2; ++n) { \
        if constexpr (FP8) { asm volatile("v_mfma_f32_16x16x128_f8f6f4 %0, %1, %2, %0" : "+v"(acc[ai][bj][m][n]) : "v"(Bt##8[n]), "v"(At##8[m])); } \
        else { _Pragma("unroll") for (int k = 0; k < 2; ++k) acc[ai][bj][m][n] = __builtin_amdgcn_mfma_f32_16x16x32_bf16(Bt[n][k], At[m][k], acc[ai][bj][m][n], 0, 0, 0); } } \
        __builtin_amdgcn_s_setprio(0); } while (0)
#define PG8_WAIT_V(n) asm volatile("s_waitcnt vmcnt(" #n ")" ::: "memory")
#define PG8_WAIT_L(n) asm volatile("s_waitcnt lgkmcnt(" #n ")" ::: "memory")
#define PG8_BAR __builtin_amdgcn_s_barrier()
#define PG8_SCHED __builtin_amdgcn_sched_barrier(0)
    Unit cur, nxt; int ui = 0;
    if (!S.next(0, cur)) return;
    f32x4 acc[2][2][4][2];
#pragma unroll
    for (int a = 0; a < 2; ++a)
#pragma unroll
        for (int b = 0; b < 2; ++b)
#pragma unroll
            for (int m = 0; m < 4; ++m)
#pragma unroll
                for (int n = 0; n < 2; ++n) acc[a][b][m][n] = (f32x4){0.f, 0.f, 0.f, 0.f};
    bf16x8 At[4][2], B0[2][2], B1[2][2]; v8i_t At8[4], B08[2], B18[2];
    const char* cA = cur.A; const char* cB = cur.B;
    if constexpr (GATHER) PG8_GA_LOAD(0, cur.lrow0);
    PG8_STAGE(PG8_SB(0, 0), cB, voffB); PG8_STAGE(PG8_SB(0, 1), cB + hstep, voffB);
    if constexpr (GATHER) { PG8_WAIT_V(4); PG8_BAR; }
    PG8_STAGE_A(PG8_SA(0, 0), cA, 0, 0, 0); PG8_STAGE_A(PG8_SA(0, 1), cA + hstep, 0, 1, 0);
    if (wr == 1) PG8_BAR;
    PG8_WAIT_V(2); PG8_BAR;
    PG8_STAGE(PG8_SB(1, 0), cB + kstep, voffB); PG8_STAGE_A(PG8_SA(1, 0), cA + kstep, 0, 0, 1); PG8_STAGE(PG8_SB(1, 1), cB + hstep + kstep, voffB);
    PG8_WAIT_V(6); PG8_BAR;
    for (;;) {
        bool has_next = false; const char* nA = cA; const char* nB = cB;
        for (int t = 0; t < nt; t += 2) {
            const bool last = (t == nt - 2);
            if (t == 2) {
                has_next = S.next(ui + 1, nxt); nA = has_next ? nxt.A : cA; nB = has_next ? nxt.B : cB;
                if (GATHER && has_next) { PG8_GA_LOAD((ui & 1) ^ 1, nxt.lrow0); PG8_SCHED; } }
            const char* a1 = cA + (size_t)(t + 1) * kstep;
            const char* a2 = last ? nA : cA + (size_t)(t + 2) * kstep; const char* b2 = last ? nB : cB + (size_t)(t + 2) * kstep;
            const char* a3 = a2 + kstep; const char* b3 = b2 + kstep;
            const int pc = ui & 1, p2 = (last && has_next) ? (pc ^ 1) : pc, k2 = last ? 0 : t + 2;
            if (last) { E.prefetch(cur, wid, lane); PG8_SCHED; }
            PG8_LDB(B0, 0, 0); PG8_LDB(B1, 0, 1); PG8_SCHED; PG8_LDA(At, 0, 0); PG8_STAGE_A(PG8_SA(1, 1), a1 + hstep, pc, 1, t + 1);
            PG8_WAIT_V(8); PG8_WAIT_L(0); PG8_BAR; PG8_MMA(0, 0, At, B0); PG8_MMA(0, 1, At, B1); PG8_BAR; PG8_SCHED;
            PG8_LDA(At, 0, 1); PG8_STAGE(PG8_SB(0, 0), b2, voffB); PG8_STAGE(PG8_SB(0, 1), b2 + hstep, voffB); PG8_STAGE_A(PG8_SA(0, 0), a2, p2, 0, k2);
            PG8_WAIT_V(8); PG8_WAIT_L(0); PG8_BAR; PG8_MMA(1, 0, At, B0); PG8_MMA(1, 1, At, B1); PG8_BAR; PG8_SCHED;
            PG8_LDB(B0, 1, 0); PG8_LDB(B1, 1, 1); PG8_SCHED; PG8_LDA(At, 1, 0); PG8_STAGE_A(PG8_SA(0, 1), a2 + hstep, p2, 1, k2);
            PG8_WAIT_V(8); PG8_WAIT_L(0); PG8_BAR; PG8_MMA(0, 0, At, B0); PG8_MMA(0, 1, At, B1); PG8_BAR; PG8_SCHED;
            PG8_LDA(At, 1, 1); PG8_STAGE(PG8_SB(1, 0), b3, voffB); PG8_STAGE(PG8_SB(1, 1), b3 + hstep, voffB); PG8_STAGE_A(PG8_SA(1, 0), a3, p2, 0, k2 + 1);
            PG8_WAIT_V(8); PG8_WAIT_L(0); PG8_BAR; PG8_MMA(1, 0, At, B0); PG8_MMA(1, 1, At, B1); PG8_BAR; PG8_SCHED;
        }
        if constexpr (ALIGN_EPI) { if (wr == 0) PG8_BAR; }
        if constexpr (FP8) asm volatile("s_nop 15\n\ts_nop 15" ::: "memory");
        E(acc, cur, wr, wc, fr, fq);
        if (!has_next) break;
#pragma unroll
        for (int a = 0; a < 2; ++a)
#pragma unroll
            for (int b = 0; b < 2; ++b)
#pragma unroll
                for (int m = 0; m < 4; ++m)
#pragma unroll
                    for (int n = 0; n < 2; ++n) acc[a][b][m][n] = (f32x4){0.f, 0.f, 0.f, 0.f};
        cur = nxt; cA = nA; cB = nB; ++ui;
        if constexpr (ALIGN_EPI) { if (wr == 1) PG8_BAR; }
    }
    PG8_WAIT_V(0);
    if constexpr (!ALIGN_EPI) { if (wr == 0) PG8_BAR; }
    PG8_BAR;
#undef PG8_SA
#undef PG8_SB
#undef PG8_STAGE
#undef PG8_STAGE_A
#undef PG8_GA_LOAD
#undef PG8_LDA
#undef PG8_LDB
#undef PG8_MMA
#undef PG8_CAT8
#undef PG8_WAIT_V
#undef PG8_WAIT_L
#undef PG8_BAR
#undef PG8_SCHED
}
}

constexpr int RING_OFF = 0, RING_BYTES = 131072;
constexpr int MISC_OFF = 143360, TBL_OFF = MISC_OFF + 256, EPI_OFF = MISC_OFF + 1024;
constexpr int _unused_tbl = 0;
constexpr int RT_OFF = 146432;
constexpr int LDS_BYTES = 151552;
constexpr int NWAVES = 8;

#define GAS __attribute__((address_space(1)))
#define LAS __attribute__((address_space(3)))
typedef unsigned v4u __attribute__((ext_vector_type(4)));
typedef unsigned v2u __attribute__((ext_vector_type(2)));
typedef float f32x4 __attribute__((ext_vector_type(4)));
typedef short bf16x8 __attribute__((ext_vector_type(8)));
typedef short bf16x4 __attribute__((ext_vector_type(4)));
typedef GAS unsigned gu32;
#define RLX_AGENT __ATOMIC_RELAXED, __HIP_MEMORY_SCOPE_AGENT
#define LDS_WAIT() asm volatile("s_waitcnt lgkmcnt(0)" ::: "memory")
#define VM_WAIT() asm volatile("s_waitcnt vmcnt(0)" ::: "memory")
#ifndef TPROBE
#define TPROBE 0
#endif
#ifndef TPN
#define TPN 4
#endif
#define TP_BEGIN(k) long long _tp0_##k = 0; if (TPROBE == (k)) _tp0_##k = (long long)__builtin_amdgcn_s_memrealtime()
#define TP_END(k) do { if (TPROBE == (k)) { const long long _t1 = (long long)__builtin_amdgcn_s_memrealtime(), _dt = _t1 - _tp0_##k; while ((long long)__builtin_amdgcn_s_memrealtime() - _t1 < (long long)TPN * _dt) __builtin_amdgcn_s_sleep(4); } } while (0)
__device__ __forceinline__ unsigned pk2(float lo, float hi) { unsigned r; asm("v_cvt_pk_bf16_f32 %0, %1, %2" : "=v"(r) : "v"(lo), "v"(hi)); return r; }
__device__ __forceinline__ bf16 f2bf1(float x) { return (bf16)(pk2(x, x) & 0xffffu); }
__device__ __forceinline__ float bflo(unsigned w) { return __builtin_bit_cast(float, w << 16); }
__device__ __forceinline__ float bfhi(unsigned w) { return __builtin_bit_cast(float, w & 0xffff0000u); }

#define XB_TMO      128
#define XB_XCNT(j)  (256  + 64 * (j))
#define XB_XSUB(j)  (1280 + 64 * (j))
#define XB_XGEN(j)  (2304 + 64 * (j))
#define XB_TOP      3328
#define XB_TOPGEN   3392
#define XCD_BAR_WORDS 3456
#define XB_SPIN_CAP (1u << 18)
__device__ __forceinline__ unsigned xb_ld(unsigned* p)              { return __hip_atomic_load(p, __ATOMIC_RELAXED, __HIP_MEMORY_SCOPE_AGENT); }
__device__ __forceinline__ unsigned xb_add(unsigned* p, unsigned v) { return __hip_atomic_fetch_add(p, v, __ATOMIC_RELAXED, __HIP_MEMORY_SCOPE_AGENT); }
__device__ __forceinline__ unsigned xb_xcc_id() { return (unsigned)__builtin_amdgcn_s_getreg((3 << 11) | 20) & 0xFu; }
#define XB_SPIN(cond, bar) do { unsigned _sp = 0; while (cond) { __builtin_amdgcn_s_sleep(1); \
    if ((++_sp & 255u) == 0u) { if (xb_ld(&(bar)[XB_TMO])) break; if (_sp > XB_SPIN_CAP) { atomicAdd(&(bar)[XB_TMO], 1u); break; } } } } while (0)
struct XcdBarrier { unsigned* bar; unsigned x; volatile LAS unsigned* st; };
__device__ __forceinline__ XcdBarrier xcd_barrier_post(unsigned* bar, volatile LAS unsigned* st) {
    XcdBarrier b; b.bar = bar; b.x = xb_xcc_id(); b.st = st;
    if (threadIdx.x == 0) (void)xb_add(&bar[XB_XCNT(b.x)], 1u);
    return b;
}
__device__ __forceinline__ void xcd_barrier_complete(unsigned* bar, unsigned x, unsigned& nloc, unsigned& nx) {
    const unsigned G = gridDim.x * gridDim.y * gridDim.z;
    unsigned sum, cnt, mine, sp = 0u;
    for (;;) {
        sum = 0u; cnt = 0u; mine = 0u;
#pragma unroll
        for (unsigned j = 0; j < 16; ++j) { const unsigned c = xb_ld(&bar[XB_XCNT(j)]); sum += c; cnt += (c > 0u) ? 1u : 0u; mine = (j == x) ? c : mine; }
        if (sum == G) break;
        __builtin_amdgcn_s_sleep(1);
        if ((++sp & 255u) == 0u) { if (xb_ld(&bar[XB_TMO])) break; if (sp > XB_SPIN_CAP) { atomicAdd(&bar[XB_TMO], 1u); break; } }
    }
    nloc = mine > 0u ? mine : 1u; nx = cnt > 0u ? cnt : 1u;
}
__device__ __attribute__((noinline)) void xcd_barrier(unsigned* bar_, unsigned x_, volatile LAS unsigned* st_) {
    XcdBarrier b; b.bar = bar_; b.x = x_; b.st = st_;
    asm volatile("s_waitcnt vmcnt(0)" ::: "memory");
    __syncthreads();
    if (threadIdx.x == 0) {
        unsigned* bar = b.bar;
        __builtin_amdgcn_s_waitcnt(0);
        unsigned nloc = b.st[0], nx = b.st[1];
        if (nloc == 0u) { xcd_barrier_complete(bar, b.x, nloc, nx); b.st[0] = nloc; b.st[1] = nx; }
        const unsigned old = xb_add(&bar[XB_XSUB(b.x)], 1u);
        const unsigned gen = old / nloc;
        if (old + 1u == (gen + 1u) * nloc) {
            __builtin_amdgcn_fence(__ATOMIC_RELEASE, "agent");
            asm volatile("s_waitcnt vmcnt(0)" ::: "memory");
            const unsigned og = xb_add(&bar[XB_TOP], 1u);
            const unsigned tg = og / nx;
            if (og + 1u == (tg + 1u) * nx) xb_add(&bar[XB_TOPGEN], 1u);
            else XB_SPIN(xb_ld(&bar[XB_TOPGEN]) == tg, bar);
            __builtin_amdgcn_fence(__ATOMIC_ACQUIRE, "agent");
            xb_add(&bar[XB_XGEN(b.x)], 1u);
            asm volatile("s_waitcnt vmcnt(0)" ::: "memory");
        } else {
            XB_SPIN(xb_ld(&bar[XB_XGEN(b.x)]) == gen, bar);
            __builtin_amdgcn_fence(__ATOMIC_ACQUIRE, "agent");
            asm volatile("s_waitcnt vmcnt(0)" ::: "memory");
        }
    }
    __syncthreads();
}

struct Args { const float* in[28]; float* out; unsigned char* ws; int ph_lo, ph_hi, li, pad; };
enum { I_X = 0, I_C, I_ADAW, I_ADAB, I_N1G, I_WIN, I_CONVW, I_CONVB, I_WR, I_BR, I_WI, I_BI, I_LAM, I_LNG, I_LNB, I_SGUW, I_SGUB, I_GNL, I_GNS, I_WOUT, I_N2G, I_RW, I_RB, I_WGU, I_BGU, I_WDN, I_BDN, I_FG };
constexpr int NPH = 11;

template <int CTRL> __device__ __forceinline__ float dppf(float v) { return __builtin_bit_cast(float, __builtin_amdgcn_update_dpp(0, __builtin_bit_cast(int, v), CTRL, 0xF, 0xF, true)); }
__device__ __forceinline__ float xor16f(float v, float& own) { const unsigned a = __builtin_bit_cast(unsigned, v); const auto r = __builtin_amdgcn_permlane16_swap(a, a, false, false); own = __builtin_bit_cast(float, (unsigned)r[0]); return __builtin_bit_cast(float, (unsigned)r[1]); }
__device__ __forceinline__ float xor32f(float v, float& own) { const unsigned a = __builtin_bit_cast(unsigned, v); const auto r = __builtin_amdgcn_permlane32_swap(a, a, false, false); own = __builtin_bit_cast(float, (unsigned)r[0]); return __builtin_bit_cast(float, (unsigned)r[1]); }
__device__ __forceinline__ float sum32(float v) {
    v += dppf<0xB1>(v); v += dppf<0x4E>(v); v += dppf<0x141>(v); v += dppf<0x140>(v); float o; const float p = xor16f(v, o); return o + p; }
__device__ __forceinline__ float max32(float v) {
    v = fmaxf(v, dppf<0xB1>(v)); v = fmaxf(v, dppf<0x4E>(v)); v = fmaxf(v, dppf<0x141>(v)); v = fmaxf(v, dppf<0x140>(v)); float o; const float p = xor16f(v, o); return fmaxf(o, p); }
__device__ __forceinline__ float wave_sum(float v) { v = sum32(v); float o; const float p = xor32f(v, o); return o + p; }

struct P0Item { const float* src; size_t step; unsigned char* dst; const float* ksc; int k0, kind; };
__device__ __forceinline__ void p0_load(f32x4 (&v)[16], const P0Item& it) {
#pragma unroll
    for (int i = 0; i < 16; ++i) v[i] = __builtin_nontemporal_load((const f32x4*)(it.src + (size_t)i * it.step));
}
__device__ __forceinline__ void p0_process(const f32x4 (&v)[16], const P0Item& it, LAS float* scr, int lane) {
    if (it.kind == 0) {
#pragma unroll
        for (int i = 0; i < 16; ++i) { const int kk = 4 * i + (lane >> 4); f32x4 w = v[i];
            if (it.ksc) w = w * it.ksc[it.k0 + kk];
            LAS float* d = scr + kk * 65 + 4 * (lane & 15); d[0] = w.x; d[1] = w.y; d[2] = w.z; d[3] = w.w; }
        LDS_WAIT();
        const int c = lane & 7;
#pragma unroll
        for (int j = 0; j < 8; ++j) { const int n = (lane >> 3) + 8 * j; const LAS float* s = scr + (8 * c) * 65 + n;
            v4u o; o.x = pk2(s[0 * 65], s[1 * 65]); o.y = pk2(s[2 * 65], s[3 * 65]); o.z = pk2(s[4 * 65], s[5 * 65]); o.w = pk2(s[6 * 65], s[7 * 65]);
            *(v4u*)(it.dst + ((size_t)n * D + it.k0 + 8 * c) * 2) = o; }
        LDS_WAIT();
    } else {
#pragma unroll
        for (int i = 0; i < 16; ++i) { const int kk = 8 * i + (lane >> 3); const f32x4 w = v[i] * pg8::W8_SCALE;
            LAS float* d = scr + kk * 33 + 4 * (lane & 7); d[0] = w.x; d[1] = w.y; d[2] = w.z; d[3] = w.w; }
        LDS_WAIT();
#pragma unroll
        for (int j = 0; j < 8; ++j) { const int n = (lane & 7) + 8 * (j & 3), c = (lane >> 3) + 8 * (j >> 2); const LAS float* s = scr + (8 * c) * 33 + n;
            v2u o; o.x = pg8::pk4_fp8(s[0 * 33], s[1 * 33], s[2 * 33], s[3 * 33]); o.y = pg8::pk4_fp8(s[4 * 33], s[5 * 33], s[6 * 33], s[7 * 33]);
            *(v2u*)(it.dst + (size_t)n * D + it.k0 + 8 * c) = o; }
        LDS_WAIT();
    }
}
__device__ __forceinline__ void p0_prologue(const Args& a, LAS unsigned char* lds, int tid, int lane, int wave, int vcu, int G) {
    unsigned char* ws = a.ws;
    TP_BEGIN(1);
    for (int u = vcu; u < 192; u += G) {
        const int cb = u % 12, ks = u / 12; LAS float* sl = (LAS float*)lds; LAS float* red = (LAS float*)(lds + 1024);
        const int g = tid >> 7, c4 = tid & 127; f32x4 w[16];
        { const float* src = a.in[I_ADAW] + (size_t)(ks * 64 + g) * 6144 + cb * 512 + 4 * c4;
#pragma unroll
          for (int i = 0; i < 16; ++i) w[i] = __builtin_nontemporal_load((const f32x4*)(src + (size_t)(4 * i) * 6144)); }
        if (tid < 256) { const float c = a.in[I_C][(tid >> 6) * 1024 + ks * 64 + (tid & 63)]; sl[tid] = c * sigmoidf_(c); }
        __syncthreads();
        f32x4 acc[4];
#pragma unroll
        for (int bb = 0; bb < 4; ++bb) acc[bb] = (f32x4){0.f, 0.f, 0.f, 0.f};
#pragma unroll
        for (int i = 0; i < 16; ++i) { const int kk = g + 4 * i;
#pragma unroll
            for (int bb = 0; bb < 4; ++bb) acc[bb] += w[i] * sl[bb * 64 + kk]; }
#pragma unroll
        for (int bb = 0; bb < 4; ++bb) *(LAS f32x4*)(red + (g * 4 + bb) * 512 + 4 * c4) = acc[bb];
        __syncthreads();
        float* mp = (float*)(ws + WS_MODP) + (size_t)(ks * 4) * 6144 + cb * 512 + tid;
#pragma unroll
        for (int bb = 0; bb < 4; ++bb) mp[bb * 6144] = (red[bb * 512 + tid] + red[(4 + bb) * 512 + tid]) + (red[(8 + bb) * 512 + tid] + red[(12 + bb) * 512 + tid]);
        __syncthreads();
    }
    TP_END(1); TP_BEGIN(2);
    for (int j = vcu; j < 48; j += G) {
        if (j < 16) { const int m = j >> 3, h = j & 7; const float* src = a.in[m ? I_WI : I_WR] + h * 4096; bf16* dst = (bf16*)(ws + WS_WRT) + (m * 8 + h) * 4096;
            for (int idx = tid; idx < 4096; idx += 512) { const int o = idx >> 6, i = idx & 63; dst[idx] = (bf16)f2bf(src[i * 64 + o]); } }
        else { const int q = j - 16; bf16* dst = (bf16*)(ws + WS_WM);
            for (int idx = q * 4096 + tid; idx < (q + 1) * 4096; idx += 512) { const int t = (idx >> 7) & 127, s = idx & 127; dst[idx] = s <= t ? (bf16)f2bf(a.in[I_SGUW][idx]) : (bf16)0; } }
    }
    TP_END(2); TP_BEGIN(3);
    LAS float* scr = (LAS float*)(lds + wave * 16896);
    const int gw = vcu * NWAVES + wave, NGW = G * NWAVES;
    constexpr int I_IN = 16 * 32, I_OUT = 16 * 16, I_GU = 32 * 16 * 32, I_DN = 32 * 16 * 16, NITEMS = I_IN + I_OUT + I_GU + I_DN;
    const float* pWIN = a.in[I_WIN]; const float* pWOUT = a.in[I_WOUT]; const float* pWGU = a.in[I_WGU]; const float* pWDN = a.in[I_WDN]; const float* pGNL = a.in[I_GNL]; const float* pGNS = a.in[I_GNS];
    auto decode = [&](int it0, P0Item& o) {
        int r = it0;
        if (r < I_IN) { const int kb = r >> 5, nb = r & 31; o.kind = 0; o.k0 = 64 * kb; o.ksc = nullptr;
            o.src = pWIN + (size_t)(64 * kb + (lane >> 4)) * NPROJ + 64 * nb + 4 * (lane & 15); o.step = (size_t)4 * NPROJ; o.dst = ws + WS_WINT + (size_t)(64 * nb) * D * 2; return; }
        r -= I_IN;
        if (r < I_OUT) { const int kb = r >> 4, nb = r & 15; o.kind = 0; o.k0 = 64 * kb; o.ksc = o.k0 < DL ? pGNL : pGNS - DL;
            o.src = pWOUT + (size_t)(64 * kb + (lane >> 4)) * D + 64 * nb + 4 * (lane & 15); o.step = (size_t)4 * D; o.dst = ws + WS_WOUTT + (size_t)(64 * nb) * D * 2; return; }
        r -= I_OUT;
        if (r < I_GU) { const int e = r >> 9, q = r & 511, kb = q >> 6, nb = q & 63; const int n0 = 32 * nb, n1 = n0 & 1023; const int rd = (n1 >> 7) * 256 + (n0 >= 1024 ? 128 : 0) + (n1 & 127);
            o.kind = 1; o.k0 = 128 * kb; o.ksc = nullptr;
            o.src = pWGU + (size_t)e * D * 2048 + (size_t)(128 * kb + (lane >> 3)) * 2048 + n0 + 4 * (lane & 7); o.step = (size_t)8 * 2048; o.dst = ws + WS_WGUT + ((size_t)e * 2048 + rd) * D; return; }
        r -= I_GU;
        { const int e = r >> 8, q = r & 255, kb = q >> 5, nb = q & 31; o.kind = 1; o.k0 = 128 * kb; o.ksc = nullptr;
            o.src = pWDN + (size_t)e * D * D + (size_t)(128 * kb + (lane >> 3)) * D + 32 * nb + 4 * (lane & 7); o.step = (size_t)8 * D; o.dst = ws + WS_WDNT + ((size_t)e * D + 32 * nb) * D; }
    };
    int it = gw;
    if (it < NITEMS) {
        P0Item cur; f32x4 vc[16]; decode(it, cur); p0_load(vc, cur);
        for (;;) {
            const int itn = it + NGW; const bool more = itn < NITEMS;
            P0Item nxt = cur; f32x4 vn[16];
            if (more) { decode(itn, nxt); p0_load(vn, nxt); }
            p0_process(vc, cur, scr, lane);
            if (!more) break;
            cur = nxt; it = itn;
#pragma unroll
            for (int i = 0; i < 16; ++i) vc[i] = vn[i];
        }
    }
    TP_END(3);
}
__device__ __forceinline__ void p1_modz(const Args& a, LAS unsigned char* lds, int tid, int lane, int wave, int vcu, int G) {
    const float* modp = (const float*)(a.ws + WS_MODP); float* mod = (float*)(a.ws + WS_MOD); bf16* Z = (bf16*)(a.ws + WS_Z); bf16* XB = (bf16*)(a.ws + WS_XB);
    for (int idx = vcu * 512 + tid; idx < 4 * 6144; idx += G * 512) { const int b = idx / 6144, n = idx - b * 6144; float s = a.in[I_ADAB][n];
#pragma unroll
        for (int ks = 0; ks < 16; ++ks) s += modp[(size_t)(ks * 4 + b) * 6144 + n];
        mod[idx] = s; }
    const int wpb = G / 4, b = vcu / wpb;
    LAS float* SHs = (LAS float*)lds; LAS float* SCs = (LAS float*)(lds + 4096);
    for (int k = tid; k < 2048; k += 512) { float s = a.in[I_ADAB][k];
#pragma unroll
        for (int ks = 0; ks < 16; ++ks) s += modp[(size_t)(ks * 4 + b) * 6144 + k];
        if (k < 1024) SHs[k] = s; else SCs[k - 1024] = (1.f + s) * a.in[I_N1G][k - 1024]; }
    __syncthreads();
    const int lw = (vcu - b * wpb) * NWAVES + wave, nlw = wpb * NWAVES;
#ifndef P1_NR
#define P1_NR 4
#endif
    for (int t = lw; t < SEQ; t += P1_NR * nlw) {
        f32x4 v[P1_NR][4]; float s[P1_NR];
#pragma unroll
        for (int q = 0; q < P1_NR; ++q) { const int tq_ = min(t + q * nlw, SEQ - 1); const f32x4* xr = (const f32x4*)(a.in[I_X] + ((size_t)b * SEQ + tq_) * D) + lane;
#pragma unroll
            for (int j = 0; j < 4; ++j) v[q][j] = __builtin_nontemporal_load(xr + 64 * j); }
#pragma unroll
        for (int q = 0; q < P1_NR; ++q) { s[q] = 0.f;
#pragma unroll
            for (int j = 0; j < 4; ++j) s[q] += (v[q][j].x * v[q][j].x + v[q][j].y * v[q][j].y) + (v[q][j].z * v[q][j].z + v[q][j].w * v[q][j].w);
            s[q] = rsqrtf(wave_sum(s[q]) * (1.f / D) + EPS); }
#pragma unroll
        for (int q = 0; q < P1_NR; ++q) if (t + q * nlw < SEQ) { v2u* o8 = (v2u*)(Z + ((size_t)b * SEQ + t + q * nlw) * D) + lane; v2u* x8 = (v2u*)(XB + ((size_t)b * SEQ + t + q * nlw) * D) + lane;
#pragma unroll
            for (int j = 0; j < 4; ++j) { const f32x4 g = *(const LAS f32x4*)(SCs + 4 * lane + 256 * j), sh = *(const LAS f32x4*)(SHs + 4 * lane + 256 * j); const f32x4 z = v[q][j] * s[q] * g + sh;
                v2u w; w.x = pk2(z.x, z.y); w.y = pk2(z.z, z.w); o8[64 * j] = w;
                v2u xw; xw.x = pk2(v[q][j].x, v[q][j].y); xw.y = pk2(v[q][j].z, v[q][j].w); x8[64 * j] = xw; } }
    }
    __syncthreads();
}
constexpr int XS = 516;
template <bool PASSB>
__device__ __forceinline__ void lru_unit(const Args& a, LAS unsigned char* lds, int tid, int lane, int wave, int unit) {
    const int b = unit >> 6, tb = unit & 63; const size_t row0 = (size_t)b * SEQ + tb * 64;
    const bf16* P = (const bf16*)(a.ws + WS_PROJ); float* agg = (float*)(a.ws + WS_AGG); bf16* HEADS = (bf16*)(a.ws + WS_HEADS); unsigned* phg = (unsigned*)(a.ws + WS_O32);
    LAS float* xcf = (LAS float*)lds; LAS float* Al = (LAS float*)(lds + 33280); LAS float* Bl = (LAS float*)(lds + 66560);
    LAS float* cst = (LAS float*)(lds + 99840); LAS float* rsl = (LAS float*)(lds + 105984);
    const int ch = tid, h = wave, tq = lane & 15, kq = lane >> 4;
    TP_BEGIN(311);
    bf16 xan[16], yan[16];
#pragma unroll
    for (int i = 0; i < 16; ++i) { xan[i] = __builtin_nontemporal_load(P + (row0 + i) * NPROJ + ch); if (PASSB) yan[i] = P[(row0 + i) * NPROJ + 512 + ch]; }
    const float cw0 = a.in[I_CONVW][ch], cw1 = a.in[I_CONVW][DL + ch], cw2 = a.in[I_CONVW][2 * DL + ch], cw3 = a.in[I_CONVW][3 * DL + ch], cb = a.in[I_CONVB][ch];
    cst[ch] = a.in[I_BR][ch]; cst[512 + ch] = a.in[I_BI][ch]; cst[1024 + ch] = log1pf(expf(-a.in[I_LAM][ch]));
    bf16x8 wrf[4][2], wif[4][2];
    { const bf16* wrt = (const bf16*)(a.ws + WS_WRT) + h * 4096; const bf16* wit = wrt + 8 * 4096;
#pragma unroll
      for (int ct = 0; ct < 4; ++ct)
#pragma unroll
          for (int ks = 0; ks < 2; ++ks) { const int off = (16 * ct + tq) * 64 + ks * 32 + 8 * kq; wrf[ct][ks] = *(const bf16x8*)(wrt + off); wif[ct][ks] = *(const bf16x8*)(wit + off); } }
    float x1 = 0.f, x2 = 0.f, x3 = 0.f;
    if (tb > 0) { x1 = bf2f(P[(row0 - 1) * NPROJ + ch]); x2 = bf2f(P[(row0 - 2) * NPROJ + ch]); x3 = bf2f(P[(row0 - 3) * NPROJ + ch]); }
    float hs = 0.f, pp = 1.f;
    if (PASSB) { const float* ag = agg + ((size_t)(b * 64) * 512 + ch) * 2;
        for (int c0 = 0; c0 < tb; c0 += 32) { float2 ph[32];
#pragma unroll
            for (int j = 0; j < 32; ++j) { ph[j].x = 1.f; ph[j].y = 0.f; if (c0 + j < tb) ph[j] = *(const float2*)(ag + (size_t)(c0 + j) * 1024); }
#pragma unroll
            for (int j = 0; j < 32; ++j) hs = ph[j].x * hs + ph[j].y; } }
    __syncthreads();
    TP_END(311);
    for (int sub = 0; sub < 4; ++sub) {
        TP_BEGIN(312);
        const size_t r0 = row0 + sub * 16;
        float xav[16], o[16];
#pragma unroll
        for (int i = 0; i < 16; ++i) { xav[i] = bf2f(xan[i]); if (PASSB) o[i] = bf2f(yan[i]); }
        if (sub < 3) {
#pragma unroll
            for (int i = 0; i < 16; ++i) { xan[i] = __builtin_nontemporal_load(P + (r0 + 16 + i) * NPROJ + ch); if (PASSB) yan[i] = P[(r0 + 16 + i) * NPROJ + 512 + ch]; } }
#pragma unroll
        for (int i = 0; i < 16; ++i) { const float xa = xav[i]; xcf[i * XS + ch] = cw0 * x3 + cw1 * x2 + cw2 * x1 + cw3 * xa + cb; x3 = x2; x2 = x1; x1 = xa; }
        __syncthreads();
        TP_END(312); TP_BEGIN(313);
        {
            bf16x8 xb[2];
#pragma unroll
            for (int ks = 0; ks < 2; ++ks) { const LAS float* p = xcf + tq * XS + h * 64 + ks * 32 + 8 * kq; const f32x4 lo = *(const LAS f32x4*)p, hi = *(const LAS f32x4*)(p + 4);
                const v4u w = {pk2(lo.x, lo.y), pk2(lo.z, lo.w), pk2(hi.x, hi.y), pk2(hi.z, hi.w)}; xb[ks] = __builtin_bit_cast(bf16x8, w); }
#pragma unroll
            for (int ct = 0; ct < 4; ++ct) { f32x4 rec = {0.f, 0.f, 0.f, 0.f}, inp = {0.f, 0.f, 0.f, 0.f};
#pragma unroll
                for (int ks = 0; ks < 2; ++ks) { rec = __builtin_amdgcn_mfma_f32_16x16x32_bf16(wrf[ct][ks], xb[ks], rec, 0, 0, 0); inp = __builtin_amdgcn_mfma_f32_16x16x32_bf16(wif[ct][ks], xb[ks], inp, 0, 0, 0); }
                const int cbase = h * 64 + 16 * ct + 4 * kq;
                const f32x4 xc4 = *(const LAS f32x4*)(xcf + tq * XS + cbase), br4 = *(const LAS f32x4*)(cst + cbase), bi4 = *(const LAS f32x4*)(cst + 512 + cbase), sp4 = *(const LAS f32x4*)(cst + 1024 + cbase);
                f32x4 av, bt;
                {
                    const f32x4 er = (rec + br4) * (-1.4426950409f), ei = (inp + bi4) * (-1.4426950409f); f32x4 rr, ig;
#pragma unroll
                    for (int r = 0; r < 4; ++r) { rr[r] = __builtin_amdgcn_rcpf(1.f + __builtin_amdgcn_exp2f(er[r])); ig[r] = __builtin_amdgcn_rcpf(1.f + __builtin_amdgcn_exp2f(ei[r])); }
                    const f32x4 la = rr * sp4 * (-8.f), y = la * 2.f, l2 = la * 1.4426950409f;
#pragma unroll
                    for (int r = 0; r < 4; ++r) av[r] = __builtin_amdgcn_exp2f(l2[r]);
                    const f32x4 ser = -y * (y * (y * (y * (y * 0.0083333338f + 0.041666668f) + 0.16666667f) + 0.5f) + 1.f), big = (f32x4){1.f, 1.f, 1.f, 1.f} - av * av; f32x4 em;
#pragma unroll
                    for (int r = 0; r < 4; ++r) em[r] = __builtin_amdgcn_sqrtf(y[r] > -0.25f ? ser[r] : big[r]);
                    bt = em * ig * xc4; }
                *(LAS f32x4*)(Al + tq * XS + cbase) = av; *(LAS f32x4*)(Bl + tq * XS + cbase) = bt; }
        }
        __syncthreads();
        TP_END(313); TP_BEGIN(314);
#pragma unroll
        for (int i = 0; i < 16; ++i) { const float av = Al[i * XS + ch], bt = Bl[i * XS + ch]; hs = av * hs + bt; if (PASSB) o[i] *= hs; else { pp *= av; phg[(r0 + i) * 512 + ch] = pk2(pp, hs); } }
        if (PASSB) {
#pragma unroll
            for (int i = 0; i < 16; ++i) Al[i * XS + ch] = o[i];
            __syncthreads();
            { const int t = tid >> 5, part = tid & 31; float s = 0.f;
#pragma unroll
              for (int j = 0; j < 16; ++j) { const float v = Al[t * XS + part + 32 * j]; s += v * v; }
              s = sum32(s);
              if (part == 0) rsl[t] = rsqrtf(s * (1.f / 512.f) + EPS); }
            __syncthreads();
#pragma unroll
            for (int i = 0; i < 16; ++i) HEADS[(r0 + i) * D + ch] = f2bf1(o[i] * rsl[i]);
        }
        __syncthreads();
        TP_END(314);
    }
    if (!PASSB) { float2 ph; ph.x = pp; ph.y = hs; *(float2*)(agg + ((size_t)(b * 64 + tb) * 512 + ch) * 2) = ph; }
}
__device__ __forceinline__ void lru_passb_unit(const Args& a, LAS unsigned char* lds, int tid, int lane, int wave, int unit) {
    const int b = unit >> 6, tb = unit & 63; const size_t row0 = (size_t)b * SEQ + tb * 64;
    const bf16* P = (const bf16*)(a.ws + WS_PROJ); const float* agg = (const float*)(a.ws + WS_AGG); bf16* HEADS = (bf16*)(a.ws + WS_HEADS); const unsigned* phg = (const unsigned*)(a.ws + WS_O32);
    LAS float* ol = (LAS float*)lds; LAS float* rsl = (LAS float*)(lds + 33280);
    const int ch = tid;
    unsigned phn[16]; bf16 yan[16];
#pragma unroll
    for (int i = 0; i < 16; ++i) { phn[i] = __builtin_nontemporal_load(phg + (row0 + i) * 512 + ch); yan[i] = __builtin_nontemporal_load(P + (row0 + i) * NPROJ + 512 + ch); }
    float carry = 0.f;
    { const float* ag = agg + ((size_t)(b * 64) * 512 + ch) * 2;
      for (int c0 = 0; c0 < tb; c0 += 32) { float2 ph[32];
#pragma unroll
          for (int j = 0; j < 32; ++j) { ph[j].x = 1.f; ph[j].y = 0.f; if (c0 + j < tb) ph[j] = *(const float2*)(ag + (size_t)(c0 + j) * 1024); }
#pragma unroll
          for (int j = 0; j < 32; ++j) carry = ph[j].x * carry + ph[j].y; } }
    for (int sub = 0; sub < 4; ++sub) {
        const size_t r0 = row0 + sub * 16; float o[16];
#pragma unroll
        for (int i = 0; i < 16; ++i) o[i] = (bfhi(phn[i]) + bflo(phn[i]) * carry) * bf2f(yan[i]);
        if (sub < 3) {
#pragma unroll
            for (int i = 0; i < 16; ++i) { phn[i] = __builtin_nontemporal_load(phg + (r0 + 16 + i) * 512 + ch); yan[i] = __builtin_nontemporal_load(P + (r0 + 16 + i) * NPROJ + 512 + ch); } }
#pragma unroll
        for (int i = 0; i < 16; ++i) ol[i * XS + ch] = o[i];
        __syncthreads();
        { const int t = tid >> 5, part = tid & 31; float sq = 0.f;
#pragma unroll
          for (int j = 0; j < 16; ++j) { const float v = ol[t * XS + part + 32 * j]; sq += v * v; }
          sq = sum32(sq);
          if (part == 0) rsl[t] = rsqrtf(sq * (1.f / 512.f) + EPS); }
        __syncthreads();
#pragma unroll
        for (int i = 0; i < 16; ++i) HEADS[(r0 + i) * D + ch] = f2bf1(o[i] * rsl[i]);
        __syncthreads();
    }
}
__device__ __forceinline__ void sgu_unit(const Args& a, LAS unsigned char* lds, int tid, int lane, int wave, int unit) {
    constexpr int RS = 132;
    const int th = unit & 1, bn = unit >> 1, Ks = 64 * (th + 1); const size_t rowbase = (size_t)bn * CHUNK;
    const bf16* P = (const bf16*)(a.ws + WS_PROJ); bf16* HEADS = (bf16*)(a.ws + WS_HEADS); const bf16* WM = (const bf16*)(a.ws + WS_WM);
    LAS bf16* vnT = (LAS bf16*)lds; LAS float* ssq = (LAS float*)(lds + 135168);
    bf16x8 wfr[4][4];
    { const bf16* wmh0 = WM + (size_t)wave * 16384 + (size_t)(64 * th + (lane & 15)) * 128 + 8 * (lane >> 4);
#pragma unroll
      for (int rt = 0; rt < 4; ++rt)
#pragma unroll
          for (int ks = 0; ks < 4; ++ks) { wfr[rt][ks] = (bf16x8){0, 0, 0, 0, 0, 0, 0, 0}; if (32 * ks < Ks && 32 * ks <= 64 * th + 16 * rt + 15) wfr[rt][ks] = *(const bf16x8*)(wmh0 + rt * 16 * 128 + 32 * ks); } }
    TP_BEGIN(321);
    {
        float lg[8], lb[8];
#pragma unroll
        for (int j = 0; j < 8; ++j) { lg[j] = a.in[I_LNG][lane + 64 * j]; lb[j] = a.in[I_LNB][lane + 64 * j]; }
        for (int s8 = 8 * wave; s8 < Ks; s8 += 8 * NWAVES) { float v[8][8]; float mean[8], rstd[8];
#pragma unroll
            for (int q = 0; q < 8; ++q) { const bf16* prow = P + (rowbase + s8 + q) * NPROJ + 1536;
#pragma unroll
                for (int j = 0; j < 8; ++j) v[q][j] = bf2f(__builtin_nontemporal_load(prow + lane + 64 * j)); }
#pragma unroll
            for (int q = 0; q < 8; ++q) { float sm = 0.f;
#pragma unroll
                for (int j = 0; j < 8; ++j) sm += v[q][j];
                mean[q] = sm; }
#pragma unroll
            for (int q = 0; q < 8; ++q) { mean[q] = wave_sum(mean[q]) * (1.f / 512.f); float qq = 0.f;
#pragma unroll
                for (int j = 0; j < 8; ++j) { v[q][j] -= mean[q]; qq += v[q][j] * v[q][j]; }
                rstd[q] = qq; }
#pragma unroll
            for (int q = 0; q < 8; ++q) rstd[q] = rsqrtf(wave_sum(rstd[q]) * (1.f / 512.f) + EPS);
#pragma unroll
            for (int j = 0; j < 8; ++j) {
#pragma unroll
                for (int g = 0; g < 2; ++g) { v2u w; w.x = pk2(v[4 * g][j] * rstd[4 * g] * lg[j] + lb[j], v[4 * g + 1][j] * rstd[4 * g + 1] * lg[j] + lb[j]); w.y = pk2(v[4 * g + 2][j] * rstd[4 * g + 2] * lg[j] + lb[j], v[4 * g + 3][j] * rstd[4 * g + 3] * lg[j] + lb[j]);
                    *(LAS v2u*)(vnT + (lane + 64 * j) * RS + s8 + 4 * g) = w; } } }
    }
    __syncthreads();
    TP_END(321);
    TP_BEGIN(322);
    const int h = wave, tq = lane & 15, kq = lane >> 4;
    f32x4 acc[4][4];
#pragma unroll
    for (int rt = 0; rt < 4; ++rt)
#pragma unroll
        for (int ct = 0; ct < 4; ++ct) acc[rt][ct] = (f32x4){0.f, 0.f, 0.f, 0.f};
    v2u uw[4][4]; float bias4[4];
#pragma unroll
    for (int rt = 0; rt < 4; ++rt) { const int t = 64 * th + 16 * rt + tq; bias4[rt] = a.in[I_SGUB][h * CHUNK + t]; const bf16* urow = P + (rowbase + t) * NPROJ + 1024 + h * 64 + 4 * kq;
#pragma unroll
        for (int ct = 0; ct < 4; ++ct) uw[rt][ct] = __builtin_nontemporal_load((const v2u*)(urow + 16 * ct)); }
#pragma unroll
    for (int ks = 0; ks < 4; ++ks) { if (32 * ks >= Ks) break;
        bf16x8 vf[4];
#pragma unroll
        for (int ct = 0; ct < 4; ++ct) { const LAS bf16* p = vnT + (h * 64 + 16 * ct + tq) * RS + 32 * ks + 8 * kq; const bf16x4 lo = *(const LAS bf16x4*)p, hi = *(const LAS bf16x4*)(p + 4);
            vf[ct] = (bf16x8){lo[0], lo[1], lo[2], lo[3], hi[0], hi[1], hi[2], hi[3]}; }
#pragma unroll
        for (int rt = 0; rt < 4; ++rt) if (32 * ks <= 64 * th + 16 * rt + 15) { const bf16x8 wf = wfr[rt][ks];
#pragma unroll
            for (int ct = 0; ct < 4; ++ct) acc[rt][ct] = __builtin_amdgcn_mfma_f32_16x16x32_bf16(vf[ct], wf, acc[rt][ct], 0, 0, 0); }
    }
    TP_END(322);
#pragma unroll
    for (int rt = 0; rt < 4; ++rt) { const float bias = bias4[rt]; float sl = 0.f;
#pragma unroll
        for (int ct = 0; ct < 4; ++ct) { const v2u uq = uw[rt][ct];
            f32x4 o; o.x = bflo(uq.x) * (acc[rt][ct].x + bias); o.y = bfhi(uq.x) * (acc[rt][ct].y + bias); o.z = bflo(uq.y) * (acc[rt][ct].z + bias); o.w = bfhi(uq.y) * (acc[rt][ct].w + bias);
            acc[rt][ct] = o; sl += (o.x * o.x + o.y * o.y) + (o.z * o.z + o.w * o.w); }
        { float o_; const float p_ = xor16f(sl, o_); sl = o_ + p_; } { float o_; const float p_ = xor32f(sl, o_); sl = o_ + p_; }
        if (kq == 0) ssq[(16 * rt + tq) * 8 + h] = sl; }
    __syncthreads();
#pragma unroll
    for (int rt = 0; rt < 4; ++rt) { const int tl = 16 * rt + tq; const f32x4 s0 = *(const LAS f32x4*)(ssq + tl * 8), s1 = *(const LAS f32x4*)(ssq + tl * 8 + 4);
        const float rs = rsqrtf(((s0.x + s0.y) + (s0.z + s0.w) + (s1.x + s1.y) + (s1.z + s1.w)) * (1.f / 512.f) + EPS);
        bf16* hrow = HEADS + (rowbase + 64 * th + tl) * D + DL + h * 64 + 4 * kq;
#pragma unroll
        for (int ct = 0; ct < 4; ++ct) { v2u w; w.x = pk2(acc[rt][ct].x * rs, acc[rt][ct].y * rs); w.y = pk2(acc[rt][ct].z * rs, acc[rt][ct].w * rs); *(v2u*)(hrow + 16 * ct) = w; } }
    __syncthreads();
}
constexpr int RW_PITCH = 2064, RW_IMG = 2 * 32 * RW_PITCH;
constexpr size_t WS_RWS = 12 * MiB, WS_CB = 12 * MiB + 786432;
__device__ __forceinline__ void router_tables(const Args& a, int tid, int lane, int wave, int c, int n) {
    const float* mod = (const float*)(a.ws + WS_MOD); const float* rw = a.in[I_RW]; const float* n2g = a.in[I_N2G];
    for (int idx = c * 512 + tid; idx < 4 * D * NE; idx += n * 512) { const int e = idx & 31, k = (idx >> 5) & 1023, b = idx >> 15;
        const float w = rw[k * NE + e] * (n2g[k] * (1.f + mod[b * 6144 + 4096 + k]));
        const unsigned hi = pk2(w, w) & 0xffffu; const float r = w - __builtin_bit_cast(float, hi << 16); const unsigned mid = pk2(r, r) & 0xffffu;
        bf16* img = (bf16*)(a.ws + WS_RWS + (size_t)b * RW_IMG) + e * (RW_PITCH / 2) + k; img[0] = (bf16)hi; img[RW_IMG / 4] = (bf16)mid; }
    for (int j = c * NWAVES + wave; j < 4 * NE; j += n * NWAVES) { const int b = j >> 5, e = j & 31; float sacc = 0.f;
        for (int k = lane; k < D; k += 64) sacc += mod[b * 6144 + 3072 + k] * rw[k * NE + e];
        sacc = wave_sum(sacc); if (lane == 0) ((float*)(a.ws + WS_CB))[j] = sacc + a.in[I_RB][e]; }
}
template <int DRY>
__device__ __forceinline__ void router_unit(const Args& a, LAS unsigned char* lds, int tid, int lane, int wave, int unit) {
    const int tok0 = unit * 64, b = tok0 / SEQ;
    TP_BEGIN(60); TP_BEGIN(61);
    const float rbv = ((const float*)(a.ws + WS_CB))[b * NE + (lane & 31)];
    const bf16* HB = (const bf16*)(a.ws + WS_PROJ); const float* mod = (const float*)(a.ws + WS_MOD) + b * 6144; unsigned char* Z = a.ws + WS_Z;
    int* toke = (int*)(a.ws + WS_TOKE); float* gatee = (float*)(a.ws + WS_GATEE); int* pos = (int*)(a.ws + WS_POS); unsigned* cursor = (unsigned*)(a.ws + WS_CTL) + CW_CUR;
    LAS int* asg_e = (LAS int*)(lds + 140672); LAS float* asg_g = (LAS float*)(lds + 141696); LAS int* offl = (LAS int*)(lds + 142720);
    LAS float* part = (LAS float*)lds; LAS float* GK = (LAS float*)(lds + 132096); LAS float* SH = (LAS float*)(lds + 136192); LAS float* rsl = (LAS float*)(lds + 140288); LAS int* hist = (LAS int*)(lds + 140544);
    for (int k = tid; k < D; k += 512) { GK[k] = a.in[I_N2G][k] * (1.f + mod[4096 + k]); SH[k] = mod[3072 + k]; }
    if (tid < 32) hist[tid] = 0;
    { const unsigned char* img = a.ws + WS_RWS + (size_t)b * RW_IMG + lane * 16;
#pragma unroll
      for (int p = 0; p < 16; ++p) { const int piece = wave * 16 + p; __builtin_amdgcn_global_load_lds((const unsigned*)(img + piece * 1024), (LAS unsigned*)(lds + piece * 1024), 16, 0, 0); }
      if (wave == 0) __builtin_amdgcn_global_load_lds((const unsigned*)(img + 128 * 1024), (LAS unsigned*)(lds + 128 * 1024), 16, 0, 0); }
    __syncthreads();
    TP_END(61); TP_BEGIN(62);
    v4u dvv[16];
    { const int tt = wave & 3, kh = wave >> 2, ti = lane & 15, kq = lane >> 4; const bf16* drow = HB + (size_t)(tok0 + tt * 16 + ti) * D + kh * 512 + 8 * kq;
#pragma unroll
      for (int blk = 0; blk < 16; ++blk) dvv[blk] = *(const v4u*)(drow + blk * 32); }
    for (int i0 = 0; i0 < 8; i0 += 4) {
        f32x4 v[4][4]; float rs[4];
#pragma unroll
        for (int q = 0; q < 4; ++q) { const size_t ro = (size_t)(tok0 + wave * 8 + i0 + q) * D + 4 * lane;
#pragma unroll
            for (int j = 0; j < 4; ++j) { const v2u d = *(const v2u*)(HB + ro + 256 * j); f32x4 xv; xv.x = bflo(d.x); xv.y = bfhi(d.x); xv.z = bflo(d.y); xv.w = bfhi(d.y); v[q][j] = xv; } }
#pragma unroll
        for (int q = 0; q < 4; ++q) { float s = 0.f;
#pragma unroll
            for (int j = 0; j < 4; ++j) s += (v[q][j].x * v[q][j].x + v[q][j].y * v[q][j].y) + (v[q][j].z * v[q][j].z + v[q][j].w * v[q][j].w);
            rs[q] = rsqrtf(wave_sum(s) * (1.f / D) + EPS); }
#pragma unroll
        for (int q = 0; q < 4; ++q) { const int tl = wave * 8 + i0 + q; unsigned* o4 = (unsigned*)(Z + (size_t)(tok0 + tl) * D) + lane;
#pragma unroll
            for (int j = 0; j < 4; ++j) { const f32x4 g = *(const LAS f32x4*)(GK + 4 * lane + 256 * j), sh = *(const LAS f32x4*)(SH + 4 * lane + 256 * j); const f32x4 z = v[q][j] * rs[q] * g + sh;
                o4[64 * j] = pg8::pk4_fp8(z.x, z.y, z.z, z.w); }
            if (lane == 0) rsl[tl] = rs[q]; } }
    TP_END(62); TP_BEGIN(63);
    asm volatile("s_waitcnt vmcnt(16)" ::: "memory");
    __syncthreads();
    TP_END(63); TP_BEGIN(64);
    if (DRY == 3) { if (dvv[0].x == 0x12345u && dvv[15].w == 0x54321u && dvv[7].y == 0x777u) rsl[0] = 0.f; __syncthreads(); return; }
    {
        const int tt = wave & 3, kh = wave >> 2, ti = lane & 15, kq = lane >> 4;
        f32x4 c0 = {0.f, 0.f, 0.f, 0.f}, c1 = {0.f, 0.f, 0.f, 0.f};
        const LAS unsigned char* bp = lds + ti * RW_PITCH + (kh * 512 + 8 * kq) * 2;
#pragma unroll
        for (int blk = 0; blk < 16; ++blk) { const bf16x8 av = __builtin_bit_cast(bf16x8, dvv[blk]);
            const bf16x8 b00 = *(const LAS bf16x8*)(bp + blk * 64), b01 = *(const LAS bf16x8*)(bp + blk * 64 + RW_IMG / 2), b10 = *(const LAS bf16x8*)(bp + blk * 64 + 16 * RW_PITCH), b11 = *(const LAS bf16x8*)(bp + blk * 64 + 16 * RW_PITCH + RW_IMG / 2);
            c0 = __builtin_amdgcn_mfma_f32_16x16x32_bf16(av, b00, c0, 0, 0, 0); c1 = __builtin_amdgcn_mfma_f32_16x16x32_bf16(av, b10, c1, 0, 0, 0);
            c0 = __builtin_amdgcn_mfma_f32_16x16x32_bf16(av, b01, c0, 0, 0, 0); c1 = __builtin_amdgcn_mfma_f32_16x16x32_bf16(av, b11, c1, 0, 0, 0); }
        __syncthreads();
#pragma unroll
        for (int r = 0; r < 4; ++r) { LAS float* p = part + (kh * 64 + tt * 16 + kq * 4 + r) * 33; p[ti] = c0[r]; p[16 + ti] = c1[r]; }
    }
    __syncthreads();
    TP_END(64); TP_BEGIN(65);
    if (DRY == 2) return;
    {
        const int e = lane & 31, hs = lane & 32;
        float v[4], m0[4], myv[4]; int myk[4];
#pragma unroll
        for (int p = 0; p < 4; ++p) { const int tl = wave * 8 + 2 * p + (lane >> 5); v[p] = (part[tl * 33 + e] + part[(64 + tl) * 33 + e]) * rsl[tl] + rbv; m0[p] = 0.f; myv[p] = 0.f; myk[p] = -1; }
#pragma unroll
        for (int k = 0; k < 4; ++k) { float m[4];
#pragma unroll
            for (int p = 0; p < 4; ++p) m[p] = max32(v[p]);
#pragma unroll
            for (int p = 0; p < 4; ++p) { const unsigned long long bal = __ballot(v[p] == m[p]); const int idx = __ffs((unsigned)(bal >> hs)) - 1;
                if (k == 0) m0[p] = m[p];
                if (e == idx) { v[p] = -INFINITY; myk[p] = k; myv[p] = m[p]; } } }
#pragma unroll
        for (int p = 0; p < 4; ++p) { const float myex = myk[p] >= 0 ? __builtin_amdgcn_exp2f((myv[p] - m0[p]) * 1.4426950409f) : 0.f; const float den = sum32(myex);
            if (myk[p] >= 0) { const int tl = wave * 8 + 2 * p + (lane >> 5); const int r = __hip_atomic_fetch_add(hist + e, 1, __ATOMIC_RELAXED, __HIP_MEMORY_SCOPE_WORKGROUP); asg_e[tl * 4 + myk[p]] = e | (r << 8); asg_g[tl * 4 + myk[p]] = myex * __builtin_amdgcn_rcpf(den); } }
    }
    __syncthreads();
    TP_END(65); TP_BEGIN(66);
    if (DRY == 1) return;
    if (tid < 32) offl[tid] = (int)__hip_atomic_fetch_add(cursor + tid, (unsigned)hist[tid], __ATOMIC_RELAXED, __HIP_MEMORY_SCOPE_AGENT);
    __syncthreads();
    if (tid < 256) { const int ev = asg_e[tid], e = ev & 255, r = ev >> 8; const int idx = e * pg8::ELIST + offl[e] + r; toke[idx] = tok0 + (tid >> 2); gatee[idx] = asg_g[tid]; pos[tok0 * 4 + tid] = idx; }
    __syncthreads();
    TP_END(66); TP_END(60);
}
__device__ __forceinline__ void moe_tables(const Args& a, LAS unsigned char* lds, int tid) {
    LAS int* tp = (LAS int*)(lds + TBL_OFF); LAS int* eb = tp + 36; LAS int* tot = tp + 72; unsigned* cursor = (unsigned*)(a.ws + WS_CTL) + CW_CUR;
    if (tid < 32) tot[tid] = (int)__hip_atomic_load(cursor + tid, __ATOMIC_RELAXED, __HIP_MEMORY_SCOPE_AGENT);
    __syncthreads();
    if (tid <= NE) { int s = 0, r = 0;
#pragma unroll
        for (int e = 0; e < NE; ++e) { const int c_ = tot[e]; if (e < tid) { s += (c_ + 255) >> 8; r += c_; } }
        tp[tid] = s; eb[tid] = r; }
    __syncthreads();
}
__device__ __forceinline__ void final_rows(const Args& a, LAS unsigned char* lds, int lane, int wave, int vcu, int G, bool do_store) {
    const unsigned char* Y = a.ws + WS_Y; const int* pos = (const int*)(a.ws + WS_POS); const float* mod = (const float*)(a.ws + WS_MOD); const bf16* HB = (const bf16*)(a.ws + WS_PROJ);
    const LAS int* ebl = (const LAS int*)(lds + TBL_OFF) + 36;
    const int stride = G * NWAVES; constexpr int NQ = 4;
    int4 pn[NQ];
    { const int t0 = vcu * NWAVES + wave;
#pragma unroll
      for (int q = 0; q < NQ; ++q) pn[q] = *(const int4*)(pos + min(t0 + q * stride, NTOK - 1) * 4); }
    for (int tok0 = vcu * NWAVES + wave; tok0 < NTOK; tok0 += NQ * stride) {
        f32x4 v[NQ][4]; float s[NQ]; int4 pc[NQ];
#pragma unroll
        for (int q = 0; q < NQ; ++q) { pc[q] = pn[q]; pn[q] = *(const int4*)(pos + min(tok0 + (NQ + q) * stride, NTOK - 1) * 4); }
#pragma unroll
        for (int q = 0; q < NQ; ++q) { const int tok = min(tok0 + q * stride, NTOK - 1); const int b = tok / SEQ;
            int4 p = pc[q]; p.x = ebl[p.x >> 14] + (p.x & (pg8::ELIST - 1)); p.y = ebl[p.y >> 14] + (p.y & (pg8::ELIST - 1)); p.z = ebl[p.z >> 14] + (p.z & (pg8::ELIST - 1)); p.w = ebl[p.w >> 14] + (p.w & (pg8::ELIST - 1));
            const bf16* dr = HB + (size_t)tok * D;
#pragma unroll
            for (int j = 0; j < 4; ++j) { const int off = 4 * lane + 256 * j;
                const unsigned y0 = __builtin_nontemporal_load((const unsigned*)(Y + (size_t)p.x * D + off)), y1 = __builtin_nontemporal_load((const unsigned*)(Y + (size_t)p.y * D + off)), y2 = __builtin_nontemporal_load((const unsigned*)(Y + (size_t)p.z * D + off)), y3 = __builtin_nontemporal_load((const unsigned*)(Y + (size_t)p.w * D + off));
                typedef float f32x2_t __attribute__((ext_vector_type(2)));
                const f32x2_t a0 = __builtin_amdgcn_cvt_pk_f32_fp8(y0, false), a1 = __builtin_amdgcn_cvt_pk_f32_fp8(y0, true), b0 = __builtin_amdgcn_cvt_pk_f32_fp8(y1, false), b1 = __builtin_amdgcn_cvt_pk_f32_fp8(y1, true);
                const f32x2_t c0 = __builtin_amdgcn_cvt_pk_f32_fp8(y2, false), c1 = __builtin_amdgcn_cvt_pk_f32_fp8(y2, true), d0 = __builtin_amdgcn_cvt_pk_f32_fp8(y3, false), d1 = __builtin_amdgcn_cvt_pk_f32_fp8(y3, true);
                f32x4 m; m.x = ((a0.x + b0.x) + (c0.x + d0.x)) * (1.f / pg8::Y8_SCALE); m.y = ((a0.y + b0.y) + (c0.y + d0.y)) * (1.f / pg8::Y8_SCALE);
                m.z = ((a1.x + b1.x) + (c1.x + d1.x)) * (1.f / pg8::Y8_SCALE); m.w = ((a1.y + b1.y) + (c1.y + d1.y)) * (1.f / pg8::Y8_SCALE);
                const f32x4 g2 = *(const f32x4*)(mod + b * 6144 + 5120 + off); const v2u d = __builtin_nontemporal_load((const v2u*)(dr + off)); f32x4 hv; hv.x = bflo(d.x); hv.y = bfhi(d.x); hv.z = bflo(d.y); hv.w = bfhi(d.y); v[q][j] = hv + g2 * m; } }
#pragma unroll
        for (int q = 0; q < NQ; ++q) { s[q] = 0.f;
#pragma unroll
            for (int j = 0; j < 4; ++j) s[q] += (v[q][j].x * v[q][j].x + v[q][j].y * v[q][j].y) + (v[q][j].z * v[q][j].z + v[q][j].w * v[q][j].w); }
#pragma unroll
        for (int q = 0; q < NQ; ++q) s[q] = wave_sum(s[q]);
#pragma unroll
        for (int q = 0; q < NQ; ++q) if (do_store && tok0 + q * stride < NTOK) { const float rs = rsqrtf(s[q] * (1.f / D) + EPS); float* hr = a.out + (size_t)(tok0 + q * stride) * D;
#pragma unroll
            for (int j = 0; j < 4; ++j) { const int off = 4 * lane + 256 * j; const f32x4 fg = *(const f32x4*)(a.in[I_FG] + off); *(f32x4*)(hr + off) = v[q][j] * rs * fg; } }
    }
}

__global__ void __launch_bounds__(NWAVES * 64, 2) mega(Args args) {
    extern __shared__ __attribute__((aligned(16))) unsigned char lds_raw[];
    LAS unsigned char* lds = (LAS unsigned char*)lds_raw;
    volatile LAS unsigned* MISC = (volatile LAS unsigned*)(lds + MISC_OFF);
    const int tid = threadIdx.x, lane = tid & 63, wave = __builtin_amdgcn_readfirstlane(tid >> 6);
    const int G = gridDim.x; const int bx = blockIdx.x; const int vcu = (G % 8 == 0) ? (bx % 8) * (G / 8) + bx / 8 : bx;
    for (int u = tid; u < (LDS_BYTES - MISC_OFF) / 4; u += NWAVES * 64) ((LAS unsigned*)(lds + MISC_OFF))[u] = 0u;
    __syncthreads();
    const int lo = args.ph_lo, hi = args.ph_hi;
    XcdBarrier bar; bar.bar = (unsigned*)(args.ws + WS_CTL) + CW_BAR + args.li * XCD_BAR_WORDS; bar.x = 0; bar.st = nullptr;
    if (hi - lo > 1) bar = xcd_barrier_post((unsigned*)(args.ws + WS_CTL) + CW_BAR + args.li * XCD_BAR_WORDS, MISC + 8);
#ifndef PHMASK
#define PHMASK 0x7FF
#endif
#ifndef PHREP
#define PHREP 0
#endif
#define IN(k) (((PHMASK >> (k)) & 1) && lo <= (k) && (k) < hi)
#define NREP(k) (((PHREP >> (k)) & 1) ? 2 : 1)
#ifndef BARREP
#define BARREP 1
#endif
#define SEAM(k) do { if (IN(k) && IN((k) + 1)) { for (int _b = 0; _b < BARREP; ++_b) xcd_barrier(bar.bar, bar.x, bar.st); } } while (0)
    unsigned char* ws = args.ws;
#ifndef P3DUP
#define P3DUP 0
#endif
#ifndef P3DUP
#define P3DUP 0
#endif
#ifndef DRYMODE
#define DRYMODE 1
#endif
#ifndef PHDUP
#define PHDUP -1
#endif
#define DUPBAR() xcd_barrier(bar.bar, bar.x, bar.st)
#define PH2(SH) do { pg8::DenseOrder S; S.init(ws + WS_Z, ws + WS_WINT, NTOK, NPROJ, D * 2, G, ((SH) ? ((bx + 4) & 255) : bx)); pg8::EpiInProj E{(bf16*)(ws + WS_PROJ)}; \
        pg8::gemm_phase<pg8::EpiInProj, pg8::DenseOrder, true>(lds + RING_OFF, D * 2, S, E); } while (0)
#define PH3(SH) do { { TP_BEGIN(31); for (int u = vcu; u < 256; u += G) lru_unit<false>(args, lds, tid, lane, wave, ((SH) ? ((u + 128) & 255) : u)); TP_END(31); } { TP_BEGIN(32); for (int u = vcu; u < 256; u += G) sgu_unit(args, lds, tid, lane, wave, ((SH) ? ((u + 128) & 255) : u)); TP_END(32); } } while (0)
#define PH4(SH) do { for (int u = vcu; u < 256; u += G) lru_passb_unit(args, lds, tid, lane, wave, ((SH) ? ((u + 128) & 255) : u)); } while (0)
#define PH5(SH) do { pg8::DenseOrder S; S.init(ws + WS_HEADS, ws + WS_WOUTT, NTOK, D, D * 2, G, ((SH) ? ((bx + 4) & 255) : bx)); pg8::EpiOutProj E{(const float*)(ws + WS_MOD), (const bf16*)(ws + WS_XB), (bf16*)(ws + WS_PROJ)}; \
        pg8::gemm_phase<pg8::EpiOutProj, pg8::DenseOrder, true>(lds + RING_OFF, D * 2, S, E); } while (0)
#define PH8(SH) do { moe_tables(args, lds, tid); pg8::MoeOrder S; S.init(ws + WS_Z, ws + WS_WGUT, (const LAS int*)(lds + TBL_OFF), (const LAS int*)(lds + TBL_OFF) + 36, 2048, D, G, ((SH) ? ((bx + 4) & 255) : bx)); \
        pg8::EpiSwiglu E{args.in[I_BGU], ws + WS_ACT, lds + EPI_OFF}; const pg8::GatherA ga{(const char*)(ws + WS_Z), (const int*)(ws + WS_TOKE), (LAS unsigned*)(lds + RT_OFF)}; \
        pg8::gemm_phase<pg8::EpiSwiglu, pg8::MoeOrder, true, true, true>(lds + RING_OFF, D, S, E, ga); } while (0)
#define PH9(SH) do { moe_tables(args, lds, tid); pg8::MoeOrder S; S.init(ws + WS_ACT, ws + WS_WDNT, (const LAS int*)(lds + TBL_OFF), (const LAS int*)(lds + TBL_OFF) + 36, D, D, G, ((SH) ? ((bx + 4) & 255) : bx)); \
        pg8::EpiDown E{args.in[I_BDN], (const float*)(ws + WS_GATEE), ws + WS_Y, lds + EPI_OFF}; pg8::gemm_phase<pg8::EpiDown, pg8::MoeOrder, true, true>(lds + RING_OFF, D, S, E); } while (0)
    if (IN(0)) { p0_prologue(args, lds, tid, lane, wave, vcu, G);
#if PHDUP == 0
        DUPBAR(); p0_prologue(args, lds, tid, lane, wave, vcu, G);
#endif
        SEAM(0); }
    if (IN(1)) { TP_BEGIN(10); p1_modz(args, lds, tid, lane, wave, vcu, G); TP_END(10);
#if PHDUP == 1
        DUPBAR(); p1_modz(args, lds, tid, lane, wave, vcu, G);
#endif
        SEAM(1); }
    if (IN(2)) {
#if PHDUP == 2
        PH2(1); DUPBAR();
#endif
        { TP_BEGIN(20); PH2(0); TP_END(20); } SEAM(2); }
    if (IN(3)) {
#if PHDUP == 3
        PH3(1); DUPBAR();
#endif
#if P3DUP == 1
        for (int u = vcu; u < 256; u += G) lru_unit<false>(args, lds, tid, lane, wave, (u + 128) & 255); DUPBAR();
#elif P3DUP == 2
        for (int u = vcu; u < 256; u += G) sgu_unit(args, lds, tid, lane, wave, (u + 128) & 255); DUPBAR();
#endif
#if P3DUP == 1
        for (int u = vcu; u < 256; u += G) lru_unit<false>(args, lds, tid, lane, wave, (u + 128) & 255); DUPBAR();
#elif P3DUP == 2
        for (int u = vcu; u < 256; u += G) sgu_unit(args, lds, tid, lane, wave, (u + 128) & 255); DUPBAR();
#endif
        PH3(0);
        if (G != 256) router_tables(args, tid, lane, wave, vcu, G); else if (!(vcu & 1)) router_tables(args, tid, lane, wave, vcu >> 1, 128);
        SEAM(3); }
    if (IN(4)) {
#if PHDUP == 4
        PH4(1); DUPBAR();
#endif
        { TP_BEGIN(40); PH4(0); TP_END(40); } SEAM(4); }
    if (IN(5)) {
#if PHDUP == 5
        PH5(1); DUPBAR();
#endif
        { TP_BEGIN(50); PH5(0); TP_END(50); } SEAM(5); }
    if (IN(6)) {
#if PHDUP == 6
        for (int u = vcu; u < 256; u += G) router_unit<DRYMODE>(args, lds, tid, lane, wave, (u + 128) & 255); DUPBAR();
#endif
        for (int u = vcu; u < 256; u += G) router_unit<0>(args, lds, tid, lane, wave, u); SEAM(6); }
    if (IN(8)) {
#if PHDUP == 8
        PH8(1); DUPBAR();
#endif
        PH8(0); SEAM(8); }
    if (IN(9)) {
#if PHDUP == 9
        PH9(1); DUPBAR();
#endif
        PH9(0); SEAM(9); }
    if (IN(10)) { TP_BEGIN(100); moe_tables(args, lds, tid); final_rows(args, lds, lane, wave, vcu, G, true); TP_END(100); }
#undef IN
#undef SEAM
}

extern "C" void kernel_launch(void* const* d_in, const int* in_sizes, int n_in, void* d_out, int out_size, void* d_ws, size_t ws_size, hipStream_t stream) {
    static int grid = 0;
    if (grid == 0) {
        if (n_in != 28 || out_size != NTOK * D || ws_size < WS_END) { fprintf(stderr, "kernel_launch: unexpected shapes (n_in %d out %d ws %zu)\n", n_in, out_size, ws_size); grid = -1; return; }
        int dev = 0, cus = 0, per_cu = 0;
        if (hipGetDevice(&dev) != hipSuccess || hipDeviceGetAttribute(&cus, hipDeviceAttributeMultiprocessorCount, dev) != hipSuccess) { grid = -1; return; }
        if (hipFuncSetAttribute((const void*)mega, hipFuncAttributeMaxDynamicSharedMemorySize, LDS_BYTES) != hipSuccess) { fprintf(stderr, "kernel_launch: hipFuncSetAttribute failed\n"); grid = -1; return; }
        if (hipOccupancyMaxActiveBlocksPerMultiprocessor(&per_cu, (const void*)mega, NWAVES * 64, LDS_BYTES) != hipSuccess || per_cu < 1) { fprintf(stderr, "kernel_launch: occupancy query says %d blocks per CU\n", per_cu); (void)hipGetLastError(); grid = -1; return; }
        grid = cus < 256 ? cus : 256;
        if (grid % 8 != 0) { fprintf(stderr, "kernel_launch: %d CUs; the phase programs need a grid that is a multiple of 8\n", cus); grid = -1; return; }
    }
    if (grid < 0) return;
    (void)hipMemsetAsync((unsigned char*)d_ws + WS_CTL, 0, CTL_ZERO_BYTES, stream);
    Args a{};
    for (int i = 0; i < 28; ++i) a.in[i] = (const float*)d_in[i];
    a.out = (float*)d_out; a.ws = (unsigned char*)d_ws; a.ph_lo = 0; a.ph_hi = NPH; a.li = 0;
    hipLaunchKernelGGL(mega, dim3(grid), dim3(NWAVES * 64), LDS_BYTES, stream, a);
}
```

```cpp
#include <hip/hip_runtime.h>
#include <cstdio>
#include <cstdint>

typedef unsigned short bf16;
constexpr int D = 1024, BATCH = 4, SEQ = 4096, NTOK = BATCH * SEQ, NPROJ = 2048, DL = 512, NH = 8, HD = 64, CHUNK = 128, NE = 32, TOPK = 4;
constexpr int NASSIGN = NTOK * TOPK;
constexpr float EPS = 1e-6f;

__device__ __forceinline__ unsigned f2bf(float f) { unsigned u = __builtin_bit_cast(unsigned, f); return (u + 0x7fffu + ((u >> 16) & 1u)) >> 16; }
__device__ __forceinline__ float bf2f(bf16 h) { return __builtin_bit_cast(float, (unsigned)h << 16); }
__device__ __forceinline__ float gelu_tanh(float x) { const float u = 1.5957691216057308f * (x + 0.044715f * x * x * x); return x / (1.f + __expf(-u)); }
__device__ __forceinline__ float sigmoidf_(float x) { return 1.f / (1.f + __expf(-x)); }

constexpr size_t MiB = 1u << 20;
constexpr size_t WS_CTL = 0;
constexpr size_t CTL_ZERO_BYTES = 20480;
constexpr size_t WS_MODP = 1 * MiB;
constexpr size_t WS_MOD = 3 * MiB;
constexpr size_t WS_AGG = 4 * MiB;
constexpr size_t WS_CNT = 5 * MiB;
constexpr size_t WS_TOPE = 6 * MiB;
constexpr size_t WS_GATE = 7 * MiB;
constexpr size_t WS_RANK = 8 * MiB;
constexpr size_t WS_POS = 9 * MiB;
constexpr size_t WS_GSORT = 10 * MiB;
constexpr size_t WS_TOKL = 11 * MiB;
constexpr size_t WS_STATS = 12 * MiB;
constexpr size_t WS_WRT = 13 * MiB;
constexpr size_t WS_WM = 14 * MiB;
constexpr size_t WS_Z = 16 * MiB;
constexpr size_t WS_HEADS = 48 * MiB;
constexpr size_t WS_PROJ = 80 * MiB;
constexpr size_t WS_ACT = 144 * MiB;
constexpr size_t WS_Y = 280 * MiB;
constexpr size_t WS_WINT = 416 * MiB;
constexpr size_t WS_WOUTT = 420 * MiB;
constexpr size_t WS_WGUT = 424 * MiB;
constexpr size_t WS_WDNT = 552 * MiB;
constexpr size_t WS_TOKE = 616 * MiB;
constexpr size_t WS_GATEE = 620 * MiB;
constexpr size_t WS_O32 = 752 * MiB;
constexpr size_t WS_XB = 784 * MiB;
constexpr size_t WS_END = 816 * MiB;
constexpr int CW_CNT = 0, CW_CUR = 64, CW_EBASE = 128;
constexpr int CW_BAR = 1024;

#ifndef P9REV
#define P9REV 1
#endif
#ifndef WARMDN8
#define WARMDN8 1
#endif
namespace pg8 {
#define PG8_LAS __attribute__((address_space(3)))
typedef unsigned short bf16_t;
typedef short bf16x8 __attribute__((ext_vector_type(8)));
typedef float f32x4 __attribute__((ext_vector_type(4)));
typedef unsigned u32x4 __attribute__((ext_vector_type(4)));
constexpr int BM = 256, BK = 64, HALF = 128, HTB = HALF * BK * 2, STAGE_BYTES = 8 * HTB, NXCD = 8, WGM = 8;
constexpr int ELIST = 16384;

__host__ __device__ __forceinline__ int lds_byte(int r, int c) { const int st = (r >> 4) * 2 + (c >> 5), rr = r & 15, cc = c & 31, ob = rr * 64 + cc * 2; return st * 1024 + (ob ^ (((ob >> 9) & 1) << 5)); }
__host__ __device__ __forceinline__ void stage_rc(int b, int& R, int& C) { const int st = b / 1024, sb = b % 1024, swz = sb ^ (((sb >> 9) & 1) << 5); R = (st >> 1) * 16 + swz / 64; C = (st & 1) * 32 + (swz % 64) / 2; }
__host__ __device__ __forceinline__ int perm32(int rho) { const int n = rho >> 4, i = rho & 15; return 8 * (i >> 2) + 4 * n + (i & 3); }

struct Unit { const char* A; const char* B; int row0, col0, nr, e, lrow0; };

struct DenseOrder {
    const char* A; const char* B; int nM, nN, nwg, G, c, pitch;
    __device__ __forceinline__ void init(const void* A_, const void* B_, int M, int N, int pitch_, int G_, int c_) { A = (const char*)A_; B = (const char*)B_; nM = M / BM; nN = N / BM; nwg = nM * nN; G = G_; c = c_; pitch = pitch_; }
    __device__ __forceinline__ bool next(int i, Unit& u) const {
        const long L = (long)i * G + c; if (L >= nwg) return false;
        int wgid = (int)L; { const int q = nwg / NXCD, r = nwg % NXCD, xcd = wgid % NXCD, off = wgid / NXCD; wgid = (xcd < r ? xcd * (q + 1) : r * (q + 1) + (xcd - r) * q) + off; }
        const int nig = WGM * nN, gid = wgid / nig, fm = gid * WGM, gsz = (nM - fm) < WGM ? (nM - fm) : WGM;
        const int pm = fm + ((wgid % nig) % gsz), pn = (wgid % nig) / gsz;
        u.A = A + (size_t)pm * BM * pitch; u.B = B + (size_t)pn * BM * pitch; u.row0 = pm * BM; u.col0 = pn * BM; u.nr = BM; u.e = 0; u.lrow0 = 0; return true;
    }
};
struct MoeOrder {
    const char* A; const char* B; const PG8_LAS int* tpre; const PG8_LAS int* ebase; int NPN, nU, G, c, pitch, N, rev;
    __device__ __forceinline__ void init(const void* A_, const void* B_, const PG8_LAS int* tpre_, const PG8_LAS int* ebase_, int N_, int pitch_, int G_, int c_, int rev_ = 0) {
        rev = rev_; A = (const char*)A_; B = (const char*)B_; tpre = tpre_; ebase = ebase_; N = N_; NPN = N_ / BM; pitch = pitch_; G = G_; c = c_; nU = __builtin_amdgcn_readfirstlane(tpre_[32]) * NPN; }
    __device__ __forceinline__ bool next(int i, Unit& u) const {
        const long L = (long)i * G + c; if (L >= nU) return false;
        int wgid = (int)L; { const int q = nU / NXCD, r = nU % NXCD, xcd = wgid % NXCD; int off = wgid / NXCD; if (rev) off = (xcd < r ? q + 1 : q) - 1 - off; wgid = (xcd < r ? xcd * (q + 1) : r * (q + 1) + (xcd - r) * q) + off; }
        const int ln = threadIdx.x & 31; const unsigned long long bal = __ballot(tpre[ln + 1] * NPN <= wgid);
        int e = __builtin_popcount((unsigned)bal); e = e > 31 ? 31 : e;
        const int tp0 = __builtin_amdgcn_readfirstlane(tpre[e]), tp1 = __builtin_amdgcn_readfirstlane(tpre[e + 1]);
        const int q2 = wgid - tp0 * NPN, nt = tp1 - tp0, pn = q2 / nt, mt = q2 - pn * nt;
        const int eb = __builtin_amdgcn_readfirstlane(ebase[e]), cnt = __builtin_amdgcn_readfirstlane(ebase[e + 1]) - eb;
        u.row0 = eb + BM * mt; u.nr = min(BM, cnt - BM * mt); u.col0 = pn * BM; u.e = e; u.lrow0 = e * ELIST + BM * mt;
        u.A = A + (size_t)u.row0 * pitch; u.B = B + ((size_t)e * N + (size_t)pn * BM) * pitch; return true;
    }
};

__device__ __forceinline__ unsigned cvt_pk_bf16(float lo, float hi) { unsigned r; asm volatile("v_cvt_pk_bf16_f32 %0, %1, %2" : "=v"(r) : "v"(lo), "v"(hi)); return r; }
__device__ __forceinline__ float gelu_fast(float x) { const float u = x * (1.5957691216f + 0.0713548163f * x * x); return x * __builtin_amdgcn_rcpf(1.f + __builtin_amdgcn_exp2f(-1.4426950409f * u)); }
__device__ __forceinline__ f32x4 gelu4(const f32x4 x) {
    const f32x4 t = x * (x * x * (-0.0713548163f * 1.4426950409f) + (-1.5957691216f * 1.4426950409f)); f32x4 d;
#pragma unroll
    for (int q = 0; q < 4; ++q) d[q] = __builtin_amdgcn_rcpf(1.f + __builtin_amdgcn_exp2f(t[q]));
    return x * d;
}
__device__ __forceinline__ float sigm_fast(float x) { return __builtin_amdgcn_rcpf(1.f + __builtin_amdgcn_exp2f(-1.4426950409f * x)); }

struct EpiInProj {
    static constexpr bool PERM = true; static constexpr bool WARM = false; bf16_t* O;
    __device__ __forceinline__ void prefetch(const Unit&, int, int) const {}
    __device__ __forceinline__ void operator()(const f32x4 (&acc)[2][2][4][2], const Unit& u, int wr, int wc, int fr, int fq) const {
        const int row0 = u.row0 + wr * 64 + fr, col0 = u.col0 + wc * 32 + 8 * fq; const bool act = u.col0 >= 512;
#pragma unroll
        for (int ai = 0; ai < 2; ++ai)
#pragma unroll
            for (int m = 0; m < 4; ++m) { bf16_t* rowp = O + (size_t)(row0 + ai * HALF + m * 16) * NPROJ + col0;
#pragma unroll
                for (int bj = 0; bj < 2; ++bj) { f32x4 v0 = acc[ai][bj][m][0], v1 = acc[ai][bj][m][1];
                    if (act) { v0 = gelu4(v0); v1 = gelu4(v1); }
                    u32x4 w; w.x = cvt_pk_bf16(v0[0], v0[1]); w.y = cvt_pk_bf16(v0[2], v0[3]); w.z = cvt_pk_bf16(v1[0], v1[1]); w.w = cvt_pk_bf16(v1[2], v1[3]);
                    *(u32x4*)(rowp + bj * HALF) = w; } }
    }
};
struct EpiOutProj {
    static constexpr bool PERM = true; static constexpr bool WARM = false; const float* mod; const bf16_t* XB; bf16_t* O;
    __device__ __forceinline__ void prefetch(const Unit&, int, int) const {}
    __device__ __forceinline__ void operator()(const f32x4 (&acc)[2][2][4][2], const Unit& u, int wr, int wc, int fr, int fq) const {
        const int row0 = u.row0 + wr * 64 + fr, col0 = u.col0 + wc * 32 + 8 * fq; const int b = u.row0 / SEQ;
        f32x4 g[2][2];
#pragma unroll
        for (int bj = 0; bj < 2; ++bj)
#pragma unroll
            for (int n = 0; n < 2; ++n) g[bj][n] = *(const f32x4*)(mod + b * 6144 + 2048 + col0 + bj * HALF + 4 * n);
#pragma unroll
        for (int ai = 0; ai < 2; ++ai) {
            u32x4 xr[4][2];
#pragma unroll
            for (int m = 0; m < 4; ++m)
#pragma unroll
                for (int bj = 0; bj < 2; ++bj) xr[m][bj] = __builtin_nontemporal_load((const u32x4*)(XB + (size_t)(row0 + ai * HALF + m * 16) * D + col0 + bj * HALF));
#pragma unroll
            for (int m = 0; m < 4; ++m) { bf16_t* rowp = O + (size_t)(row0 + ai * HALF + m * 16) * D + col0;
#pragma unroll
                for (int bj = 0; bj < 2; ++bj) { const u32x4 xw = xr[m][bj]; f32x4 v0 = acc[ai][bj][m][0] * g[bj][0], v1 = acc[ai][bj][m][1] * g[bj][1];
                    v0[0] += __builtin_bit_cast(float, xw.x << 16); v0[1] += __builtin_bit_cast(float, xw.x & 0xffff0000u); v0[2] += __builtin_bit_cast(float, xw.y << 16); v0[3] += __builtin_bit_cast(float, xw.y & 0xffff0000u);
                    v1[0] += __builtin_bit_cast(float, xw.z << 16); v1[1] += __builtin_bit_cast(float, xw.z & 0xffff0000u); v1[2] += __builtin_bit_cast(float, xw.w << 16); v1[3] += __builtin_bit_cast(float, xw.w & 0xffff0000u);
                    u32x4 w; w.x = cvt_pk_bf16(v0[0], v0[1]); w.y = cvt_pk_bf16(v0[2], v0[3]); w.z = cvt_pk_bf16(v1[0], v1[1]); w.w = cvt_pk_bf16(v1[2], v1[3]);
                    *(u32x4*)(rowp + bj * HALF) = w; } }
            asm volatile("" ::: "memory"); }
    }
};
__device__ __forceinline__ unsigned pk4_fp8(float a, float b, float c, float d) { int w = 0; w = __builtin_amdgcn_cvt_pk_fp8_f32(a, b, w, false); w = __builtin_amdgcn_cvt_pk_fp8_f32(c, d, w, true); return (unsigned)w; }
constexpr float W8_SCALE = 64.f, A8_SCALE = 4.f;
typedef unsigned u32x2 __attribute__((ext_vector_type(2)));
__device__ __forceinline__ u32x4 pair16(const u32x2 wA, const u32x2 wB, const bool) {
    const auto r0 = __builtin_amdgcn_permlane16_swap(wA.x, wB.x, false, false), r1 = __builtin_amdgcn_permlane16_swap(wA.y, wB.y, false, false);
    return (u32x4){(unsigned)r0[0], (unsigned)r1[0], (unsigned)r0[1], (unsigned)r1[1]};
}
struct EpiSwiglu {
    static constexpr bool PERM = true; static constexpr bool WARM = (WARMDN8 != 0); const float* bgu; unsigned char* ACT; PG8_LAS unsigned char* epl; const unsigned char* wsrc; PG8_LAS unsigned char* wdst;
    __device__ __forceinline__ void prefetch(const Unit& u, int wid, int lane) const {
        if (wid == 0) { const float* src = bgu + u.e * 2048 + (lane >= 32 ? 1024 : 0) + (u.col0 >> 1) + 4 * (lane & 31);
            __builtin_amdgcn_global_load_lds((const unsigned*)src, (PG8_LAS unsigned*)epl, 16, 0, 0); }
    }
    __device__ __forceinline__ void warm(int ui, int wid, int lane) const {
        __builtin_amdgcn_global_load_lds((const unsigned*)(wsrc + (size_t)(ui * 512 + wid * 64 + lane) * 128), (PG8_LAS unsigned*)wdst, 4, 0, 0); }
    __device__ __forceinline__ void operator()(const f32x4 (&acc)[2][2][4][2], const Unit& u, int wr, int wc, int fr, int fq) const {
        asm volatile("" : "+v"(fr), "+v"(fq));
        const int jl = wc * 32 + 8 * fq, j0 = (u.col0 >> 1) + jl; const bool odd = (fq & 1) != 0;
        f32x4 bg[2], bl[2];
#pragma unroll
        for (int n = 0; n < 2; ++n) { bg[n] = *(const PG8_LAS f32x4*)(epl + (jl + 4 * n) * 4); bl[n] = *(const PG8_LAS f32x4*)(epl + 512 + (jl + 4 * n) * 4); }
#pragma unroll
        for (int ai = 0; ai < 2; ++ai)
#pragma unroll
            for (int mp = 0; mp < 2; ++mp) { u32x2 w2[2];
#pragma unroll
                for (int h = 0; h < 2; ++h) { const int m = 2 * mp + h; f32x4 o[2];
#pragma unroll
                    for (int n = 0; n < 2; ++n) { const f32x4 g = __builtin_elementwise_min(acc[ai][0][m][n] * (1.f / W8_SCALE) + bg[n], (f32x4){7.f, 7.f, 7.f, 7.f});
                        const f32x4 l = __builtin_elementwise_min(__builtin_elementwise_max(acc[ai][1][m][n] * (1.f / W8_SCALE) + bl[n], (f32x4){-7.f, -7.f, -7.f, -7.f}), (f32x4){7.f, 7.f, 7.f, 7.f});
                        const f32x4 ex = g * (-1.702f * 1.4426950409f); f32x4 den;
#pragma unroll
                        for (int q = 0; q < 4; ++q) den[q] = __builtin_amdgcn_rcpf(1.f + __builtin_amdgcn_exp2f(ex[q]));
                        o[n] = (g * A8_SCALE) * den * (l + 1.f); }
                    w2[h].x = pk4_fp8(o[0][0], o[0][1], o[0][2], o[0][3]); w2[h].y = pk4_fp8(o[1][0], o[1][1], o[1][2], o[1][3]); }
                const u32x4 o16 = pair16(w2[0], w2[1], odd);
                const int r = ai * HALF + wr * 64 + (2 * mp + (odd ? 1 : 0)) * 16 + fr;
                if (r < u.nr) *(u32x4*)(ACT + (size_t)(u.row0 + r) * D + j0 - (odd ? 8 : 0)) = o16; }
    }
};
constexpr float Y8_SCALE = 8.f;
struct EpiDown {
    static constexpr bool PERM = true; static constexpr bool WARM = false; const float* bd; const float* gs; unsigned char* Y; PG8_LAS unsigned char* epl;
    __device__ __forceinline__ void prefetch(const Unit& u, int wid, int lane) const {
        if (wid == 0) __builtin_amdgcn_global_load_lds((const unsigned*)(bd + u.e * D + u.col0 + 4 * lane), (PG8_LAS unsigned*)epl, 16, 0, 0);
        if (wid == 1) __builtin_amdgcn_global_load_lds((const unsigned*)(gs + u.lrow0 + 4 * lane), (PG8_LAS unsigned*)(epl + 1024), 16, 0, 0);
    }
    __device__ __forceinline__ void operator()(const f32x4 (&acc)[2][2][4][2], const Unit& u, int wr, int wc, int fr, int fq) const {
        asm volatile("" : "+v"(fr), "+v"(fq));
        const int cl = wc * 32 + 8 * fq, col0 = u.col0 + cl; const bool odd = (fq & 1) != 0;
        f32x4 bv[2][2];
#pragma unroll
        for (int bj = 0; bj < 2; ++bj)
#pragma unroll
            for (int n = 0; n < 2; ++n) bv[bj][n] = *(const PG8_LAS f32x4*)(epl + (cl + bj * HALF + 4 * n) * 4);
#pragma unroll
        for (int ai = 0; ai < 2; ++ai)
#pragma unroll
            for (int mp = 0; mp < 2; ++mp) { const int rb = ai * HALF + wr * 64 + 2 * mp * 16 + fr;
                const float gA = *(const PG8_LAS float*)(epl + 1024 + rb * 4) * Y8_SCALE, gB = *(const PG8_LAS float*)(epl + 1024 + (rb + 16) * 4) * Y8_SCALE;
                const int r = rb + (odd ? 16 : 0); unsigned char* rowp = Y + (size_t)(u.row0 + r) * D + col0 - (odd ? 8 : 0);
#pragma unroll
                for (int bj = 0; bj < 2; ++bj) { u32x2 w2[2];
#pragma unroll
                    for (int h = 0; h < 2; ++h) { const int m = 2 * mp + h; const float gt = h ? gB : gA;
                        const f32x4 v0 = (acc[ai][bj][m][0] * (1.f / (W8_SCALE * A8_SCALE)) + bv[bj][0]) * gt, v1 = (acc[ai][bj][m][1] * (1.f / (W8_SCALE * A8_SCALE)) + bv[bj][1]) * gt;
                        w2[h].x = pk4_fp8(v0[0], v0[1], v0[2], v0[3]); w2[h].y = pk4_fp8(v1[0], v1[1], v1[2], v1[3]); }
                    const u32x4 o16 = pair16(w2[0], w2[1], odd);
                    if (r < u.nr) *(u32x4*)(rowp + bj * HALF) = o16; } }
    }
};

typedef int v4i_t __attribute__((ext_vector_type(4)));
typedef int v8i_t __attribute__((ext_vector_type(8)));
struct GatherA { const char* base; const int* tokl; PG8_LAS unsigned* rt; };
template <class Epi, class Sched, bool ALIGN_EPI, bool FP8 = false, bool GATHER = false>
__device__ __forceinline__ void gemm_phase(PG8_LAS unsigned char* lds, const int pitch, const Sched& S, const Epi& E, const GatherA ga = GatherA{nullptr, nullptr, nullptr}) {
    const int tid = threadIdx.x, wid = __builtin_amdgcn_readfirstlane(tid >> 6), lane = tid & 63, wr = wid >> 2, wc = wid & 3, fr = lane & 15, fq = lane >> 4;
    const int nt = pitch / (BK * 2);
    unsigned voffA[2], voffB[2];
#pragma unroll
    for (int i = 0; i < 2; ++i) { int R, C; stage_rc(tid * 16 + i * 8192, R, C); const int Rb = Epi::PERM ? ((R & ~31) + perm32(R & 31)) : R;
        voffA[i] = GATHER ? (unsigned)(R * 65536 + C * 2) : (unsigned)(R * pitch + C * 2); voffB[i] = (unsigned)(Rb * pitch + C * 2); }
    const size_t kstep = (size_t)(BK * 2);
    const size_t hstep = (size_t)HALF * pitch;
    const unsigned ldsw = (unsigned)wid * 1024u;
    const int aoff = lds_byte(wr * 64 + fr, fq * 8), boff = lds_byte(wc * 32 + fr, fq * 8);
#define PG8_SA(b, h) (((b) * 2 + (h)) * HTB)
#define PG8_SB(b, h) ((4 + (b) * 2 + (h)) * HTB)
#define PG8_STAGE(bufoff, gbase, voff) do { _Pragma("unroll") for (int _i = 0; _i < 2; ++_i) \
        __builtin_amdgcn_global_load_lds((const unsigned*)((const char*)(gbase) + (voff)[_i]), (PG8_LAS unsigned*)(lds + (bufoff) + ldsw + _i * 8192), 16, 0, 0); } while (0)
#define PG8_STAGE_A(bufoff, gbase, par, half, kt) do { if constexpr (GATHER) { _Pragma("unroll") for (int _i = 0; _i < 2; ++_i) { const unsigned _tk = min(ga.rt[(par) * 256 + (half) * 128 + (voffA[_i] >> 16)], (unsigned)(NTOK - 1)); \
            __builtin_amdgcn_global_load_lds((const unsigned*)(ga.base + (size_t)_tk * pitch + (voffA[_i] & 0xffffu) + (kt) * (BK * 2)), (PG8_LAS unsigned*)(lds + (bufoff) + ldsw + _i * 8192), 16, 0, 0); } } \
        else PG8_STAGE(bufoff, gbase, voffA); } while (0)
#define PG8_GA_LOAD(par, row0_) do { if constexpr (GATHER) { if (wid == 2) __builtin_amdgcn_global_load_lds((const unsigned*)(ga.tokl + (row0_) + 4 * lane), (PG8_LAS unsigned*)(ga.rt + (par) * 256), 16, 0, 0); } } while (0)
#define PG8_CAT8(x0, x1) __builtin_shufflevector(x0, x1, 0, 1, 2, 3, 4, 5, 6, 7)
#define PG8_LDA(dst, b, h) do { if constexpr (FP8) { _Pragma("unroll") for (int m = 0; m < 4; ++m) { const v4i_t x0 = *(const PG8_LAS v4i_t*)(lds + PG8_SA(b, h) + aoff + m * 2048), x1 = *(const PG8_LAS v4i_t*)(lds + PG8_SA(b, h) + aoff + m * 2048 + 1024); dst##8[m] = PG8_CAT8(x0, x1); } } \
    else { _Pragma("unroll") for (int m = 0; m < 4; ++m) _Pragma("unroll") for (int k = 0; k < 2; ++k) dst[m][k] = *(const PG8_LAS bf16x8*)(lds + PG8_SA(b, h) + aoff + m * 2048 + k * 1024); } } while (0)
#define PG8_LDB(dst, b, h) do { if constexpr (FP8) { _Pragma("unroll") for (int n = 0; n < 2; ++n) { const v4i_t x0 = *(const PG8_LAS v4i_t*)(lds + PG8_SB(b, h) + boff + n * 2048), x1 = *(const PG8_LAS v4i_t*)(lds + PG8_SB(b, h) + boff + n * 2048 + 1024); dst##8[n] = PG8_CAT8(x0, x1); } } \
    else { _Pragma("unroll") for (int n = 0; n < 2; ++n) _Pragma("unroll") for (int k = 0; k < 2; ++k) dst[n][k] = *(const PG8_LAS bf16x8*)(lds + PG8_SB(b, h) + boff + n * 2048 + k * 1024); } } while (0)
#define PG8_MMA(ai, bj, At, Bt) do { __builtin_amdgcn_s_setprio(1); _Pragma("unroll") for (int m = 0; m < 4; ++m) _Pragma("unroll") for (int n = 0; n < 2; ++n) { \
        if constexpr (FP8) { asm volatile("v_mfma_f32_16x16x128_f8f6f4 %0, %1, %2, %0" : "+v"(acc[ai][bj][m][n]) : "v"(Bt##8[n]), "v"(At##8[m])); } \
        else { _Pragma("unroll") for (int k = 0; k < 2; ++k) acc[ai][bj][m][n] = __builtin_amdgcn_mfma_f32_16x16x32_bf16(Bt[n][k], At[m][k], acc[ai][bj][m][n], 0, 0, 0); } } \
        __builtin_amdgcn_s_setprio(0); } while (0)
#define PG8_WAIT_V(n) asm volatile("s_waitcnt vmcnt(" #n ")" ::: "memory")
#define PG8_WAIT_L(n) asm volatile("s_waitcnt lgkmcnt(" #n ")" ::: "memory")
#define PG8_BAR __builtin_amdgcn_s_barrier()
#define PG8_SCHED __builtin_amdgcn_sched_barrier(0)
    Unit cur, nxt; int ui = 0;
    if (!S.next(0, cur)) return;
    f32x4 acc[2][2][4][2];
#pragma unroll
    for (int a = 0; a < 2; ++a)
#pragma unroll
        for (int b = 0; b < 2; ++b)
#pragma unroll
            for (int m = 0; m < 4; ++m)
#pragma unroll
                for (int n = 0; n < 2; ++n) acc[a][b][m][n] = (f32x4){0.f, 0.f, 0.f, 0.f};
    bf16x8 At[4][2], B0[2][2], B1[2][2]; v8i_t At8[4], B08[2], B18[2];
    const char* cA = cur.A; const char* cB = cur.B;
    if constexpr (GATHER) PG8_GA_LOAD(0, cur.lrow0);
    PG8_STAGE(PG8_SB(0, 0), cB, voffB); PG8_STAGE(PG8_SB(0, 1), cB + hstep, voffB);
    if constexpr (GATHER) { PG8_WAIT_V(4); PG8_BAR; }
    PG8_STAGE_A(PG8_SA(0, 0), cA, 0, 0, 0); PG8_STAGE_A(PG8_SA(0, 1), cA + hstep, 0, 1, 0);
    if (wr == 1) PG8_BAR;
    PG8_WAIT_V(2); PG8_BAR;
    PG8_STAGE(PG8_SB(1, 0), cB + kstep, voffB); PG8_STAGE_A(PG8_SA(1, 0), cA + kstep, 0, 0, 1); PG8_STAGE(PG8_SB(1, 1), cB + hstep + kstep, voffB);
    PG8_WAIT_V(6); PG8_BAR;
    for (;;) {
        bool has_next = false; const char* nA = cA; const char* nB = cB;
        for (int t = 0; t < nt; t += 2) {
            const bool last = (t == nt - 2);
            if (t == 2) {
                has_next = S.next(ui + 1, nxt); nA = has_next ? nxt.A : cA; nB = has_next ? nxt.B : cB;
                if (GATHER && has_next) { PG8_GA_LOAD((ui & 1) ^ 1, nxt.lrow0); PG8_SCHED; } }
            const char* a1 = cA + (size_t)(t + 1) * kstep;
            const char* a2 = last ? nA : cA + (size_t)(t + 2) * kstep; const char* b2 = last ? nB : cB + (size_t)(t + 2) * kstep;
            const char* a3 = a2 + kstep; const char* b3 = b2 + kstep;
            const int pc = ui & 1, p2 = (last && has_next) ? (pc ^ 1) : pc, k2 = last ? 0 : t + 2;
            if (last) { E.prefetch(cur, wid, lane); PG8_SCHED; }
            PG8_LDB(B0, 0, 0); PG8_LDB(B1, 0, 1); PG8_SCHED; PG8_LDA(At, 0, 0); PG8_STAGE_A(PG8_SA(1, 1), a1 + hstep, pc, 1, t + 1);
            PG8_WAIT_V(8); PG8_WAIT_L(0); PG8_BAR; PG8_MMA(0, 0, At, B0); PG8_MMA(0, 1, At, B1); PG8_BAR; PG8_SCHED;
            PG8_LDA(At, 0, 1); PG8_STAGE(PG8_SB(0, 0), b2, voffB); PG8_STAGE(PG8_SB(0, 1), b2 + hstep, voffB); PG8_STAGE_A(PG8_SA(0, 0), a2, p2, 0, k2);
            PG8_WAIT_V(8); PG8_WAIT_L(0); PG8_BAR; PG8_MMA(1, 0, At, B0); PG8_MMA(1, 1, At, B1); PG8_BAR; PG8_SCHED;
            PG8_LDB(B0, 1, 0); PG8_LDB(B1, 1, 1); PG8_SCHED; PG8_LDA(At, 1, 0); PG8_STAGE_A(PG8_SA(0, 1), a2 + hstep, p2, 1, k2);
            PG8_WAIT_V(8); PG8_WAIT_L(0); PG8_BAR; PG8_MMA(0, 0, At, B0); PG8_MMA(0, 1, At, B1); PG8_BAR; PG8_SCHED;
            PG8_LDA(At, 1, 1); PG8_STAGE(PG8_SB(1, 0), b3, voffB); PG8_STAGE(PG8_SB(1, 1), b3 + hstep, voffB); PG8_STAGE_A(PG8_SA(1, 0), a3, p2, 0, k2 + 1);
            PG8_WAIT_V(8); PG8_WAIT_L(0); PG8_BAR; PG8_MMA(1, 0, At, B0); PG8_MMA(1, 1, At, B1); PG8_BAR; PG8_SCHED;
        }
        if constexpr (ALIGN_EPI) { if (wr == 0) PG8_BAR; }
        if constexpr (FP8) asm volatile("s_nop 15\n\ts_nop 15" ::: "memory");
        if constexpr (Epi::WARM) { if (ui < 2) E.warm(ui, wid, lane); }
        E(acc, cur, wr, wc, fr, fq);
        if (!has_next) break;
#pragma unroll
        for (int a = 0; a < 2; ++a)
#pragma unroll
            for (int b = 0; b < 2; ++b)
#pragma unroll
                for (int m = 0; m < 4; ++m)
#pragma unroll
                    for (int n = 0; n < 2; ++n) acc[a][b][m][n] = (f32x4){0.f, 0.f, 0.f, 0.f};
        cur = nxt; cA = nA; cB = nB; ++ui;
        if constexpr (ALIGN_EPI) { if (wr == 1) PG8_BAR; }
    }
    PG8_WAIT_V(0);
    if constexpr (!ALIGN_EPI) { if (wr == 0) PG8_BAR; }
    PG8_BAR;
#undef PG8_SA
#undef PG8_SB
#undef PG8_STAGE
#undef PG8_STAGE_A
#undef PG8_GA_LOAD
#undef PG8_LDA
#undef PG8_LDB
#undef PG8_MMA
#undef PG8_CAT8
#undef PG8_WAIT_V
#undef PG8_WAIT_L
#undef PG8_BAR
#undef PG8_SCHED
}
}

constexpr int RING_OFF = 0, RING_BYTES = 131072;
constexpr int MISC_OFF = 143360, TBL_OFF = MISC_OFF + 256, EPI_OFF = MISC_OFF + 1024;
constexpr int _unused_tbl = 0;
constexpr int RT_OFF = 146432;
constexpr int LDS_BYTES = 151552;
constexpr int NWAVES = 8;

#define GAS __attribute__((address_space(1)))
#define LAS __attribute__((address_space(3)))
typedef unsigned v4u __attribute__((ext_vector_type(4)));
typedef unsigned v2u __attribute__((ext_vector_type(2)));
typedef float f32x4 __attribute__((ext_vector_type(4)));
typedef short bf16x8 __attribute__((ext_vector_type(8)));
typedef short bf16x4 __attribute__((ext_vector_type(4)));
typedef GAS unsigned gu32;
#define RLX_AGENT __ATOMIC_RELAXED, __HIP_MEMORY_SCOPE_AGENT
#define LDS_WAIT() asm volatile("s_waitcnt lgkmcnt(0)" ::: "memory")
#define VM_WAIT() asm volatile("s_waitcnt vmcnt(0)" ::: "memory")
#ifndef TPROBE
#define TPROBE 0
#endif
#ifndef TPN
#define TPN 4
#endif
#define TP_BEGIN(k) long long _tp0_##k = 0; if (TPROBE == (k)) _tp0_##k = (long long)__builtin_amdgcn_s_memrealtime()
#define TP_END(k) do { if (TPROBE == (k)) { const long long _t1 = (long long)__builtin_amdgcn_s_memrealtime(), _dt = _t1 - _tp0_##k; while ((long long)__builtin_amdgcn_s_memrealtime() - _t1 < (long long)TPN * _dt) __builtin_amdgcn_s_sleep(4); } } while (0)
__device__ __forceinline__ unsigned pk2(float lo, float hi) { unsigned r; asm("v_cvt_pk_bf16_f32 %0, %1, %2" : "=v"(r) : "v"(lo), "v"(hi)); return r; }
__device__ __forceinline__ bf16 f2bf1(float x) { return (bf16)(pk2(x, x) & 0xffffu); }
__device__ __forceinline__ float bflo(unsigned w) { return __builtin_bit_cast(float, w << 16); }
__device__ __forceinline__ float bfhi(unsigned w) { return __builtin_bit_cast(float, w & 0xffff0000u); }

constexpr int CW_ADA = 256;
constexpr int CW_EXIT = 4600, CW_ZERO_WORDS = 4992, CW_FLAG = 5056; constexpr unsigned INIT_MAGIC = 0x1F2E3D4Cu;
#define XB_TMO      128
#define XB_XCNT(j)  (256  + 64 * (j))
#define XB_XSUB(j)  (1280 + 64 * (j))
#define XB_XGEN(j)  (2304 + 64 * (j))
#define XB_TOP      3328
#define XB_TOPGEN   3392
#define XCD_BAR_WORDS 3456
#define XB_SPIN_CAP (1u << 18)
__device__ __forceinline__ unsigned xb_ld(unsigned* p)              { return __hip_atomic_load(p, __ATOMIC_RELAXED, __HIP_MEMORY_SCOPE_AGENT); }
__device__ __forceinline__ unsigned xb_add(unsigned* p, unsigned v) { return __hip_atomic_fetch_add(p, v, __ATOMIC_RELAXED, __HIP_MEMORY_SCOPE_AGENT); }
__device__ __forceinline__ void ctl_wait_ready(unsigned* ctl) { unsigned sp = 0u; while (xb_ld(ctl + CW_FLAG) != INIT_MAGIC) { __builtin_amdgcn_s_sleep(1); if (++sp > (1u << 22)) break; } }
__device__ __forceinline__ unsigned xb_xcc_id() { return (unsigned)__builtin_amdgcn_s_getreg((3 << 11) | 20) & 0xFu; }
#define XB_SPIN(cond, bar) do { unsigned _sp = 0; while (cond) { __builtin_amdgcn_s_sleep(1); \
    if ((++_sp & 255u) == 0u) { if (xb_ld(&(bar)[XB_TMO])) break; if (_sp > XB_SPIN_CAP) { atomicAdd(&(bar)[XB_TMO], 1u); break; } } } } while (0)
struct XcdBarrier { unsigned* bar; unsigned x; volatile LAS unsigned* st; };
__device__ __forceinline__ XcdBarrier xcd_barrier_post(unsigned* bar, volatile LAS unsigned* st) {
    XcdBarrier b; b.bar = bar; b.x = xb_xcc_id(); b.st = st;
    if (threadIdx.x == 0) (void)xb_add(&bar[XB_XCNT(b.x)], 1u);
    return b;
}
__device__ __forceinline__ void xcd_barrier_complete(unsigned* bar, unsigned x, unsigned& nloc, unsigned& nx) {
    const unsigned G = gridDim.x * gridDim.y * gridDim.z;
    unsigned sum, cnt, mine, sp = 0u;
    for (;;) {
        sum = 0u; cnt = 0u; mine = 0u;
#pragma unroll
        for (unsigned j = 0; j < 16; ++j) { const unsigned c = xb_ld(&bar[XB_XCNT(j)]); sum += c; cnt += (c > 0u) ? 1u : 0u; mine = (j == x) ? c : mine; }
        if (sum == G) break;
        __builtin_amdgcn_s_sleep(1);
        if ((++sp & 255u) == 0u) { if (xb_ld(&bar[XB_TMO])) break; if (sp > XB_SPIN_CAP) { atomicAdd(&bar[XB_TMO], 1u); break; } }
    }
    nloc = mine > 0u ? mine : 1u; nx = cnt > 0u ? cnt : 1u;
}
__device__ __attribute__((noinline)) void xcd_barrier(unsigned* bar_, unsigned x_, volatile LAS unsigned* st_) {
    XcdBarrier b; b.bar = bar_; b.x = x_; b.st = st_;
    asm volatile("s_waitcnt vmcnt(0)" ::: "memory");
    __syncthreads();
#ifndef EARLYINV
#define EARLYINV 1
#endif
    if (threadIdx.x == 0) {
        unsigned* bar = b.bar;
        __builtin_amdgcn_s_waitcnt(0);
        if (EARLYINV) asm volatile("buffer_inv sc1" ::: "memory");
        unsigned nloc = b.st[0], nx = b.st[1];
        if (nloc == 0u) { xcd_barrier_complete(bar, b.x, nloc, nx); b.st[0] = nloc; b.st[1] = nx; }
        const unsigned old = xb_add(&bar[XB_XSUB(b.x)], 1u);
        const unsigned gen = old / nloc;
        if (old + 1u == (gen + 1u) * nloc) {
            __builtin_amdgcn_fence(__ATOMIC_RELEASE, "agent");
            asm volatile("s_waitcnt vmcnt(0)" ::: "memory");
            const unsigned og = xb_add(&bar[XB_TOP], 1u);
            const unsigned tg = og / nx;
#ifndef TOPPOLL
#define TOPPOLL 1
#endif
            if (TOPPOLL) { const unsigned target = (tg + 1u) * nx; if (og + 1u != target) XB_SPIN(xb_ld(&bar[XB_TOP]) < target, bar); }
            else { if (og + 1u == (tg + 1u) * nx) xb_add(&bar[XB_TOPGEN], 1u); else XB_SPIN(xb_ld(&bar[XB_TOPGEN]) == tg, bar); }
            if (!EARLYINV) __builtin_amdgcn_fence(__ATOMIC_ACQUIRE, "agent");
#ifndef ALLPOLLTOP
#define ALLPOLLTOP 1
#endif
            if (!ALLPOLLTOP) xb_add(&bar[XB_XGEN(b.x)], 1u);
            if (!EARLYINV) asm volatile("s_waitcnt vmcnt(0)" ::: "memory");
        } else {
            if (ALLPOLLTOP) XB_SPIN(xb_ld(&bar[XB_TOP]) < (gen + 1u) * nx, bar);
            else XB_SPIN(xb_ld(&bar[XB_XGEN(b.x)]) == gen, bar);
            if (!EARLYINV) __builtin_amdgcn_fence(__ATOMIC_ACQUIRE, "agent");
            asm volatile("s_waitcnt vmcnt(0)" ::: "memory");
        }
    }
    __syncthreads();
}

struct Args { const float* in[28]; float* out; unsigned char* ws; int ph_lo, ph_hi, li, pad; };
enum { I_X = 0, I_C, I_ADAW, I_ADAB, I_N1G, I_WIN, I_CONVW, I_CONVB, I_WR, I_BR, I_WI, I_BI, I_LAM, I_LNG, I_LNB, I_SGUW, I_SGUB, I_GNL, I_GNS, I_WOUT, I_N2G, I_RW, I_RB, I_WGU, I_BGU, I_WDN, I_BDN, I_FG };
constexpr int NPH = 11;

template <int CTRL> __device__ __forceinline__ float dppf(float v) { return __builtin_bit_cast(float, __builtin_amdgcn_update_dpp(0, __builtin_bit_cast(int, v), CTRL, 0xF, 0xF, true)); }
__device__ __forceinline__ float xor16f(float v, float& own) { const unsigned a = __builtin_bit_cast(unsigned, v); const auto r = __builtin_amdgcn_permlane16_swap(a, a, false, false); own = __builtin_bit_cast(float, (unsigned)r[0]); return __builtin_bit_cast(float, (unsigned)r[1]); }
__device__ __forceinline__ float xor32f(float v, float& own) { const unsigned a = __builtin_bit_cast(unsigned, v); const auto r = __builtin_amdgcn_permlane32_swap(a, a, false, false); own = __builtin_bit_cast(float, (unsigned)r[0]); return __builtin_bit_cast(float, (unsigned)r[1]); }
__device__ __forceinline__ float sum32(float v) {
    v += dppf<0xB1>(v); v += dppf<0x4E>(v); v += dppf<0x141>(v); v += dppf<0x140>(v); float o; const float p = xor16f(v, o); return o + p; }
__device__ __forceinline__ float max32(float v) {
    v = fmaxf(v, dppf<0xB1>(v)); v = fmaxf(v, dppf<0x4E>(v)); v = fmaxf(v, dppf<0x141>(v)); v = fmaxf(v, dppf<0x140>(v)); float o; const float p = xor16f(v, o); return fmaxf(o, p); }
__device__ __forceinline__ float wave_sum(float v) { v = sum32(v); float o; const float p = xor32f(v, o); return o + p; }

struct P0Item { const float* src; size_t step; unsigned char* dst; const float* ksc; int k0, kind; };
__device__ __forceinline__ void p0_load(f32x4 (&v)[16], const P0Item& it) {
#pragma unroll
    for (int i = 0; i < 16; ++i) v[i] = __builtin_nontemporal_load((const f32x4*)(it.src + (size_t)i * it.step));
}
__device__ __forceinline__ void p0_process(const f32x4 (&v)[16], const P0Item& it, LAS float* scr, int lane) {
    if (it.kind == 0) {
#pragma unroll
        for (int i = 0; i < 16; ++i) { const int kk = 4 * i + (lane >> 4); f32x4 w = v[i];
            if (it.ksc) w = w * it.ksc[it.k0 + kk];
            LAS float* d = scr + kk * 65 + 4 * (lane & 15); d[0] = w.x; d[1] = w.y; d[2] = w.z; d[3] = w.w; }
        LDS_WAIT();
        const int c = lane & 7;
#pragma unroll
        for (int j = 0; j < 8; ++j) { const int n = (lane >> 3) + 8 * j; const LAS float* s = scr + (8 * c) * 65 + n;
            v4u o; o.x = pk2(s[0 * 65], s[1 * 65]); o.y = pk2(s[2 * 65], s[3 * 65]); o.z = pk2(s[4 * 65], s[5 * 65]); o.w = pk2(s[6 * 65], s[7 * 65]);
            *(v4u*)(it.dst + ((size_t)n * D + it.k0 + 8 * c) * 2) = o; }
        LDS_WAIT();
    } else {
#pragma unroll
        for (int i = 0; i < 16; ++i) { const int kk = 8 * i + (lane >> 3); const f32x4 w = v[i] * pg8::W8_SCALE;
            LAS float* d = scr + kk * 33 + 4 * (lane & 7); d[0] = w.x; d[1] = w.y; d[2] = w.z; d[3] = w.w; }
        LDS_WAIT();
#pragma unroll
        for (int j = 0; j < 8; ++j) { const int n = (lane & 7) + 8 * (j & 3), c = (lane >> 3) + 8 * (j >> 2); const LAS float* s = scr + (8 * c) * 33 + n;
            v2u o; o.x = pg8::pk4_fp8(s[0 * 33], s[1 * 33], s[2 * 33], s[3 * 33]); o.y = pg8::pk4_fp8(s[4 * 33], s[5 * 33], s[6 * 33], s[7 * 33]);
            *(v2u*)(it.dst + (size_t)n * D + it.k0 + 8 * c) = o; }
        LDS_WAIT();
    }
}
__device__ __forceinline__ void p0_prologue(const Args& a, LAS unsigned char* lds, int tid, int lane, int wave, int vcu, int G) {
    unsigned char* ws = a.ws;
    TP_BEGIN(1);
    for (int u = vcu; u < 192; u += G) {
        const int cb = u % 12, ks = u / 12; LAS float* sl = (LAS float*)lds; LAS float* red = (LAS float*)(lds + 1024);
        const int g = tid >> 7, c4 = tid & 127; f32x4 w[16];
        { const float* src = a.in[I_ADAW] + (size_t)(ks * 64 + g) * 6144 + cb * 512 + 4 * c4;
#pragma unroll
          for (int i = 0; i < 16; ++i) w[i] = __builtin_nontemporal_load((const f32x4*)(src + (size_t)(4 * i) * 6144)); }
        if (tid < 256) { const float c = a.in[I_C][(tid >> 6) * 1024 + ks * 64 + (tid & 63)]; sl[tid] = c * sigmoidf_(c); }
        __syncthreads();
        f32x4 acc[4];
#pragma unroll
        for (int bb = 0; bb < 4; ++bb) acc[bb] = (f32x4){0.f, 0.f, 0.f, 0.f};
#pragma unroll
        for (int i = 0; i < 16; ++i) { const int kk = g + 4 * i;
#pragma unroll
            for (int bb = 0; bb < 4; ++bb) acc[bb] += w[i] * sl[bb * 64 + kk]; }
#pragma unroll
        for (int bb = 0; bb < 4; ++bb) *(LAS f32x4*)(red + (g * 4 + bb) * 512 + 4 * c4) = acc[bb];
        __syncthreads();
        float* mp = (float*)(ws + WS_MODP) + (size_t)(ks * 4) * 6144 + cb * 512 + tid;
#pragma unroll
        for (int bb = 0; bb < 4; ++bb) mp[bb * 6144] = (red[bb * 512 + tid] + red[(4 + bb) * 512 + tid]) + (red[(8 + bb) * 512 + tid] + red[(12 + bb) * 512 + tid]);
        asm volatile("s_waitcnt vmcnt(0)" ::: "memory");
        __syncthreads();
        if (tid == 0) { __builtin_amdgcn_fence(__ATOMIC_RELEASE, "agent"); ctl_wait_ready((unsigned*)(ws + WS_CTL)); (void)xb_add((unsigned*)(ws + WS_CTL) + CW_ADA, 1u); }
    }
    for (int j = vcu; j < 48; j += G) {
        if (j < 16) { const int m = j >> 3, h = j & 7; const float* src = a.in[m ? I_WI : I_WR] + h * 4096; bf16* dst = (bf16*)(ws + WS_WRT) + (m * 8 + h) * 4096;
            for (int idx = tid; idx < 4096; idx += 512) { const int o = idx >> 6, i = idx & 63; dst[idx] = (bf16)f2bf(src[i * 64 + o]); } }
        else { const int q = j - 16; bf16* dst = (bf16*)(ws + WS_WM);
            for (int idx = q * 4096 + tid; idx < (q + 1) * 4096; idx += 512) { const int t = (idx >> 7) & 127, s = idx & 127; dst[idx] = s <= t ? (bf16)f2bf(a.in[I_SGUW][idx]) : (bf16)0; } }
    }
    LAS float* scr = (LAS float*)(lds + wave * 16896);
    const int gw = vcu * NWAVES + wave, NGW = G * NWAVES;
    constexpr int I_IN = 16 * 32, I_OUT = 16 * 16, I_GU = 32 * 16 * 32, I_DN = 32 * 16 * 16, NITEMS = I_IN + I_OUT + I_GU + I_DN;
    const float* pWIN = a.in[I_WIN]; const float* pWOUT = a.in[I_WOUT]; const float* pWGU = a.in[I_WGU]; const float* pWDN = a.in[I_WDN]; const float* pGNL = a.in[I_GNL]; const float* pGNS = a.in[I_GNS];
    auto decode = [&](int it0, P0Item& o) {
        int r = it0;
        if (r < I_IN) { const int kb = r >> 5, nb = r & 31; o.kind = 0; o.k0 = 64 * kb; o.ksc = nullptr;
            o.src = pWIN + (size_t)(64 * kb + (lane >> 4)) * NPROJ + 64 * nb + 4 * (lane & 15); o.step = (size_t)4 * NPROJ; o.dst = ws + WS_WINT + (size_t)(64 * nb) * D * 2; return; }
        r -= I_IN;
        if (r < I_OUT) { const int kb = r >> 4, nb = r & 15; o.kind = 0; o.k0 = 64 * kb; o.ksc = o.k0 < DL ? pGNL : pGNS - DL;
            o.src = pWOUT + (size_t)(64 * kb + (lane >> 4)) * D + 64 * nb + 4 * (lane & 15); o.step = (size_t)4 * D; o.dst = ws + WS_WOUTT + (size_t)(64 * nb) * D * 2; return; }
        r -= I_OUT;
        if (r < I_GU) { const int e = r >> 9, q = r & 511, kb = q >> 6, nb = q & 63; const int n0 = 32 * nb, n1 = n0 & 1023; const int rd = (n1 >> 7) * 256 + (n0 >= 1024 ? 128 : 0) + (n1 & 127);
            o.kind = 1; o.k0 = 128 * kb; o.ksc = nullptr;
            o.src = pWGU + (size_t)e * D * 2048 + (size_t)(128 * kb + (lane >> 3)) * 2048 + n0 + 4 * (lane & 7); o.step = (size_t)8 * 2048; o.dst = ws + WS_WGUT + ((size_t)e * 2048 + rd) * D; return; }
        r -= I_GU;
        { const int e = r >> 8, q = r & 255, kb = q >> 5, nb = q & 31; o.kind = 1; o.k0 = 128 * kb; o.ksc = nullptr;
            o.src = pWDN + (size_t)e * D * D + (size_t)(128 * kb + (lane >> 3)) * D + 32 * nb + 4 * (lane & 7); o.step = (size_t)8 * D; o.dst = ws + WS_WDNT + ((size_t)e * D + 32 * nb) * D; }
    };
    int it = gw;
    if (it < NITEMS) {
        P0Item cur; f32x4 vc[16]; decode(it, cur); p0_load(vc, cur);
        for (;;) {
            const int itn = it + NGW; const bool more = itn < NITEMS;
            P0Item nxt = cur; f32x4 vn[16];
            if (more) { decode(itn, nxt); p0_load(vn, nxt); }
            p0_process(vc, cur, scr, lane);
            if (!more) break;
            cur = nxt; it = itn;
#pragma unroll
            for (int i = 0; i < 16; ++i) vc[i] = vn[i];
        }
    }
}
__device__ __forceinline__ void p1_modz(const Args& a, LAS unsigned char* lds, int tid, int lane, int wave, int vcu, int G) {
    const float* modp = (const float*)(a.ws + WS_MODP); float* mod = (float*)(a.ws + WS_MOD); bf16* Z = (bf16*)(a.ws + WS_Z); bf16* XB = (bf16*)(a.ws + WS_XB);
    if (tid == 0) { unsigned* c = (unsigned*)(a.ws + WS_CTL) + CW_ADA; unsigned sp = 0u; while (xb_ld(c) < 192u) { __builtin_amdgcn_s_sleep(1); if (++sp > (1u << 22)) break; } __builtin_amdgcn_fence(__ATOMIC_ACQUIRE, "agent"); }
    __syncthreads();
    for (int idx = vcu * 512 + tid; idx < 4 * 6144; idx += G * 512) { const int b = idx / 6144, n = idx - b * 6144; float s = a.in[I_ADAB][n];
#pragma unroll
        for (int ks = 0; ks < 16; ++ks) s += modp[(size_t)(ks * 4 + b) * 6144 + n];
        mod[idx] = s; }
    const int wpb = G / 4, b = vcu / wpb;
    LAS float* SHs = (LAS float*)lds; LAS float* SCs = (LAS float*)(lds + 4096);
    for (int k = tid; k < 2048; k += 512) { float s = a.in[I_ADAB][k];
#pragma unroll
        for (int ks = 0; ks < 16; ++ks) s += modp[(size_t)(ks * 4 + b) * 6144 + k];
        if (k < 1024) SHs[k] = s; else SCs[k - 1024] = (1.f + s) * a.in[I_N1G][k - 1024]; }
    __syncthreads();
    const int lw = (vcu - b * wpb) * NWAVES + wave, nlw = wpb * NWAVES;
#ifndef P1_NR
#define P1_NR 4
#endif
    for (int t = lw; t < SEQ; t += P1_NR * nlw) {
        f32x4 v[P1_NR][4]; float s[P1_NR];
#pragma unroll
        for (int q = 0; q < P1_NR; ++q) { const int tq_ = min(t + q * nlw, SEQ - 1); const f32x4* xr = (const f32x4*)(a.in[I_X] + ((size_t)b * SEQ + tq_) * D) + lane;
#pragma unroll
            for (int j = 0; j < 4; ++j) v[q][j] = __builtin_nontemporal_load(xr + 64 * j); }
#pragma unroll
        for (int q = 0; q < P1_NR; ++q) { s[q] = 0.f;
#pragma unroll
            for (int j = 0; j < 4; ++j) s[q] += (v[q][j].x * v[q][j].x + v[q][j].y * v[q][j].y) + (v[q][j].z * v[q][j].z + v[q][j].w * v[q][j].w);
            s[q] = rsqrtf(wave_sum(s[q]) * (1.f / D) + EPS); }
#pragma unroll
        for (int q = 0; q < P1_NR; ++q) if (t + q * nlw < SEQ) { v2u* o8 = (v2u*)(Z + ((size_t)b * SEQ + t + q * nlw) * D) + lane; v2u* x8 = (v2u*)(XB + ((size_t)b * SEQ + t + q * nlw) * D) + lane;
#pragma unroll
            for (int j = 0; j < 4; ++j) { const f32x4 g = *(const LAS f32x4*)(SCs + 4 * lane + 256 * j), sh = *(const LAS f32x4*)(SHs + 4 * lane + 256 * j); const f32x4 z = v[q][j] * s[q] * g + sh;
                v2u w; w.x = pk2(z.x, z.y); w.y = pk2(z.z, z.w); o8[64 * j] = w;
                v2u xw; xw.x = pk2(v[q][j].x, v[q][j].y); xw.y = pk2(v[q][j].z, v[q][j].w); x8[64 * j] = xw; } }
    }
    __syncthreads();
}
constexpr int XS = 516;
template <bool PASSB>
__device__ __forceinline__ void lru_unit(const Args& a, LAS unsigned char* lds, int tid, int lane, int wave, int unit) {
    const int b = unit >> 6, tb = unit & 63; const size_t row0 = (size_t)b * SEQ + tb * 64;
    const bf16* P = (const bf16*)(a.ws + WS_PROJ); float* agg = (float*)(a.ws + WS_AGG); bf16* HEADS = (bf16*)(a.ws + WS_HEADS); unsigned* phg = (unsigned*)(a.ws + WS_O32);
    LAS float* xcf = (LAS float*)lds; LAS float* Al = (LAS float*)(lds + 33280); LAS float* Bl = (LAS float*)(lds + 66560);
    LAS float* cst = (LAS float*)(lds + 99840); LAS float* rsl = (LAS float*)(lds + 105984);
    const int ch = tid, h = wave, tq = lane & 15, kq = lane >> 4;
    TP_BEGIN(311);
    bf16 xan[16], yan[16];
#pragma unroll
    for (int i = 0; i < 16; ++i) { xan[i] = __builtin_nontemporal_load(P + (row0 + i) * NPROJ + ch); if (PASSB) yan[i] = P[(row0 + i) * NPROJ + 512 + ch]; }
    const float cw0 = a.in[I_CONVW][ch], cw1 = a.in[I_CONVW][DL + ch], cw2 = a.in[I_CONVW][2 * DL + ch], cw3 = a.in[I_CONVW][3 * DL + ch], cb = a.in[I_CONVB][ch];
    cst[ch] = a.in[I_BR][ch]; cst[512 + ch] = a.in[I_BI][ch]; cst[1024 + ch] = log1pf(expf(-a.in[I_LAM][ch]));
    bf16x8 wrf[4][2], wif[4][2];
    { const bf16* wrt = (const bf16*)(a.ws + WS_WRT) + h * 4096; const bf16* wit = wrt + 8 * 4096;
#pragma unroll
      for (int ct = 0; ct < 4; ++ct)
#pragma unroll
          for (int ks = 0; ks < 2; ++ks) { const int off = (16 * ct + tq) * 64 + ks * 32 + 8 * kq; wrf[ct][ks] = *(const bf16x8*)(wrt + off); wif[ct][ks] = *(const bf16x8*)(wit + off); } }
    float x1 = 0.f, x2 = 0.f, x3 = 0.f;
    if (tb > 0) { x1 = bf2f(P[(row0 - 1) * NPROJ + ch]); x2 = bf2f(P[(row0 - 2) * NPROJ + ch]); x3 = bf2f(P[(row0 - 3) * NPROJ + ch]); }
    float hs = 0.f, pp = 1.f;
    if (PASSB) { const float* ag = agg + ((size_t)(b * 64) * 512 + ch) * 2;
        for (int c0 = 0; c0 < tb; c0 += 32) { float2 ph[32];
#pragma unroll
            for (int j = 0; j < 32; ++j) { ph[j].x = 1.f; ph[j].y = 0.f; if (c0 + j < tb) ph[j] = *(const float2*)(ag + (size_t)(c0 + j) * 1024); }
#pragma unroll
            for (int j = 0; j < 32; ++j) hs = ph[j].x * hs + ph[j].y; } }
    __syncthreads();
    TP_END(311);
    for (int sub = 0; sub < 4; ++sub) {
        TP_BEGIN(312);
        const size_t r0 = row0 + sub * 16;
        float xav[16], o[16];
#pragma unroll
        for (int i = 0; i < 16; ++i) { xav[i] = bf2f(xan[i]); if (PASSB) o[i] = bf2f(yan[i]); }
        if (sub < 3) {
#pragma unroll
            for (int i = 0; i < 16; ++i) { xan[i] = __builtin_nontemporal_load(P + (r0 + 16 + i) * NPROJ + ch); if (PASSB) yan[i] = P[(r0 + 16 + i) * NPROJ + 512 + ch]; } }
#pragma unroll
        for (int i = 0; i < 16; ++i) { const float xa = xav[i]; xcf[i * XS + ch] = cw0 * x3 + cw1 * x2 + cw2 * x1 + cw3 * xa + cb; x3 = x2; x2 = x1; x1 = xa; }
        __syncthreads();
        TP_END(312); TP_BEGIN(313);
        {
            bf16x8 xb[2];
#pragma unroll
            for (int ks = 0; ks < 2; ++ks) { const LAS float* p = xcf + tq * XS + h * 64 + ks * 32 + 8 * kq; const f32x4 lo = *(const LAS f32x4*)p, hi = *(const LAS f32x4*)(p + 4);
                const v4u w = {pk2(lo.x, lo.y), pk2(lo.z, lo.w), pk2(hi.x, hi.y), pk2(hi.z, hi.w)}; xb[ks] = __builtin_bit_cast(bf16x8, w); }
#pragma unroll
            for (int ct = 0; ct < 4; ++ct) { f32x4 rec = {0.f, 0.f, 0.f, 0.f}, inp = {0.f, 0.f, 0.f, 0.f};
#pragma unroll
                for (int ks = 0; ks < 2; ++ks) { rec = __builtin_amdgcn_mfma_f32_16x16x32_bf16(wrf[ct][ks], xb[ks], rec, 0, 0, 0); inp = __builtin_amdgcn_mfma_f32_16x16x32_bf16(wif[ct][ks], xb[ks], inp, 0, 0, 0); }
                const int cbase = h * 64 + 16 * ct + 4 * kq;
                const f32x4 xc4 = *(const LAS f32x4*)(xcf + tq * XS + cbase), br4 = *(const LAS f32x4*)(cst + cbase), bi4 = *(const LAS f32x4*)(cst + 512 + cbase), sp4 = *(const LAS f32x4*)(cst + 1024 + cbase);
                f32x4 av, bt;
                {
                    const f32x4 er = (rec + br4) * (-1.4426950409f), ei = (inp + bi4) * (-1.4426950409f); f32x4 rr, ig;
#pragma unroll
                    for (int r = 0; r < 4; ++r) { rr[r] = __builtin_amdgcn_rcpf(1.f + __builtin_amdgcn_exp2f(er[r])); ig[r] = __builtin_amdgcn_rcpf(1.f + __builtin_amdgcn_exp2f(ei[r])); }
                    const f32x4 la = rr * sp4 * (-8.f), y = la * 2.f, l2 = la * 1.4426950409f;
#pragma unroll
                    for (int r = 0; r < 4; ++r) av[r] = __builtin_amdgcn_exp2f(l2[r]);
                    const f32x4 ser = -y * (y * (y * (y * (y * 0.0083333338f + 0.041666668f) + 0.16666667f) + 0.5f) + 1.f), big = (f32x4){1.f, 1.f, 1.f, 1.f} - av * av; f32x4 em;
#pragma unroll
                    for (int r = 0; r < 4; ++r) em[r] = __builtin_amdgcn_sqrtf(y[r] > -0.25f ? ser[r] : big[r]);
                    bt = em * ig * xc4; }
                *(LAS f32x4*)(Al + tq * XS + cbase) = av; *(LAS f32x4*)(Bl + tq * XS + cbase) = bt; }
        }
        __syncthreads();
        TP_END(313); TP_BEGIN(314);
#pragma unroll
        for (int i = 0; i < 16; ++i) { const float av = Al[i * XS + ch], bt = Bl[i * XS + ch]; hs = av * hs + bt; if (PASSB) o[i] *= hs; else { pp *= av; phg[(r0 + i) * 512 + ch] = pk2(pp, hs); } }
        if (PASSB) {
#pragma unroll
            for (int i = 0; i < 16; ++i) Al[i * XS + ch] = o[i];
            __syncthreads();
            { const int t = tid >> 5, part = tid & 31; float s = 0.f;
#pragma unroll
              for (int j = 0; j < 16; ++j) { const float v = Al[t * XS + part + 32 * j]; s += v * v; }
              s = sum32(s);
              if (part == 0) rsl[t] = rsqrtf(s * (1.f / 512.f) + EPS); }
            __syncthreads();
#pragma unroll
            for (int i = 0; i < 16; ++i) HEADS[(r0 + i) * D + ch] = f2bf1(o[i] * rsl[i]);
        }
        __syncthreads();
        TP_END(314);
    }
    if (!PASSB) { float2 ph; ph.x = pp; ph.y = hs; *(float2*)(agg + ((size_t)(b * 64 + tb) * 512 + ch) * 2) = ph; }
}
__device__ __forceinline__ void lru_passb_unit(const Args& a, LAS unsigned char* lds, int tid, int lane, int wave, int unit) {
    const int b = unit >> 6, tb = unit & 63; const size_t row0 = (size_t)b * SEQ + tb * 64;
    const bf16* P = (const bf16*)(a.ws + WS_PROJ); const float* agg = (const float*)(a.ws + WS_AGG); bf16* HEADS = (bf16*)(a.ws + WS_HEADS); const unsigned* phg = (const unsigned*)(a.ws + WS_O32);
    LAS float* ol = (LAS float*)lds; LAS float* rsl = (LAS float*)(lds + 33280);
    const int ch = tid;
    unsigned phn[16]; bf16 yan[16];
#pragma unroll
    for (int i = 0; i < 16; ++i) { phn[i] = __builtin_nontemporal_load(phg + (row0 + i) * 512 + ch); yan[i] = __builtin_nontemporal_load(P + (row0 + i) * NPROJ + 512 + ch); }
    float carry = 0.f;
    { const float* ag = agg + ((size_t)(b * 64) * 512 + ch) * 2;
      for (int c0 = 0; c0 < tb; c0 += 32) { float2 ph[32];
#pragma unroll
          for (int j = 0; j < 32; ++j) { ph[j].x = 1.f; ph[j].y = 0.f; if (c0 + j < tb) ph[j] = *(const float2*)(ag + (size_t)(c0 + j) * 1024); }
#pragma unroll
          for (int j = 0; j < 32; ++j) carry = ph[j].x * carry + ph[j].y; } }
    for (int sub = 0; sub < 4; ++sub) {
        const size_t r0 = row0 + sub * 16; float o[16];
#pragma unroll
        for (int i = 0; i < 16; ++i) o[i] = (bfhi(phn[i]) + bflo(phn[i]) * carry) * bf2f(yan[i]);
        if (sub < 3) {
#pragma unroll
            for (int i = 0; i < 16; ++i) { phn[i] = __builtin_nontemporal_load(phg + (r0 + 16 + i) * 512 + ch); yan[i] = __builtin_nontemporal_load(P + (r0 + 16 + i) * NPROJ + 512 + ch); } }
#pragma unroll
        for (int i = 0; i < 16; ++i) ol[i * XS + ch] = o[i];
        __syncthreads();
        { const int t = tid >> 5, part = tid & 31; float sq = 0.f;
#pragma unroll
          for (int j = 0; j < 16; ++j) { const float v = ol[t * XS + part + 32 * j]; sq += v * v; }
          sq = sum32(sq);
          if (part == 0) rsl[t] = rsqrtf(sq * (1.f / 512.f) + EPS); }
        __syncthreads();
#pragma unroll
        for (int i = 0; i < 16; ++i) HEADS[(r0 + i) * D + ch] = f2bf1(o[i] * rsl[i]);
        __syncthreads();
    }
}
__device__ __forceinline__ void sgu_unit(const Args& a, LAS unsigned char* lds, int tid, int lane, int wave, int unit) {
    constexpr int PW = 68;
    const int th = unit & 1, bn = unit >> 1, Ks = 64 * (th + 1); const size_t rowbase = (size_t)bn * CHUNK;
    const bf16* P = (const bf16*)(a.ws + WS_PROJ); bf16* HEADS = (bf16*)(a.ws + WS_HEADS); const bf16* WM = (const bf16*)(a.ws + WS_WM);
    LAS unsigned* vw = (LAS unsigned*)lds; LAS float* ssq = (LAS float*)(lds + 139264);
#define SGU_VADDR(c, g) ((c) * PW + ((((g) ^ (((c) >> 3) & 7))) << 2))
    bf16x8 wfr[4][4];
    { const bf16* wmh0 = WM + (size_t)wave * 16384 + (size_t)(64 * th + (lane & 15)) * 128 + 8 * (lane >> 4);
#pragma unroll
      for (int rt = 0; rt < 4; ++rt)
#pragma unroll
          for (int ks = 0; ks < 4; ++ks) { wfr[rt][ks] = (bf16x8){0, 0, 0, 0, 0, 0, 0, 0}; if (32 * ks < Ks && 32 * ks <= 64 * th + 16 * rt + 15) wfr[rt][ks] = *(const bf16x8*)(wmh0 + rt * 16 * 128 + 32 * ks); } }
    TP_BEGIN(321);
    {
        const bf16* vbase = P + rowbase * NPROJ + 1536 + 8 * lane; const int sA = 8 * wave, sB = sA + 64; const bool two = Ks > 64;
        v4u raw[2][8];
#pragma unroll
        for (int q = 0; q < 8; ++q) raw[0][q] = __builtin_nontemporal_load((const v4u*)(vbase + (size_t)(sA + q) * NPROJ));
#pragma unroll
        for (int q = 0; q < 8; ++q) { raw[1][q] = (v4u){0u, 0u, 0u, 0u}; if (two) raw[1][q] = __builtin_nontemporal_load((const v4u*)(vbase + (size_t)(sB + q) * NPROJ)); }
        float lg[8], lb[8];
        { const f32x4 g0 = *(const f32x4*)(a.in[I_LNG] + 8 * lane), g1 = *(const f32x4*)(a.in[I_LNG] + 8 * lane + 4), b0 = *(const f32x4*)(a.in[I_LNB] + 8 * lane), b1 = *(const f32x4*)(a.in[I_LNB] + 8 * lane + 4);
#pragma unroll
          for (int i = 0; i < 4; ++i) { lg[i] = g0[i]; lg[4 + i] = g1[i]; lb[i] = b0[i]; lb[4 + i] = b1[i]; } }
#pragma unroll
        for (int t = 0; t < 2; ++t) { if (t == 1 && !two) break;
            float v[8][8], mean[8], rstd[8];
#pragma unroll
            for (int q = 0; q < 8; ++q) { const v4u r = raw[t][q]; v[q][0] = bflo(r.x); v[q][1] = bfhi(r.x); v[q][2] = bflo(r.y); v[q][3] = bfhi(r.y); v[q][4] = bflo(r.z); v[q][5] = bfhi(r.z); v[q][6] = bflo(r.w); v[q][7] = bfhi(r.w);
                mean[q] = ((v[q][0] + v[q][1]) + (v[q][2] + v[q][3])) + ((v[q][4] + v[q][5]) + (v[q][6] + v[q][7])); }
#pragma unroll
            for (int q = 0; q < 8; ++q) { mean[q] = wave_sum(mean[q]) * (1.f / 512.f); float qq = 0.f;
#pragma unroll
                for (int i = 0; i < 8; ++i) { v[q][i] -= mean[q]; qq += v[q][i] * v[q][i]; }
                rstd[q] = qq; }
#pragma unroll
            for (int q = 0; q < 8; ++q) rstd[q] = rsqrtf(wave_sum(rstd[q]) * (1.f / 512.f) + EPS);
            const int g = (t ? sB : sA) >> 3;
#pragma unroll
            for (int i = 0; i < 8; ++i) { v4u w;
                w.x = pk2(v[0][i] * rstd[0] * lg[i] + lb[i], v[1][i] * rstd[1] * lg[i] + lb[i]); w.y = pk2(v[2][i] * rstd[2] * lg[i] + lb[i], v[3][i] * rstd[3] * lg[i] + lb[i]);
                w.z = pk2(v[4][i] * rstd[4] * lg[i] + lb[i], v[5][i] * rstd[5] * lg[i] + lb[i]); w.w = pk2(v[6][i] * rstd[6] * lg[i] + lb[i], v[7][i] * rstd[7] * lg[i] + lb[i]);
                *(LAS v4u*)(vw + SGU_VADDR(8 * lane + i, g)) = w; } }
    }
    __syncthreads();
    TP_END(321);
    TP_BEGIN(322);
    const int h = wave, tq = lane & 15, kq = lane >> 4;
    f32x4 acc[4][4];
#pragma unroll
    for (int rt = 0; rt < 4; ++rt)
#pragma unroll
        for (int ct = 0; ct < 4; ++ct) acc[rt][ct] = (f32x4){0.f, 0.f, 0.f, 0.f};
    v2u uw[4][4]; float bias4[4];
#pragma unroll
    for (int rt = 0; rt < 4; ++rt) { const int t = 64 * th + 16 * rt + tq; bias4[rt] = a.in[I_SGUB][h * CHUNK + t]; const bf16* urow = P + (rowbase + t) * NPROJ + 1024 + h * 64 + 4 * kq;
#pragma unroll
        for (int ct = 0; ct < 4; ++ct) uw[rt][ct] = __builtin_nontemporal_load((const v2u*)(urow + 16 * ct)); }
#pragma unroll
    for (int ks = 0; ks < 4; ++ks) { if (32 * ks >= Ks) break;
        bf16x8 vf[4];
#pragma unroll
        for (int ct = 0; ct < 4; ++ct) vf[ct] = *(const LAS bf16x8*)(vw + SGU_VADDR(h * 64 + 16 * ct + tq, 4 * ks + kq));
#pragma unroll
        for (int rt = 0; rt < 4; ++rt) if (32 * ks <= 64 * th + 16 * rt + 15) { const bf16x8 wf = wfr[rt][ks];
#pragma unroll
            for (int ct = 0; ct < 4; ++ct) acc[rt][ct] = __builtin_amdgcn_mfma_f32_16x16x32_bf16(vf[ct], wf, acc[rt][ct], 0, 0, 0); }
    }
    TP_END(322);
#pragma unroll
    for (int rt = 0; rt < 4; ++rt) { const float bias = bias4[rt]; float sl = 0.f;
#pragma unroll
        for (int ct = 0; ct < 4; ++ct) { const v2u uq = uw[rt][ct];
            f32x4 o; o.x = bflo(uq.x) * (acc[rt][ct].x + bias); o.y = bfhi(uq.x) * (acc[rt][ct].y + bias); o.z = bflo(uq.y) * (acc[rt][ct].z + bias); o.w = bfhi(uq.y) * (acc[rt][ct].w + bias);
            acc[rt][ct] = o; sl += (o.x * o.x + o.y * o.y) + (o.z * o.z + o.w * o.w); }
        { float o_; const float p_ = xor16f(sl, o_); sl = o_ + p_; } { float o_; const float p_ = xor32f(sl, o_); sl = o_ + p_; }
        if (kq == 0) ssq[(16 * rt + tq) * 8 + h] = sl; }
    __syncthreads();
#pragma unroll
    for (int rt = 0; rt < 4; ++rt) { const int tl = 16 * rt + tq; const f32x4 s0 = *(const LAS f32x4*)(ssq + tl * 8), s1 = *(const LAS f32x4*)(ssq + tl * 8 + 4);
        const float rs = rsqrtf(((s0.x + s0.y) + (s0.z + s0.w) + (s1.x + s1.y) + (s1.z + s1.w)) * (1.f / 512.f) + EPS);
        bf16* hrow = HEADS + (rowbase + 64 * th + tl) * D + DL + h * 64 + 4 * kq;
#pragma unroll
        for (int ct = 0; ct < 4; ++ct) { v2u w; w.x = pk2(acc[rt][ct].x * rs, acc[rt][ct].y * rs); w.y = pk2(acc[rt][ct].z * rs, acc[rt][ct].w * rs); *(v2u*)(hrow + 16 * ct) = w; } }
    __syncthreads();
}
#undef SGU_VADDR
constexpr int RW_PITCH = 2064, RW_IMG = 2 * 32 * RW_PITCH;
constexpr size_t WS_RWS = 12 * MiB, WS_CB = 12 * MiB + 786432;
__device__ __forceinline__ void router_tables(const Args& a, int tid, int lane, int wave, int c, int n) {
    const float* mod = (const float*)(a.ws + WS_MOD); const float* rw = a.in[I_RW]; const float* n2g = a.in[I_N2G];
    for (int idx = c * 512 + tid; idx < 4 * D * NE; idx += n * 512) { const int e = idx & 31, k = (idx >> 5) & 1023, b = idx >> 15;
        const float w = rw[k * NE + e] * (n2g[k] * (1.f + mod[b * 6144 + 4096 + k]));
        const unsigned hi = pk2(w, w) & 0xffffu; const float r = w - __builtin_bit_cast(float, hi << 16); const unsigned mid = pk2(r, r) & 0xffffu;
        bf16* img = (bf16*)(a.ws + WS_RWS + (size_t)b * RW_IMG) + e * (RW_PITCH / 2) + k; img[0] = (bf16)hi; img[RW_IMG / 4] = (bf16)mid; }
    for (int j = c * NWAVES + wave; j < 4 * NE; j += n * NWAVES) { const int b = j >> 5, e = j & 31; float sacc = 0.f;
        for (int k = lane; k < D; k += 64) sacc += mod[b * 6144 + 3072 + k] * rw[k * NE + e];
        sacc = wave_sum(sacc); if (lane == 0) ((float*)(a.ws + WS_CB))[j] = sacc + a.in[I_RB][e]; }
}
template <int DRY>
__device__ __forceinline__ void router_unit(const Args& a, LAS unsigned char* lds, int tid, int lane, int wave, int unit) {
    const int tok0 = unit * 64, b = tok0 / SEQ;
    TP_BEGIN(60); TP_BEGIN(61);
    const float rbv = ((const float*)(a.ws + WS_CB))[b * NE + (lane & 31)];
    const bf16* HB = (const bf16*)(a.ws + WS_PROJ); const float* mod = (const float*)(a.ws + WS_MOD) + b * 6144; unsigned char* Z = a.ws + WS_Z;
    int* toke = (int*)(a.ws + WS_TOKE); float* gatee = (float*)(a.ws + WS_GATEE); int* pos = (int*)(a.ws + WS_POS); unsigned* cursor = (unsigned*)(a.ws + WS_CTL) + CW_CUR;
    LAS int* asg_e = (LAS int*)(lds + 140672); LAS float* asg_g = (LAS float*)(lds + 141696); LAS int* offl = (LAS int*)(lds + 142720);
    LAS float* part = (LAS float*)lds; LAS float* GK = (LAS float*)(lds + 132096); LAS float* SH = (LAS float*)(lds + 136192); LAS float* rsl = (LAS float*)(lds + 140288); LAS int* hist = (LAS int*)(lds + 140544);
    float tn[2], tsc[2], tsh[2];
#pragma unroll
    for (int i = 0; i < 2; ++i) { const int k = tid + 512 * i; tn[i] = a.in[I_N2G][k]; tsc[i] = mod[4096 + k]; tsh[i] = mod[3072 + k]; }
    v4u dvv[16];
    { const int tt = wave & 3, kh = wave >> 2, ti = lane & 15, kq = lane >> 4; const bf16* drow = HB + (size_t)(tok0 + tt * 16 + ti) * D + kh * 512 + 8 * kq;
#pragma unroll
      for (int blk = 0; blk < 16; ++blk) dvv[blk] = *(const v4u*)(drow + blk * 32); }
#pragma unroll
    for (int i = 0; i < 2; ++i) { const int k = tid + 512 * i; GK[k] = tn[i] * (1.f + tsc[i]); SH[k] = tsh[i]; }
    if (tid < 32) hist[tid] = 0;
    { const unsigned char* img = a.ws + WS_RWS + (size_t)b * RW_IMG + lane * 16;
#pragma unroll
      for (int p = 0; p < 16; ++p) { const int piece = wave * 16 + p; __builtin_amdgcn_global_load_lds((const unsigned*)(img + piece * 1024), (LAS unsigned*)(lds + piece * 1024), 16, 0, 0); }
      if (wave == 0) __builtin_amdgcn_global_load_lds((const unsigned*)(img + 128 * 1024), (LAS unsigned*)(lds + 128 * 1024), 16, 0, 0); }
    __syncthreads();
    TP_END(61); TP_BEGIN(62);
    for (int i0 = 0; i0 < 8; i0 += 4) {
        f32x4 v[4][4]; float rs[4];
#pragma unroll
        for (int q = 0; q < 4; ++q) { const size_t ro = (size_t)(tok0 + wave * 8 + i0 + q) * D + 4 * lane;
#pragma unroll
            for (int j = 0; j < 4; ++j) { const v2u d = *(const v2u*)(HB + ro + 256 * j); f32x4 xv; xv.x = bflo(d.x); xv.y = bfhi(d.x); xv.z = bflo(d.y); xv.w = bfhi(d.y); v[q][j] = xv; } }
#pragma unroll
        for (int q = 0; q < 4; ++q) { float s = 0.f;
#pragma unroll
            for (int j = 0; j < 4; ++j) s += (v[q][j].x * v[q][j].x + v[q][j].y * v[q][j].y) + (v[q][j].z * v[q][j].z + v[q][j].w * v[q][j].w);
            rs[q] = rsqrtf(wave_sum(s) * (1.f / D) + EPS); }
#pragma unroll
        for (int q = 0; q < 4; ++q) { const int tl = wave * 8 + i0 + q; unsigned* o4 = (unsigned*)(Z + (size_t)(tok0 + tl) * D) + lane;
#pragma unroll
            for (int j = 0; j < 4; ++j) { const f32x4 g = *(const LAS f32x4*)(GK + 4 * lane + 256 * j), sh = *(const LAS f32x4*)(SH + 4 * lane + 256 * j); const f32x4 z = v[q][j] * rs[q] * g + sh;
                o4[64 * j] = pg8::pk4_fp8(z.x, z.y, z.z, z.w); }
            if (lane == 0) rsl[tl] = rs[q]; } }
    TP_END(62); TP_BEGIN(63);
    asm volatile("s_waitcnt vmcnt(16)" ::: "memory");
    __syncthreads();
    TP_END(63); TP_BEGIN(64);
    if (DRY == 3) { if (dvv[0].x == 0x12345u && dvv[15].w == 0x54321u && dvv[7].y == 0x777u) rsl[0] = 0.f; __syncthreads(); return; }
    {
        const int tt = wave & 3, kh = wave >> 2, ti = lane & 15, kq = lane >> 4;
        f32x4 c0 = {0.f, 0.f, 0.f, 0.f}, c1 = {0.f, 0.f, 0.f, 0.f};
        const LAS unsigned char* bp = lds + ti * RW_PITCH + (kh * 512 + 8 * kq) * 2;
#pragma unroll
        for (int blk = 0; blk < 16; ++blk) { const bf16x8 av = __builtin_bit_cast(bf16x8, dvv[blk]);
            const bf16x8 b00 = *(const LAS bf16x8*)(bp + blk * 64), b01 = *(const LAS bf16x8*)(bp + blk * 64 + RW_IMG / 2), b10 = *(const LAS bf16x8*)(bp + blk * 64 + 16 * RW_PITCH), b11 = *(const LAS bf16x8*)(bp + blk * 64 + 16 * RW_PITCH + RW_IMG / 2);
            c0 = __builtin_amdgcn_mfma_f32_16x16x32_bf16(av, b00, c0, 0, 0, 0); c1 = __builtin_amdgcn_mfma_f32_16x16x32_bf16(av, b10, c1, 0, 0, 0);
            c0 = __builtin_amdgcn_mfma_f32_16x16x32_bf16(av, b01, c0, 0, 0, 0); c1 = __builtin_amdgcn_mfma_f32_16x16x32_bf16(av, b11, c1, 0, 0, 0); }
        __syncthreads();
#pragma unroll
        for (int r = 0; r < 4; ++r) { LAS float* p = part + (kh * 64 + tt * 16 + kq * 4 + r) * 33; p[ti] = c0[r]; p[16 + ti] = c1[r]; }
    }
    __syncthreads();
    TP_END(64); TP_BEGIN(65);
    if (DRY == 2) return;
    {
        const int e = lane & 31, hs = lane & 32;
        float v[4], m0[4], myv[4]; int myk[4];
#pragma unroll
        for (int p = 0; p < 4; ++p) { const int tl = wave * 8 + 2 * p + (lane >> 5); v[p] = (part[tl * 33 + e] + part[(64 + tl) * 33 + e]) * rsl[tl] + rbv; m0[p] = 0.f; myv[p] = 0.f; myk[p] = -1; }
#pragma unroll
        for (int k = 0; k < 4; ++k) { float m[4];
#pragma unroll
            for (int p = 0; p < 4; ++p) m[p] = max32(v[p]);
#pragma unroll
            for (int p = 0; p < 4; ++p) { const unsigned long long bal = __ballot(v[p] == m[p]); const int idx = __ffs((unsigned)(bal >> hs)) - 1;
                if (k == 0) m0[p] = m[p];
                if (e == idx) { v[p] = -INFINITY; myk[p] = k; myv[p] = m[p]; } } }
#pragma unroll
        for (int p = 0; p < 4; ++p) { const float myex = myk[p] >= 0 ? __builtin_amdgcn_exp2f((myv[p] - m0[p]) * 1.4426950409f) : 0.f; const float den = sum32(myex);
            if (myk[p] >= 0) { const int tl = wave * 8 + 2 * p + (lane >> 5); const int r = __hip_atomic_fetch_add(hist + e, 1, __ATOMIC_RELAXED, __HIP_MEMORY_SCOPE_WORKGROUP); asg_e[tl * 4 + myk[p]] = e | (r << 8); asg_g[tl * 4 + myk[p]] = myex * __builtin_amdgcn_rcpf(den); } }
    }
    __syncthreads();
    TP_END(65); TP_BEGIN(66);
    if (DRY == 1) return;
    if (tid < 32) offl[tid] = (int)__hip_atomic_fetch_add(cursor + tid, (unsigned)hist[tid], __ATOMIC_RELAXED, __HIP_MEMORY_SCOPE_AGENT);
    __syncthreads();
    if (tid < 256) { const int ev = asg_e[tid], e = ev & 255, r = ev >> 8; const int idx = e * pg8::ELIST + offl[e] + r; toke[idx] = tok0 + (tid >> 2); gatee[idx] = asg_g[tid]; pos[tok0 * 4 + tid] = idx; }
    __syncthreads();
    TP_END(66); TP_END(60);
}
__device__ __forceinline__ void moe_tables(const Args& a, LAS unsigned char* lds, int tid) {
    LAS int* tp = (LAS int*)(lds + TBL_OFF); LAS int* eb = tp + 36; LAS int* tot = tp + 72; unsigned* cursor = (unsigned*)(a.ws + WS_CTL) + CW_CUR;
    if (tid < 32) tot[tid] = (int)__hip_atomic_load(cursor + tid, __ATOMIC_RELAXED, __HIP_MEMORY_SCOPE_AGENT);
    __syncthreads();
    if (tid == 0) { int s = 0, r = 0; for (int e = 0; e < NE; ++e) { tp[e] = s; eb[e] = r; s += (tot[e] + 255) >> 8; r += tot[e]; } tp[NE] = s; eb[NE] = r; }
    __syncthreads();
}
__device__ __forceinline__ void final_rows(const Args& a, LAS unsigned char* lds, int lane, int wave, int vcu, int G, bool do_store) {
    const unsigned char* Y = a.ws + WS_Y; const int* pos = (const int*)(a.ws + WS_POS); const float* mod = (const float*)(a.ws + WS_MOD); const bf16* HB = (const bf16*)(a.ws + WS_PROJ);
    const LAS int* ebl = (const LAS int*)(lds + TBL_OFF) + 36;
    const int stride = G * NWAVES; constexpr int NQ = 4;
    int4 pn[NQ];
    { const int t0 = vcu * NWAVES + wave;
#pragma unroll
      for (int q = 0; q < NQ; ++q) pn[q] = *(const int4*)(pos + min(t0 + q * stride, NTOK - 1) * 4); }
    for (int tok0 = vcu * NWAVES + wave; tok0 < NTOK; tok0 += NQ * stride) {
        f32x4 v[NQ][4]; float s[NQ]; int4 pc[NQ];
#pragma unroll
        for (int q = 0; q < NQ; ++q) { pc[q] = pn[q]; pn[q] = *(const int4*)(pos + min(tok0 + (NQ + q) * stride, NTOK - 1) * 4); }
#pragma unroll
        for (int q = 0; q < NQ; ++q) { const int tok = min(tok0 + q * stride, NTOK - 1); const int b = tok / SEQ;
            int4 p = pc[q]; p.x = ebl[p.x >> 14] + (p.x & (pg8::ELIST - 1)); p.y = ebl[p.y >> 14] + (p.y & (pg8::ELIST - 1)); p.z = ebl[p.z >> 14] + (p.z & (pg8::ELIST - 1)); p.w = ebl[p.w >> 14] + (p.w & (pg8::ELIST - 1));
            const bf16* dr = HB + (size_t)tok * D;
#pragma unroll
            for (int j = 0; j < 4; ++j) { const int off = 4 * lane + 256 * j;
                const unsigned y0 = __builtin_nontemporal_load((const unsigned*)(Y + (size_t)p.x * D + off)), y1 = __builtin_nontemporal_load((const unsigned*)(Y + (size_t)p.y * D + off)), y2 = __builtin_nontemporal_load((const unsigned*)(Y + (size_t)p.z * D + off)), y3 = __builtin_nontemporal_load((const unsigned*)(Y + (size_t)p.w * D + off));
                typedef float f32x2_t __attribute__((ext_vector_type(2)));
                const f32x2_t a0 = __builtin_amdgcn_cvt_pk_f32_fp8(y0, false), a1 = __builtin_amdgcn_cvt_pk_f32_fp8(y0, true), b0 = __builtin_amdgcn_cvt_pk_f32_fp8(y1, false), b1 = __builtin_amdgcn_cvt_pk_f32_fp8(y1, true);
                const f32x2_t c0 = __builtin_amdgcn_cvt_pk_f32_fp8(y2, false), c1 = __builtin_amdgcn_cvt_pk_f32_fp8(y2, true), d0 = __builtin_amdgcn_cvt_pk_f32_fp8(y3, false), d1 = __builtin_amdgcn_cvt_pk_f32_fp8(y3, true);
                f32x4 m; m.x = ((a0.x + b0.x) + (c0.x + d0.x)) * (1.f / pg8::Y8_SCALE); m.y = ((a0.y + b0.y) + (c0.y + d0.y)) * (1.f / pg8::Y8_SCALE);
                m.z = ((a1.x + b1.x) + (c1.x + d1.x)) * (1.f / pg8::Y8_SCALE); m.w = ((a1.y + b1.y) + (c1.y + d1.y)) * (1.f / pg8::Y8_SCALE);
                const f32x4 g2 = *(const f32x4*)(mod + b * 6144 + 5120 + off); const v2u d = __builtin_nontemporal_load((const v2u*)(dr + off)); f32x4 hv; hv.x = bflo(d.x); hv.y = bfhi(d.x); hv.z = bflo(d.y); hv.w = bfhi(d.y); v[q][j] = hv + g2 * m; } }
#pragma unroll
        for (int q = 0; q < NQ; ++q) { s[q] = 0.f;
#pragma unroll
            for (int j = 0; j < 4; ++j) s[q] += (v[q][j].x * v[q][j].x + v[q][j].y * v[q][j].y) + (v[q][j].z * v[q][j].z + v[q][j].w * v[q][j].w); }
#pragma unroll
        for (int q = 0; q < NQ; ++q) s[q] = wave_sum(s[q]);
#pragma unroll
        for (int q = 0; q < NQ; ++q) if (do_store && tok0 + q * stride < NTOK) { const float rs = rsqrtf(s[q] * (1.f / D) + EPS); float* hr = a.out + (size_t)(tok0 + q * stride) * D;
#pragma unroll
            for (int j = 0; j < 4; ++j) { const int off = 4 * lane + 256 * j; const f32x4 fg = *(const f32x4*)(a.in[I_FG] + off); *(f32x4*)(hr + off) = v[q][j] * rs * fg; } }
    }
}

__global__ void __launch_bounds__(NWAVES * 64, 2) mega(Args args) {
    extern __shared__ __attribute__((aligned(16))) unsigned char lds_raw[];
    LAS unsigned char* lds = (LAS unsigned char*)lds_raw;
    volatile LAS unsigned* MISC = (volatile LAS unsigned*)(lds + MISC_OFF);
    const int tid = threadIdx.x, lane = tid & 63, wave = __builtin_amdgcn_readfirstlane(tid >> 6);
    const int G = gridDim.x; const int bx = blockIdx.x; const int vcu = (G % 8 == 0) ? (bx % 8) * (G / 8) + bx / 8 : bx;
    for (int u = tid; u < (LDS_BYTES - MISC_OFF) / 4; u += NWAVES * 64) ((LAS unsigned*)(lds + MISC_OFF))[u] = 0u;
    __syncthreads();
    const int lo = args.ph_lo, hi = args.ph_hi;
    XcdBarrier bar; bar.bar = (unsigned*)(args.ws + WS_CTL) + CW_BAR + args.li * XCD_BAR_WORDS; bar.x = 0; bar.st = nullptr;
    unsigned* const ctl = (unsigned*)(args.ws + WS_CTL);
    if (hi - lo > 1) { bar.x = xb_xcc_id(); bar.st = MISC + 8;
        if (vcu == G - 1) {
            for (int u = tid; u < CW_ZERO_WORDS; u += NWAVES * 64) __hip_atomic_store(ctl + u, 0u, __ATOMIC_RELAXED, __HIP_MEMORY_SCOPE_AGENT);
            asm volatile("s_waitcnt vmcnt(0)" ::: "memory"); __syncthreads();
            if (tid == 0) { __builtin_amdgcn_fence(__ATOMIC_RELEASE, "agent"); __hip_atomic_store(ctl + CW_FLAG, INIT_MAGIC, __ATOMIC_RELAXED, __HIP_MEMORY_SCOPE_AGENT); } } }
#ifndef PHMASK
#define PHMASK 0x7FF
#endif
#ifndef PHREP
#define PHREP 0
#endif
#define IN(k) (((PHMASK >> (k)) & 1) && lo <= (k) && (k) < hi)
#define NREP(k) (((PHREP >> (k)) & 1) ? 2 : 1)
#ifndef BARREP
#define BARREP 1
#endif
#define SEAM(k) do { if (IN(k) && IN((k) + 1)) { for (int _b = 0; _b < BARREP; ++_b) xcd_barrier(bar.bar, bar.x, bar.st); } } while (0)
    unsigned char* ws = args.ws;
#ifndef P3DUP
#define P3DUP 0
#endif
#ifndef P3DUP
#define P3DUP 0
#endif
#ifndef DRYMODE
#define DRYMODE 1
#endif
#ifndef PHDUP
#define PHDUP -1
#endif
#define DUPBAR() xcd_barrier(bar.bar, bar.x, bar.st)
#define PH2(SH) do { pg8::DenseOrder S; S.init(ws + WS_Z, ws + WS_WINT, NTOK, NPROJ, D * 2, G, ((SH) ? ((bx + 4) & 255) : bx)); pg8::EpiInProj E{(bf16*)(ws + WS_PROJ)}; \
        pg8::gemm_phase<pg8::EpiInProj, pg8::DenseOrder, true>(lds + RING_OFF, D * 2, S, E); } while (0)
#define PH3(SH) do { if ((vcu >> 1) & 1) { for (int u = vcu; u < 256; u += G) sgu_unit(args, lds, tid, lane, wave, ((SH) ? ((u + 128) & 255) : u)); for (int u = vcu; u < 256; u += G) lru_unit<false>(args, lds, tid, lane, wave, ((SH) ? ((u + 128) & 255) : u)); } \
        else { for (int u = vcu; u < 256; u += G) lru_unit<false>(args, lds, tid, lane, wave, ((SH) ? ((u + 128) & 255) : u)); for (int u = vcu; u < 256; u += G) sgu_unit(args, lds, tid, lane, wave, ((SH) ? ((u + 128) & 255) : u)); } } while (0)
#define PH4(SH) do { for (int u = vcu; u < 256; u += G) lru_passb_unit(args, lds, tid, lane, wave, ((SH) ? ((u + 128) & 255) : u)); } while (0)
#define PH5(SH) do { pg8::DenseOrder S; S.init(ws + WS_HEADS, ws + WS_WOUTT, NTOK, D, D * 2, G, ((SH) ? ((bx + 4) & 255) : bx)); pg8::EpiOutProj E{(const float*)(ws + WS_MOD), (const bf16*)(ws + WS_XB), (bf16*)(ws + WS_PROJ)}; \
        pg8::gemm_phase<pg8::EpiOutProj, pg8::DenseOrder, true>(lds + RING_OFF, D * 2, S, E); } while (0)
#define PH8(SH) do { moe_tables(args, lds, tid); pg8::MoeOrder S; S.init(ws + WS_Z, ws + WS_WGUT, (const LAS int*)(lds + TBL_OFF), (const LAS int*)(lds + TBL_OFF) + 36, 2048, D, G, ((SH) ? ((bx + 4) & 255) : bx)); \
        pg8::EpiSwiglu E{args.in[I_BGU], ws + WS_ACT, lds + EPI_OFF, ws + WS_WDNT + (size_t)bx * 131072, lds + 148480}; const pg8::GatherA ga{(const char*)(ws + WS_Z), (const int*)(ws + WS_TOKE), (LAS unsigned*)(lds + RT_OFF)}; \
        pg8::gemm_phase<pg8::EpiSwiglu, pg8::MoeOrder, true, true, true>(lds + RING_OFF, D, S, E, ga); } while (0)
#define PH9(SH) do { if (!IN(8)) moe_tables(args, lds, tid);   pg8::MoeOrder S; S.init(ws + WS_ACT, ws + WS_WDNT, (const LAS int*)(lds + TBL_OFF), (const LAS int*)(lds + TBL_OFF) + 36, D, D, G, ((SH) ? ((bx + 4) & 255) : bx), P9REV); \
        pg8::EpiDown E{args.in[I_BDN], (const float*)(ws + WS_GATEE), ws + WS_Y, lds + EPI_OFF}; pg8::gemm_phase<pg8::EpiDown, pg8::MoeOrder, true, true>(lds + RING_OFF, D, S, E); } while (0)
    if (IN(0)) { p0_prologue(args, lds, tid, lane, wave, vcu, G);
#if PHDUP == 0
        DUPBAR(); p0_prologue(args, lds, tid, lane, wave, vcu, G);
#endif
        }
    if (hi - lo > 1 && tid == 0) { ctl_wait_ready(ctl); (void)xb_add(&bar.bar[XB_XCNT(bar.x)], 1u); }
    if (IN(1)) { p1_modz(args, lds, tid, lane, wave, vcu, G);
#if PHDUP == 1
        DUPBAR(); p1_modz(args, lds, tid, lane, wave, vcu, G);
#endif
        SEAM(1); }
    if (IN(2)) {
#if PHDUP == 2
        PH2(1); DUPBAR();
#endif
        PH2(0); SEAM(2); }
    if (IN(3)) {
#if PHDUP == 3
        PH3(1); DUPBAR();
#endif
#if P3DUP == 1
        for (int u = vcu; u < 256; u += G) lru_unit<false>(args, lds, tid, lane, wave, (u + 128) & 255); DUPBAR();
#elif P3DUP == 2
        for (int u = vcu; u < 256; u += G) sgu_unit(args, lds, tid, lane, wave, (u + 128) & 255); DUPBAR();
#endif
#if P3DUP == 1
        for (int u = vcu; u < 256; u += G) lru_unit<false>(args, lds, tid, lane, wave, (u + 128) & 255); DUPBAR();
#elif P3DUP == 2
        for (int u = vcu; u < 256; u += G) sgu_unit(args, lds, tid, lane, wave, (u + 128) & 255); DUPBAR();
#endif
        PH3(0);
        if (G != 256) router_tables(args, tid, lane, wave, vcu, G); else if (!(vcu & 1)) router_tables(args, tid, lane, wave, vcu >> 1, 128);
        SEAM(3); }
    if (IN(4)) {
#if PHDUP == 4
        PH4(1); DUPBAR();
#endif
        PH4(0); SEAM(4); }
    if (IN(5)) {
#if PHDUP == 5
        PH5(1); DUPBAR();
#endif
        PH5(0); SEAM(5); }
    if (IN(6)) {
#if PHDUP == 6
        for (int u = vcu; u < 256; u += G) router_unit<DRYMODE>(args, lds, tid, lane, wave, (u + 128) & 255); DUPBAR();
#endif
        for (int u = vcu; u < 256; u += G) router_unit<0>(args, lds, tid, lane, wave, u); SEAM(6); }
    if (IN(8)) {
#if PHDUP == 8
        PH8(1); DUPBAR();
#endif
        PH8(0); SEAM(8); }
    if (IN(9)) {
#if PHDUP == 9
        PH9(1); DUPBAR();
#endif
        PH9(0); SEAM(9); }
    if (IN(10)) { if (!IN(8)) moe_tables(args, lds, tid); final_rows(args, lds, lane, wave, vcu, G, true); }
    if (hi - lo > 1 && tid == 0) { const unsigned old_ = xb_add(ctl + CW_EXIT, 1u); if (old_ + 1u == (unsigned)G) __hip_atomic_store(ctl + CW_FLAG, 0u, __ATOMIC_RELAXED, __HIP_MEMORY_SCOPE_AGENT); }
#undef IN
#undef SEAM
}

extern "C" void kernel_launch(void* const* d_in, const int* in_sizes, int n_in, void* d_out, int out_size, void* d_ws, size_t ws_size, hipStream_t stream) {
    static int grid = 0;
    if (grid == 0) {
        if (n_in != 28 || out_size != NTOK * D || ws_size < WS_END) { fprintf(stderr, "kernel_launch: unexpected shapes (n_in %d out %d ws %zu)\n", n_in, out_size, ws_size); grid = -1; return; }
        int dev = 0, cus = 0, per_cu = 0;
        if (hipGetDevice(&dev) != hipSuccess || hipDeviceGetAttribute(&cus, hipDeviceAttributeMultiprocessorCount, dev) != hipSuccess) { grid = -1; return; }
        if (hipFuncSetAttribute((const void*)mega, hipFuncAttributeMaxDynamicSharedMemorySize, LDS_BYTES) != hipSuccess) { fprintf(stderr, "kernel_launch: hipFuncSetAttribute failed\n"); grid = -1; return; }
        if (hipOccupancyMaxActiveBlocksPerMultiprocessor(&per_cu, (const void*)mega, NWAVES * 64, LDS_BYTES) != hipSuccess || per_cu < 1) { fprintf(stderr, "kernel_launch: occupancy query says %d blocks per CU\n", per_cu); (void)hipGetLastError(); grid = -1; return; }
        grid = cus < 256 ? cus : 256;
        if (grid % 8 != 0) { fprintf(stderr, "kernel_launch: %d CUs; the phase programs need a grid that is a multiple of 8\n", cus); grid = -1; return; }
    }
    if (grid < 0) return;
    Args a{};
    for (int i = 0; i < 28; ++i) a.in[i] = (const float*)d_in[i];
    a.out = (float*)d_out; a.ws = (unsigned char*)d_ws; a.ph_lo = 0; a.ph_hi = NPH; a.li = 0;
    hipLaunchKernelGGL(mega, dim3(grid), dim3(NWAVES * 64), LDS_BYTES, stream, a);
}
```
